# Optimizing an MI355X kernel written in HIP

```python
import jax
import jax.numpy as jnp
from jax import lax
import numpy as np

D_MODEL = 1024
BATCH = 8
SEQ = 4096
DEPTH = 4

N_MIXERS = 3
N_NSA = (DEPTH + 2) // 3
N_SGU = (DEPTH + 1) // 3
N_POOL = DEPTH // 3
RMS_EPS = 1e-6
LN_EPS = 1e-5
NEG_INF = -1e30
FORCE_SCORE = 1e9

NSA_HEADS = 16
NSA_KV_GROUPS = 4
NSA_HPG = NSA_HEADS // NSA_KV_GROUPS
NSA_HEAD_DIM = D_MODEL // NSA_HEADS
CMP_BLOCK = 32
CMP_STRIDE = 16
CMP_HIDDEN = 4 * NSA_HEAD_DIM
SEL_BLOCK = 64
SEL_TOPN = 16
WINDOW = 512
NSA_QBLOCK = 64
NSA_IN = NSA_HEADS * NSA_HEAD_DIM + 6 * NSA_KV_GROUPS * NSA_HEAD_DIM + 3 * NSA_HEADS
ROPE_THETA = 500000.0
ROPE_DIM = NSA_HEAD_DIM // 4

SGU_GROUPS = 8
SGU_WIDTH = D_MODEL
SGU_GROUP_DIM = SGU_WIDTH // SGU_GROUPS
SGU_CHUNK = 128

POOL_WINDOWS = (2, 4, 8, 16)
POOL_GROUPS = len(POOL_WINDOWS)
POOL_WIDTH = D_MODEL
POOL_GROUP_DIM = POOL_WIDTH // POOL_GROUPS

FFN_HIDDEN = -(-8 * D_MODEL // (3 * 256)) * 256

kernel_name = 'hybrid_nsa_gmlp_pool_swiglu_trunk'


def rmsnorm(x, g):
    xf = x.astype(jnp.float32)
    y = xf * lax.rsqrt(jnp.mean(xf * xf, axis=-1, keepdims=True) + RMS_EPS)
    return (y * g.astype(jnp.float32)).astype(x.dtype)


def layernorm(x, g, b):
    xf = x.astype(jnp.float32)
    mu = jnp.mean(xf, axis=-1, keepdims=True)
    var = jnp.mean(jnp.square(xf - mu), axis=-1, keepdims=True)
    y = (xf - mu) * lax.rsqrt(var + LN_EPS) * g.astype(jnp.float32) + b.astype(jnp.float32)
    return y.astype(x.dtype)


def rope_tables(positions):
    inv_freq = ROPE_THETA ** (-jnp.arange(0, ROPE_DIM, 2, dtype=jnp.float32) / ROPE_DIM)
    ang = positions.astype(jnp.float32)[..., None] * inv_freq
    return jnp.cos(ang)[:, None], jnp.sin(ang)[:, None]


def partial_rope(t, cos, sin):
    half = ROPE_DIM // 2
    tf = t[..., :ROPE_DIM].astype(jnp.float32)
    t1, t2 = tf[..., :half], tf[..., half:]
    rot = jnp.concatenate([t1 * cos - t2 * sin, t2 * cos + t1 * sin], axis=-1)
    return jnp.concatenate([rot.astype(t.dtype), t[..., ROPE_DIM:]], axis=-1)


def nsa_mixer(h, cos, sin, w_in, cmp_pos_k, cmp_k_w1, cmp_k_w2, cmp_pos_v, cmp_v_w1, cmp_v_w2, w_out):
    B, S, _ = h.shape
    H, G, P, dh, QB = NSA_HEADS, NSA_KV_GROUPS, NSA_HPG, NSA_HEAD_DIM, NSA_QBLOCK
    splits = [H * dh + k * G * dh for k in range(7)]
    q, kc, vc, ks, vs, kw, vw, gl = jnp.split(h @ w_in, splits, axis=-1)

    def to_heads(t, n):
        return t.reshape(B, S, n, dh).transpose(0, 2, 1, 3)

    q = (partial_rope(to_heads(q, H), cos, sin) * (dh ** -0.5)).reshape(B, G, P, S, dh)
    kc, ks, kw = [partial_rope(to_heads(t, G), cos, sin) for t in (kc, ks, kw)]
    vc, vs, vw = [to_heads(t, G) for t in (vc, vs, vw)]
    gates = jax.nn.sigmoid(gl.astype(jnp.float32)).astype(h.dtype)
    gates = gates.reshape(B, S, 3, G, P).transpose(0, 2, 3, 4, 1)

    n_cmp = (S - CMP_BLOCK) // CMP_STRIDE + 1
    cmp_start = jnp.arange(n_cmp) * CMP_STRIDE
    cmp_end = cmp_start + CMP_BLOCK - 1
    tok_idx = cmp_start[:, None] + jnp.arange(CMP_BLOCK)[None, :]

    def compress(t, pos, w1, w2):
        blk = (t[:, :, tok_idx, :] + pos).reshape(B, G, n_cmp, CMP_BLOCK * dh)
        return jax.nn.gelu(blk @ w1) @ w2

    k_cmp = compress(kc, cmp_pos_k, cmp_k_w1, cmp_k_w2)
    v_cmp = compress(vc, cmp_pos_v, cmp_v_w1, cmp_v_w2)

    n_sel = S // SEL_BLOCK
    n_top = min(SEL_TOPN, n_sel)
    sel_ids = jnp.arange(n_sel)
    sel_start = sel_ids * SEL_BLOCK
    overlap = ((cmp_start[:, None] <= sel_start[None, :] + SEL_BLOCK - 1)
               & (cmp_end[:, None] >= sel_start[None, :])).astype(jnp.float32)
    ks_blk = ks.reshape(B, G, n_sel, SEL_BLOCK, dh)
    vs_blk = vs.reshape(B, G, n_sel, SEL_BLOCK, dh)
    b_idx = jnp.arange(B)[:, None, None, None]
    g_idx = jnp.arange(G)[None, :, None, None]

    kw_pad = jnp.pad(kw, ((0, 0), (0, 0), (WINDOW, 0), (0, 0)))
    vw_pad = jnp.pad(vw, ((0, 0), (0, 0), (WINDOW, 0), (0, 0)))

    def block_fn(bi):
        s = bi * QB
        qb = lax.dynamic_slice_in_dim(q, s, QB, axis=3)
        t_pos = s + jnp.arange(QB)

        sc = jnp.einsum('bgpqd,bgnd->bgpqn', qb, k_cmp).astype(jnp.float32)
        valid_c = cmp_end[None, :] <= t_pos[:, None]
        p_c = jax.nn.softmax(jnp.where(valid_c, sc, NEG_INF), axis=-1)
        p_c = jnp.where(valid_c.any(-1)[:, None], p_c, 0.0)
        o_c = jnp.einsum('bgpqn,bgnd->bgpqd', p_c.astype(v_cmp.dtype), v_cmp)

        imp = jnp.einsum('bgpqn,nm->bgqm', p_c, overlap)
        cur = (t_pos // SEL_BLOCK)[:, None]
        forced = (sel_ids[None, :] == 0) | (sel_ids[None, :] == cur) | (sel_ids[None, :] == cur - 1)
        imp = jnp.where(forced, FORCE_SCORE, imp)
        imp = jnp.where(sel_start[None, :] <= t_pos[:, None], imp, NEG_INF)
        _, sel_idx = lax.top_k(imp, n_top)
        k_sel = ks_blk[b_idx, g_idx, sel_idx]
        v_sel = vs_blk[b_idx, g_idx, sel_idx]
        key_pos = sel_idx[..., None] * SEL_BLOCK + jnp.arange(SEL_BLOCK)
        valid_s = key_pos <= t_pos[None, None, :, None, None]
        ss = jnp.einsum('bgpqd,bgqnld->bgpqnl', qb, k_sel).astype(jnp.float32)
        ss = jnp.where(valid_s[:, :, None], ss, NEG_INF)
        p_s = jax.nn.softmax(ss.reshape(B, G, P, QB, n_top * SEL_BLOCK), axis=-1)
        p_s = p_s.reshape(B, G, P, QB, n_top, SEL_BLOCK).astype(v_sel.dtype)
        o_s = jnp.einsum('bgpqnl,bgqnld->bgpqd', p_s, v_sel)

        kwb = lax.dynamic_slice_in_dim(kw_pad, s, WINDOW + QB, axis=2)
        vwb = lax.dynamic_slice_in_dim(vw_pad, s, WINDOW + QB, axis=2)
        kpos = s - WINDOW + jnp.arange(WINDOW + QB)
        rel = t_pos[:, None] - kpos[None, :]
        valid_w = (rel >= 0) & (rel < WINDOW) & (kpos[None, :] >= 0)
        sw = jnp.einsum('bgpqd,bgkd->bgpqk', qb, kwb).astype(jnp.float32)
        p_w = jax.nn.softmax(jnp.where(valid_w, sw, NEG_INF), axis=-1).astype(vwb.dtype)
        o_w = jnp.einsum('bgpqk,bgkd->bgpqd', p_w, vwb)

        gb = lax.dynamic_slice_in_dim(gates, s, QB, axis=4)[..., None]
        o = gb[:, 0] * o_c + gb[:, 1] * o_s + gb[:, 2] * o_w
        return o.astype(h.dtype)

    out = lax.map(block_fn, jnp.arange(S // QB))
    out = out.transpose(1, 0, 4, 2, 3, 5).reshape(B, S, H * dh)
    return out @ w_out


def sgu_mixer(h, w_in, ln_g, ln_b, w_s, b_s, w_out):
    B, S, _ = h.shape
    T = SGU_CHUNK
    u, v = jnp.split(jax.nn.gelu(h @ w_in), 2, axis=-1)
    v = layernorm(v, ln_g, ln_b).reshape(B, S // T, T, SGU_GROUPS, SGU_GROUP_DIM)
    ws = jnp.where(jnp.tril(jnp.ones((T, T), dtype=bool)), w_s, 0.0)
    sv = jnp.einsum('gts,bnsgc->bntgc', ws, v) + b_s.T[None, None, :, :, None]
    return (u * sv.reshape(B, S, SGU_WIDTH).astype(u.dtype)) @ w_out


def pool_mixer(h, w_in, w_grp, scale, w_out):
    B, S, _ = h.shape
    z = (h @ w_in).astype(jnp.float32)
    csum = jnp.pad(jnp.cumsum(z, axis=1), ((0, 0), (1, 0), (0, 0)))
    t = jnp.arange(S)
    diffs = []
    for gi, w in enumerate(POOL_WINDOWS):
        sl = slice(gi * POOL_GROUP_DIM, (gi + 1) * POOL_GROUP_DIM)
        lo = jnp.maximum(t + 1 - w, 0)
        win = csum[:, 1:, sl] - csum[:, lo, sl]
        cnt = (t + 1 - lo).astype(jnp.float32)[None, :, None]
        diffs.append(win / cnt - z[..., sl])
    d = jnp.stack(diffs, axis=2)
    y = jnp.einsum('bsgc,gce->bsge', d, w_grp.astype(jnp.float32)).reshape(B, S, POOL_WIDTH)
    y = y * scale.astype(jnp.float32)
    return y.astype(h.dtype) @ w_out


def swiglu(h, w_gate_up, w_down):
    g, u = jnp.split(h @ w_gate_up, 2, axis=-1)
    return (jax.nn.silu(g) * u) @ w_down


def setup_inputs(seed: int = 0) -> dict:
    key = jax.random.key(seed)
    keys = iter(jax.random.split(key, 32))

    def nrm(shape, scale):
        return scale * jax.random.normal(next(keys), shape, jnp.float32)

    D, dh, G = D_MODEL, NSA_HEAD_DIM, NSA_KV_GROUPS
    res = (2 * DEPTH) ** -0.5
    x = jax.random.normal(next(keys), (BATCH, SEQ, D), jnp.float32)
    positions = (jnp.arange(SEQ, dtype=jnp.int32)[None, :]
                 + jax.random.randint(next(keys), (BATCH, 1), 0, 1024, dtype=jnp.int32))
    return {
        'x': x,
        'positions': positions,
        'mix_norm': 1.0 + nrm((DEPTH, D), 0.05),
        'ffn_norm': 1.0 + nrm((DEPTH, D), 0.05),
        'final_norm': 1.0 + nrm((D,), 0.05),
        'nsa_w_in': nrm((N_NSA, D, NSA_IN), D ** -0.5),
        'nsa_cmp_pos_k': nrm((N_NSA, CMP_BLOCK, dh), 0.1),
        'nsa_cmp_k_w1': nrm((N_NSA, CMP_BLOCK * dh, CMP_HIDDEN), (CMP_BLOCK * dh) ** -0.5),
        'nsa_cmp_k_w2': nrm((N_NSA, CMP_HIDDEN, dh), CMP_HIDDEN ** -0.5),
        'nsa_cmp_pos_v': nrm((N_NSA, CMP_BLOCK, dh), 0.1),
        'nsa_cmp_v_w1': nrm((N_NSA, CMP_BLOCK * dh, CMP_HIDDEN), (CMP_BLOCK * dh) ** -0.5),
        'nsa_cmp_v_w2': nrm((N_NSA, CMP_HIDDEN, dh), CMP_HIDDEN ** -0.5),
        'nsa_w_out': nrm((N_NSA, NSA_HEADS * dh, D), res * (NSA_HEADS * dh) ** -0.5),
        'sgu_w_in': nrm((N_SGU, D, 2 * SGU_WIDTH), D ** -0.5),
        'sgu_ln_g': 1.0 + nrm((N_SGU, SGU_WIDTH), 0.05),
        'sgu_ln_b': nrm((N_SGU, SGU_WIDTH), 0.02),
        'sgu_w_s': nrm((N_SGU, SGU_GROUPS, SGU_CHUNK, SGU_CHUNK), SGU_CHUNK ** -0.5),
        'sgu_b_s': 1.0 + nrm((N_SGU, SGU_GROUPS, SGU_CHUNK), 0.1),
        'sgu_w_out': nrm((N_SGU, SGU_WIDTH, D), res * SGU_WIDTH ** -0.5),
        'pool_w_in': nrm((N_POOL, D, POOL_WIDTH), D ** -0.5),
        'pool_w_grp': nrm((N_POOL, POOL_GROUPS, POOL_GROUP_DIM, POOL_GROUP_DIM), POOL_GROUP_DIM ** -0.5),
        'pool_scale': 1.0 + nrm((N_POOL, POOL_WIDTH), 0.1),
        'pool_w_out': nrm((N_POOL, POOL_WIDTH, D), res * POOL_WIDTH ** -0.5),
        'ffn_w_gate_up': nrm((DEPTH, D, 2 * FFN_HIDDEN), D ** -0.5),
        'ffn_w_down': nrm((DEPTH, FFN_HIDDEN, D), res * FFN_HIDDEN ** -0.5),
    }


def reference(x, positions, mix_norm, ffn_norm, final_norm,
              nsa_w_in, nsa_cmp_pos_k, nsa_cmp_k_w1, nsa_cmp_k_w2,
              nsa_cmp_pos_v, nsa_cmp_v_w1, nsa_cmp_v_w2, nsa_w_out,
              sgu_w_in, sgu_ln_g, sgu_ln_b, sgu_w_s, sgu_b_s, sgu_w_out,
              pool_w_in, pool_w_grp, pool_scale, pool_w_out,
              ffn_w_gate_up, ffn_w_down):
    cos, sin = rope_tables(positions)
    for i in range(DEPTH):
        kind, j = i % N_MIXERS, i // N_MIXERS
        h = rmsnorm(x, mix_norm[i])
        if kind == 0:
            m = nsa_mixer(h, cos, sin, nsa_w_in[j], nsa_cmp_pos_k[j], nsa_cmp_k_w1[j], nsa_cmp_k_w2[j],
                          nsa_cmp_pos_v[j], nsa_cmp_v_w1[j], nsa_cmp_v_w2[j], nsa_w_out[j])
        elif kind == 1:
            m = sgu_mixer(h, sgu_w_in[j], sgu_ln_g[j], sgu_ln_b[j], sgu_w_s[j], sgu_b_s[j], sgu_w_out[j])
        else:
            m = pool_mixer(h, pool_w_in[j], pool_w_grp[j], pool_scale[j], pool_w_out[j])
        x = x + m
        x = x + swiglu(rmsnorm(x, ffn_norm[i]), ffn_w_gate_up[i], ffn_w_down[i])
    return rmsnorm(x, final_norm)
```

```cpp
#include <hip/hip_runtime.h>
#include <hip/hip_cooperative_groups.h>
#include <cstdio>
namespace cg = cooperative_groups;
namespace pg8 {
#define PG8_LAS __attribute__((address_space(3)))
typedef unsigned short bf16_t;
typedef short bf16x8 __attribute__((ext_vector_type(8)));
typedef float f32x4 __attribute__((ext_vector_type(4)));
typedef unsigned u32x4 __attribute__((ext_vector_type(4)));
constexpr int BM = 256, BK = 64, HALF = 128, HTB = HALF * BK * 2  , STAGE_BYTES = 8 * HTB, NXCD = 8, WGM = 8;

__host__ __device__ __forceinline__ int lds_byte(int r, int c) { const int st = (r >> 4) * 2 + (c >> 5), rr = r & 15, cc = c & 31, ob = rr * 64 + cc * 2; return st * 1024 + (ob ^ (((ob >> 9) & 1) << 5)); }
__host__ __device__ __forceinline__ void stage_rc(int b, int& R, int& C) { const int st = b / 1024, sb = b % 1024, swz = sb ^ (((sb >> 9) & 1) << 5); R = (st >> 1) * 16 + swz / 64; C = (st & 1) * 32 + (swz % 64) / 2; }
__host__ __device__ __forceinline__ int perm32(int rho) { const int n = rho >> 4, i = rho & 15; return 8 * (i >> 2) + 4 * n + (i & 3); }

struct Unit { int pm, pn; };
struct Gemm { const bf16_t* A; const bf16_t* Bt; int M, N, K, lda; };

struct StaticOrder {
    int nM, nN, nwg, G, c;
    __host__ __device__ void init(int M, int N, int G_, int c_) { nM = M / BM; nN = N / BM; nwg = nM * nN; G = G_; c = c_; }
    __host__ __device__ bool next(int i, Unit& u) const {
        const long L = (long)i * G + c; if (L >= nwg) return false;
        int wgid = (int)L; { const int q = nwg / NXCD, r = nwg % NXCD, xcd = wgid % NXCD, off = wgid / NXCD; wgid = (xcd < r ? xcd * (q + 1) : r * (q + 1) + (xcd - r) * q) + off; }
        const int nig = WGM * nN, gid = wgid / nig, fm = gid * WGM, gsz = (nM - fm) < WGM ? (nM - fm) : WGM;
        u.pm = fm + ((wgid % nig) % gsz); u.pn = (wgid % nig) / gsz; return true;
    }
    __device__ __forceinline__ void a_ready(const Unit&) const {}
    __device__ __forceinline__ void done(const Unit&) const {}
};
template <class Epi, class Sched, bool STAMP = false>
__device__ __forceinline__ void gemm_phase(PG8_LAS unsigned char* lds, const Gemm g, const Sched& S, const Epi& E, unsigned long long* stamps) {
    int tid_ = threadIdx.x; asm volatile("" : "+v"(tid_)); const int tid = tid_, wid = __builtin_amdgcn_readfirstlane(tid >> 6), lane = tid & 63, wr = wid >> 2, wc = wid & 3, fr = lane & 15, fq = lane >> 4;
    const int K = g.K, nt = K / BK;
    int ts_lo = 0, ts_hi = 0, nts = 0; const unsigned long long rt_entry = STAMP ? (unsigned long long)wall_clock64() : 0ull;
#define PG8_STAMP() do { if (STAMP && wid == 0 && nts < 64) { const unsigned long long _c = (unsigned long long)clock64(); \
        ts_lo = (lane == nts) ? (int)(unsigned)_c : ts_lo; ts_hi = (lane == nts) ? (int)(unsigned)(_c >> 32) : ts_hi; ++nts; } } while (0)
    PG8_STAMP();
    unsigned voffA[2], voffB[2];
#pragma unroll
    for (int i = 0; i < 2; ++i) { int R, C; stage_rc(tid * 16 + i * 8192, R, C); const int Rb = Epi::PERM ? ((R & ~31) + perm32(R & 31)) : R;
        voffA[i] = (unsigned)(R * g.lda + C) * 2u; voffB[i] = (unsigned)(Rb * K + C) * 2u; }
    const size_t kstep = (size_t)(BK * 2);
    const size_t hstep = (size_t)HALF * K * 2;
    const size_t tstep = 2 * hstep; const size_t hstepA = (size_t)HALF * g.lda * 2; const size_t tstepA = 2 * hstepA;
    const unsigned ldsw = (unsigned)wid * 1024u;
    const int aoff = lds_byte(wr * 64 + fr, fq * 8), boff = lds_byte(wc * 32 + fr, fq * 8);
#define PG8_SA(b, h) (((b) * 2 + (h)) * HTB)
#define PG8_SB(b, h) ((4 + (b) * 2 + (h)) * HTB)
#define PG8_STAGE(bufoff, gbase, voff) do { _Pragma("unroll") for (int _i = 0; _i < 2; ++_i) \
        __builtin_amdgcn_global_load_lds((const unsigned*)((const char*)(gbase) + (voff)[_i]), (PG8_LAS unsigned*)(lds + (bufoff) + ldsw + _i * 8192), 16, 0, 0); } while (0)
#define PG8_LDA(dst, b, h) do { _Pragma("unroll") for (int m = 0; m < 4; ++m) _Pragma("unroll") for (int k = 0; k < 2; ++k) dst[m][k] = *(const PG8_LAS bf16x8*)(lds + PG8_SA(b, h) + aoff + m * 2048 + k * 1024); } while (0)
#define PG8_LDB(dst, b, h) do { _Pragma("unroll") for (int n = 0; n < 2; ++n) _Pragma("unroll") for (int k = 0; k < 2; ++k) dst[n][k] = *(const PG8_LAS bf16x8*)(lds + PG8_SB(b, h) + boff + n * 2048 + k * 1024); } while (0)
#define PG8_MMA(ai, bj, At, Bt) do { __builtin_amdgcn_s_setprio(1); _Pragma("unroll") for (int m = 0; m < 4; ++m) _Pragma("unroll") for (int n = 0; n < 2; ++n) _Pragma("unroll") for (int k = 0; k < 2; ++k) \
        acc[ai][bj][m][n] = __builtin_amdgcn_mfma_f32_16x16x32_bf16(Bt[n][k], At[m][k], acc[ai][bj][m][n], 0, 0, 0); __builtin_amdgcn_s_setprio(0); } while (0)
#define PG8_WAIT_V(n) asm volatile("s_waitcnt vmcnt(" #n ")" ::: "memory")
#define PG8_WAIT_L(n) asm volatile("s_waitcnt lgkmcnt(" #n ")" ::: "memory")
#define PG8_BAR __builtin_amdgcn_s_barrier()
#define PG8_SCHED __builtin_amdgcn_sched_barrier(0)
    Unit cur, nxt; int ui = 0;
    if (!S.next(0, cur)) return;
    f32x4 acc[2][2][4][2];
#pragma unroll
    for (int a = 0; a < 2; ++a)
#pragma unroll
        for (int b = 0; b < 2; ++b)
#pragma unroll
            for (int m = 0; m < 4; ++m)
#pragma unroll
                for (int n = 0; n < 2; ++n) acc[a][b][m][n] = (f32x4){0.f, 0.f, 0.f, 0.f};
    bf16x8 At[4][2], B0[2][2], B1[2][2];
    const char* cA = (const char*)g.A + (size_t)cur.pm * tstepA; const char* cB = (const char*)g.Bt + (size_t)cur.pn * tstep;
    S.a_ready(cur);
    PG8_STAGE(PG8_SB(0, 0), cB, voffB); PG8_STAGE(PG8_SA(0, 0), cA, voffA); PG8_STAGE(PG8_SB(0, 1), cB + hstep, voffB); PG8_STAGE(PG8_SA(0, 1), cA + hstepA, voffA);
    if (wr == 1) PG8_BAR;
    PG8_WAIT_V(4); PG8_BAR;
    PG8_STAGE(PG8_SB(1, 0), cB + kstep, voffB); PG8_STAGE(PG8_SA(1, 0), cA + kstep, voffA); PG8_STAGE(PG8_SB(1, 1), cB + hstep + kstep, voffB);
    PG8_WAIT_V(6); PG8_BAR;
    PG8_STAMP();
    for (;;) {
        const bool has_next = S.next(ui + 1, nxt);
        const char* nA = has_next ? (const char*)g.A + (size_t)nxt.pm * tstepA : cA; const char* nB = has_next ? (const char*)g.Bt + (size_t)nxt.pn * tstep : cB;
        for (int t = 0; t < nt; t += 2) {
            const bool last = (t == nt - 2);
            const char* a1 = cA + (size_t)(t + 1) * kstep;
            const char* a2 = last ? nA : cA + (size_t)(t + 2) * kstep; const char* b2 = last ? nB : cB + (size_t)(t + 2) * kstep;
            const char* a3 = a2 + kstep; const char* b3 = b2 + kstep;
            if (last && has_next) S.a_ready(nxt);
            PG8_LDB(B0, 0, 0); PG8_SCHED; PG8_LDA(At, 0, 0); PG8_STAGE(PG8_SA(1, 1), a1 + hstepA, voffA);
            PG8_WAIT_L(8); PG8_BAR; PG8_WAIT_L(0); PG8_MMA(0, 0, At, B0); PG8_BAR; PG8_SCHED;
            PG8_LDB(B1, 0, 1); PG8_STAGE(PG8_SB(0, 0), b2, voffB);
            PG8_BAR; PG8_WAIT_L(0); PG8_MMA(0, 1, At, B1); PG8_BAR;
            PG8_LDA(At, 0, 1); PG8_STAGE(PG8_SA(0, 0), a2, voffA);
            PG8_BAR; PG8_WAIT_L(0); PG8_MMA(1, 0, At, B0); PG8_BAR; PG8_SCHED;
            PG8_STAGE(PG8_SB(0, 1), b2 + hstep, voffB);
            PG8_WAIT_V(6); PG8_BAR; PG8_MMA(1, 1, At, B1); PG8_BAR;
            PG8_LDB(B0, 1, 0); PG8_SCHED; PG8_LDA(At, 1, 0); PG8_STAGE(PG8_SA(0, 1), a2 + hstepA, voffA);
            PG8_WAIT_L(8); PG8_BAR; PG8_WAIT_L(0); PG8_MMA(0, 0, At, B0); PG8_BAR; PG8_SCHED;
            PG8_LDB(B1, 1, 1); PG8_STAGE(PG8_SB(1, 0), b3, voffB);
            PG8_BAR; PG8_WAIT_L(0); PG8_MMA(0, 1, At, B1); PG8_BAR;
            PG8_LDA(At, 1, 1); PG8_STAGE(PG8_SA(1, 0), a3, voffA);
            PG8_BAR; PG8_WAIT_L(0); PG8_MMA(1, 0, At, B0); PG8_BAR; PG8_SCHED;
            PG8_STAGE(PG8_SB(1, 1), b3 + hstep, voffB);
            PG8_WAIT_V(6); PG8_BAR; PG8_MMA(1, 1, At, B1); PG8_BAR;
        }
        PG8_STAMP();
        if constexpr (!Epi::AFTER_DRAIN) { E(acc, cur, wr, wc, fr, fq); S.done(cur); }
        PG8_STAMP();
        if (!has_next) break;
#pragma unroll
        for (int a = 0; a < 2; ++a)
#pragma unroll
            for (int b = 0; b < 2; ++b)
#pragma unroll
                for (int m = 0; m < 4; ++m)
#pragma unroll
                    for (int n = 0; n < 2; ++n) acc[a][b][m][n] = (f32x4){0.f, 0.f, 0.f, 0.f};
        cur = nxt; cA = nA; cB = nB; ++ui;
    }
    PG8_WAIT_V(0);
    if (wr == 0) PG8_BAR;
    PG8_BAR;
    if constexpr (Epi::AFTER_DRAIN) { E.fused(acc, cur, wr, wc, fr, fq, lds, wid, lane); S.done(cur); }
    PG8_STAMP();
    if (STAMP && wid == 0) { stamps[lane] = lane < nts ? (((unsigned long long)(unsigned)ts_hi << 32) | (unsigned)ts_lo) : 0ull;
        if (lane == 62) stamps[62] = rt_entry; if (lane == 63) stamps[63] = (unsigned long long)wall_clock64(); }
#undef PG8_STAMP
#undef PG8_SA
#undef PG8_SB
#undef PG8_STAGE
#undef PG8_LDA
#undef PG8_LDB
#undef PG8_MMA
#undef PG8_WAIT_V
#undef PG8_WAIT_L
#undef PG8_BAR
#undef PG8_SCHED
}
}

#define LAS __attribute__((address_space(3)))
typedef unsigned short bf16_t;
typedef short bf16x8 __attribute__((ext_vector_type(8)));
typedef short s16x4 __attribute__((ext_vector_type(4)));
typedef float f32x4 __attribute__((ext_vector_type(4)));
typedef float f32x16 __attribute__((ext_vector_type(16)));
typedef unsigned u32x4 __attribute__((ext_vector_type(4)));
typedef unsigned u32x2 __attribute__((ext_vector_type(2)));
typedef __bf16 bf16x2_t __attribute__((ext_vector_type(2)));
typedef float f32x2_t __attribute__((ext_vector_type(2)));

__device__ __forceinline__ int otid() { int t = threadIdx.x; asm volatile("" : "+v"(t)); return t; }
__device__ __forceinline__ int obid() { int t = blockIdx.x; asm volatile("" : "+s"(t)); return t; }
__device__ __forceinline__ int ogdim() { int t = gridDim.x; asm volatile("" : "+s"(t)); return t; }
constexpr int NB = 8, SEQ = 4096, DM = 1024, MTOK = NB * SEQ;
constexpr int FH = 2816;
constexpr int NSA_IN = 2608, NSA_NP = 2816;
constexpr size_t KVSZ = (size_t)32 * 4096 * 64;
constexpr int LDS_BYTES = 131072;

__device__ __forceinline__ unsigned pk_bf16(float a, float b) { f32x2_t v = {a, b}; bf16x2_t r = __builtin_convertvector(v, bf16x2_t); return __builtin_bit_cast(unsigned, r); }
__device__ __forceinline__ bf16_t f2bf(float a) { return (bf16_t)(pk_bf16(a, 0.f) & 0xffffu); }
__device__ __forceinline__ float bf2f(unsigned short x) { return __uint_as_float(((unsigned)x) << 16); }
__device__ __forceinline__ float gelu_tanh(float x) { const float y = 0.7978845608f * (x + 0.044715f * x * x * x); return x / (1.0f + __expf(-2.0f * y)); }
__device__ __forceinline__ float silu_f(float x) { return x / (1.0f + __expf(-x)); }
__device__ __forceinline__ float sigmoid_f(float x) { return 1.0f / (1.0f + __expf(-x)); }

constexpr size_t al256(size_t x) { return (x + 255) & ~(size_t)255; }
constexpr size_t WS_WGU = 0;
constexpr size_t WS_WDN = WS_WGU + (size_t)4 * 5632 * 1024 * 2;
constexpr size_t WS_NWIN = WS_WDN + (size_t)4 * 1024 * 2816 * 2;
constexpr size_t WS_NWOUT = WS_NWIN + (size_t)2 * NSA_NP * 1024 * 2;
constexpr size_t WS_CW1 = WS_NWOUT + (size_t)2 * 1024 * 1024 * 2;
constexpr size_t WS_SWIN = WS_CW1 + (size_t)2 * 512 * 2048 * 2;
constexpr size_t WS_SWOUT = WS_SWIN + (size_t)2048 * 1024 * 2;
constexpr size_t WS_SWS = WS_SWOUT + (size_t)1024 * 1024 * 2;
constexpr size_t WS_PWIN = WS_SWS + (size_t)8 * 128 * 128 * 2;
constexpr size_t WS_PGRP = WS_PWIN + (size_t)1024 * 1024 * 2;
constexpr size_t WS_PWOUT = WS_PGRP + (size_t)1024 * 1024 * 2;
constexpr size_t WS_CBIAS = WS_PWOUT + (size_t)1024 * 1024 * 2;
constexpr size_t WS_CS = WS_CBIAS + 4096;
constexpr size_t WS_GATES = WS_CS + (size_t)MTOK * 16 * 4;
constexpr size_t WS_CH = WS_GATES + (size_t)MTOK * 48 * 4;
constexpr size_t WS_KCMP = WS_CH + (size_t)16384 * 256 * 2;
constexpr size_t WS_VCMPT = WS_KCMP + (size_t)32 * 256 * 64 * 2;
constexpr size_t WS_H = WS_VCMPT + (size_t)32 * 64 * 256 * 2;
constexpr size_t WS_BIG = WS_H + (size_t)MTOK * 1024 * 2;
constexpr size_t WS_TBL = WS_BIG + (size_t)MTOK * 2816 * 2 + 65536;
constexpr size_t WS_END = WS_TBL + 4096;

struct Params {
    const float* x; const int* positions; const float* mix_norm; const float* ffn_norm; const float* final_norm;
    const float* nsa_w_in; const float* nsa_cmp_pos_k; const float* nsa_cmp_k_w1; const float* nsa_cmp_k_w2;
    const float* nsa_cmp_pos_v; const float* nsa_cmp_v_w1; const float* nsa_cmp_v_w2; const float* nsa_w_out;
    const float* sgu_w_in; const float* sgu_ln_g; const float* sgu_ln_b; const float* sgu_w_s; const float* sgu_b_s; const float* sgu_w_out;
    const float* pool_w_in; const float* pool_w_grp; const float* pool_scale; const float* pool_w_out;
    const float* ffn_w_gate_up; const float* ffn_w_down;
    float* out; unsigned char* ws;
};

struct EpiResid {
    static constexpr bool PERM = false, AFTER_DRAIN = false;
    const float* base; float* out;
    __device__ __forceinline__ void operator()(const f32x4 (&acc)[2][2][4][2], const pg8::Unit& u, int wr, int wc, int fr, int fq) const {
        const int row0 = u.pm * 256 + wr * 64 + fr, col0 = u.pn * 256 + wc * 32 + 4 * fq;
#pragma unroll
        for (int ai = 0; ai < 2; ++ai)
#pragma unroll
            for (int m = 0; m < 4; ++m) {
                const size_t off = (size_t)(row0 + ai * 128 + m * 16) * 1024 + col0;
#pragma unroll
                for (int bj = 0; bj < 2; ++bj)
#pragma unroll
                    for (int n = 0; n < 2; ++n) { const size_t o = off + bj * 128 + n * 16; *(f32x4*)(out + o) = *(const f32x4*)(base + o) + acc[ai][bj][m][n]; }
            }
    }
};
struct EpiF32 {
    static constexpr bool PERM = false, AFTER_DRAIN = false;
    float* C;
    __device__ __forceinline__ void operator()(const f32x4 (&acc)[2][2][4][2], const pg8::Unit& u, int wr, int wc, int fr, int fq) const {
        const int row0 = u.pm * 256 + wr * 64 + fr, col0 = u.pn * 256 + wc * 32 + 4 * fq;
#pragma unroll
        for (int ai = 0; ai < 2; ++ai)
#pragma unroll
            for (int m = 0; m < 4; ++m) {
                const size_t off = (size_t)(row0 + ai * 128 + m * 16) * 1024 + col0;
#pragma unroll
                for (int bj = 0; bj < 2; ++bj)
#pragma unroll
                    for (int n = 0; n < 2; ++n) *(f32x4*)(C + off + bj * 128 + n * 16) = acc[ai][bj][m][n];
            }
    }
};
struct EpiGU {
    static constexpr bool PERM = true, AFTER_DRAIN = false;
    bf16_t* HID;
    __device__ __forceinline__ void operator()(const f32x4 (&acc)[2][2][4][2], const pg8::Unit& u, int wr, int wc, int fr, int fq) const {
        const int row0 = u.pm * 256 + wr * 64 + fr, col0 = u.pn * 128 + wc * 32 + 8 * fq;
#pragma unroll
        for (int ai = 0; ai < 2; ++ai)
#pragma unroll
            for (int m = 0; m < 4; ++m) {
                const f32x4 g0 = acc[ai][0][m][0], g1 = acc[ai][0][m][1], u0 = acc[ai][1][m][0], u1 = acc[ai][1][m][1];
                u32x4 w;
                w.x = pk_bf16(silu_f(g0[0]) * u0[0], silu_f(g0[1]) * u0[1]); w.y = pk_bf16(silu_f(g0[2]) * u0[2], silu_f(g0[3]) * u0[3]);
                w.z = pk_bf16(silu_f(g1[0]) * u1[0], silu_f(g1[1]) * u1[1]); w.w = pk_bf16(silu_f(g1[2]) * u1[2], silu_f(g1[3]) * u1[3]);
                *(u32x4*)(HID + (size_t)(row0 + ai * 128 + m * 16) * FH + col0) = w;
            }
    }
};
template <int MODE> struct EpiBf16 {
    static constexpr bool PERM = true, AFTER_DRAIN = false;
    bf16_t* O; int ldc; const float* aux;
    __device__ __forceinline__ void operator()(const f32x4 (&acc)[2][2][4][2], const pg8::Unit& u, int wr, int wc, int fr, int fq) const {
        const int row0 = u.pm * 256 + wr * 64 + fr; const int ct = wc * 32 + 8 * fq;
        const int colbase = (MODE == 2) ? 0 : u.pn * 256;
        f32x4 av[2][2];
#pragma unroll
        for (int bj = 0; bj < 2; ++bj)
#pragma unroll
            for (int n = 0; n < 2; ++n) av[bj][n] = (MODE == 0) ? (f32x4){0.f, 0.f, 0.f, 0.f} : *(const f32x4*)(aux + u.pn * 256 + ct + bj * 128 + 4 * n);
#pragma unroll
        for (int ai = 0; ai < 2; ++ai)
#pragma unroll
            for (int m = 0; m < 4; ++m) {
                bf16_t* rowp = O + (size_t)(row0 + ai * 128 + m * 16) * ldc + colbase + ct;
#pragma unroll
                for (int bj = 0; bj < 2; ++bj) {
                    f32x4 v0 = acc[ai][bj][m][0], v1 = acc[ai][bj][m][1];
                    if (MODE == 1) { v0 = v0 * av[bj][0]; v1 = v1 * av[bj][1]; }
                    if (MODE == 2) { v0 = v0 + av[bj][0]; v1 = v1 + av[bj][1]; }
                    if (MODE != 1) {
#pragma unroll
                        for (int j = 0; j < 4; ++j) { v0[j] = gelu_tanh(v0[j]); v1[j] = gelu_tanh(v1[j]); }
                    }
                    u32x4 w; w.x = pk_bf16(v0[0], v0[1]); w.y = pk_bf16(v0[2], v0[3]); w.z = pk_bf16(v1[0], v1[1]); w.w = pk_bf16(v1[2], v1[3]);
                    *(u32x4*)(rowp + bj * 128) = w;
                }
            }
    }
};
struct EpiNsaIn {
    static constexpr bool PERM = true, AFTER_DRAIN = false;
    bf16_t* Q; bf16_t* KV; float* gates; const float* cs;
    template <int VAR> __device__ __forceinline__ void variant(const f32x4 (&acc)[2][2][4][2], const pg8::Unit& u, int wr, int wc, int fr, int fq) const {
        const int pn = u.pn; const int jkv = pn - 4;
        const int row0 = u.pm * 256 + wr * 64 + fr;
        const bool rope_w = (VAR <= 1) && ((wc & 1) == 0);
#pragma unroll
        for (int ai = 0; ai < 2; ++ai)
#pragma unroll
            for (int m = 0; m < 4; ++m) {
                const int row = row0 + ai * 128 + m * 16; const int b = row >> 12, s = row & 4095;
#pragma unroll
                for (int bj = 0; bj < 2; ++bj) {
                    const int cb = bj * 128 + wc * 32 + fq * 8;
                    f32x4 v0 = acc[ai][bj][m][0], v1 = acc[ai][bj][m][1];
                    if (rope_w) {
                        f32x4 p0, p1;
#pragma unroll
                        for (int j = 0; j < 4; ++j) { p0[j] = __shfl_xor(v0[j], 16); p1[j] = __shfl_xor(v1[j], 16); }
                        if (fq < 2) {
                            const f32x4* c4 = (const f32x4*)(cs + (size_t)row * 16);
                            const f32x4 cA = c4[0], cB = c4[1], sA = c4[2], sB = c4[3];
                            if (fq == 0) { v0 = v0 * cA - p0 * sA; v1 = v1 * cB - p1 * sB; }
                            else { v0 = v0 * cA + p0 * sA; v1 = v1 * cB + p1 * sB; }
                        }
                    }
                    const int hh = cb >> 6, d0 = cb & 63;
                    if (VAR == 0) {
                        v0 = v0 * 0.125f; v1 = v1 * 0.125f;
                        u32x4 w; w.x = pk_bf16(v0[0], v0[1]); w.y = pk_bf16(v0[2], v0[3]); w.z = pk_bf16(v1[0], v1[1]); w.w = pk_bf16(v1[2], v1[3]);
                        *(u32x4*)(Q + ((size_t)(b * 16 + pn * 4 + hh) * 4096 + s) * 64 + d0) = w;
                    } else if (VAR == 1 || VAR == 2) {
                        u32x4 w; w.x = pk_bf16(v0[0], v0[1]); w.y = pk_bf16(v0[2], v0[3]); w.z = pk_bf16(v1[0], v1[1]); w.w = pk_bf16(v1[2], v1[3]);
                        *(u32x4*)(KV + (size_t)jkv * KVSZ + ((size_t)(b * 4 + hh) * 4096 + s) * 64 + d0) = w;
                    } else if (VAR == 3) {
                        bf16_t* tp = KV + (size_t)jkv * KVSZ + ((size_t)(b * 4 + hh) * 64 + d0) * 4096 + s;
#pragma unroll
                        for (int j = 0; j < 4; ++j) { tp[(size_t)j * 4096] = f2bf(v0[j]); tp[(size_t)(j + 4) * 4096] = f2bf(v1[j]); }
                    } else if (cb < 48) {
                        f32x4 g0, g1;
#pragma unroll
                        for (int j = 0; j < 4; ++j) { g0[j] = sigmoid_f(v0[j]); g1[j] = sigmoid_f(v1[j]); }
                        float* gp = gates + (size_t)row * 48 + cb;
                        *(f32x4*)gp = g0; *(f32x4*)(gp + 4) = g1;
                    }
                }
            }
    }
    __device__ __forceinline__ void operator()(const f32x4 (&acc)[2][2][4][2], const pg8::Unit& u, int wr_, int wc_, int fr_, int fq_) const {
        const int pn = u.pn;
        const int t_ = otid(); const int wid_ = __builtin_amdgcn_readfirstlane(t_ >> 6); const int wr = wid_ >> 2, wc = wid_ & 3, fr = t_ & 15, fq = (t_ & 63) >> 4;
        (void)wr_; (void)wc_; (void)fr_; (void)fq_;
        if (pn < 4) variant<0>(acc, u, wr, wc, fr, fq);
        else if (pn == 4 || pn == 6 || pn == 8) variant<1>(acc, u, wr, wc, fr, fq);
        else if (pn == 5) variant<2>(acc, u, wr, wc, fr, fq);
        else if (pn == 7 || pn == 9) variant<3>(acc, u, wr, wc, fr, fq);
        else variant<4>(acc, u, wr, wc, fr, fq);
    }
};
struct CmpOrder {
    int G, c;
    __device__ bool next(int i, pg8::Unit& u) const { const int L = i * G + c; if (L >= 64) return false; u.pm = L; u.pn = L >> 5; return true; }
    __device__ __forceinline__ void a_ready(const pg8::Unit&) const {}
    __device__ __forceinline__ void done(const pg8::Unit&) const {}
};

template <class Epi> __device__ __forceinline__ void run_gemm(LAS unsigned char* lds, const bf16_t* A, int lda, const bf16_t* Bt, int M, int N, int K, const Epi& E) {
    pg8::Gemm g; g.A = A; g.Bt = Bt; g.M = M; g.N = N; g.K = K; g.lda = lda;
    pg8::StaticOrder S; S.init(M, N, ogdim(), obid());
    pg8::gemm_phase<Epi, pg8::StaticOrder, false>(lds, g, S, E, nullptr);
}

struct TJob { const float* src; bf16_t* dst; int K, Nsrc, Ndst, mode, tiles; };
__device__ __forceinline__ int job_colmap(int mode, int n) {
    if (mode == 0) return n;
    if (mode == 1) { const int t = n >> 8, r = n & 255; return (r < 128) ? (t * 128 + r) : (FH + t * 128 + (r - 128)); }
    return (n < NSA_IN) ? n : -1;
}
__device__ void transpose_tile(LAS float* tile, const TJob& J, int t) {
    const int tid = otid(), tx = tid & 63, ty = tid >> 6;
    const int nkt = J.K >> 6; const int tn = t / nkt, tk = t - tn * nkt; const int n0 = tn * 64, k0 = tk * 64;
    const int sc = job_colmap(J.mode, n0 + tx);
#pragma unroll
    for (int i = 0; i < 8; ++i) { const int k = k0 + ty + 8 * i; tile[(ty + 8 * i) * 65 + tx] = (sc >= 0) ? J.src[(size_t)k * J.Nsrc + sc] : 0.f; }
    __syncthreads();
#pragma unroll
    for (int i = 0; i < 8; ++i) { const int n = n0 + ty + 8 * i; J.dst[(size_t)n * J.K + k0 + tx] = f2bf(tile[tx * 65 + ty + 8 * i]); }
    __syncthreads();
}
__device__ __forceinline__ void get_job(const Params& P, unsigned char* ws, int j, TJob& J) {
        if (j < 4) { J.src = P.ffn_w_gate_up + (size_t)j * 1024 * 5632; J.dst = (bf16_t*)(ws + WS_WGU) + (size_t)j * 5632 * 1024; J.K = 1024; J.Nsrc = 5632; J.Ndst = 5632; J.mode = 1; }
        else if (j < 8) { const int l = j - 4; J.src = P.ffn_w_down + (size_t)l * 2816 * 1024; J.dst = (bf16_t*)(ws + WS_WDN) + (size_t)l * 1024 * 2816; J.K = 2816; J.Nsrc = 1024; J.Ndst = 1024; J.mode = 0; }
        else if (j < 10) { const int l = j - 8; J.src = P.nsa_w_in + (size_t)l * 1024 * NSA_IN; J.dst = (bf16_t*)(ws + WS_NWIN) + (size_t)l * NSA_NP * 1024; J.K = 1024; J.Nsrc = NSA_IN; J.Ndst = NSA_NP; J.mode = 2; }
        else if (j < 12) { const int l = j - 10; J.src = P.nsa_w_out + (size_t)l * 1024 * 1024; J.dst = (bf16_t*)(ws + WS_NWOUT) + (size_t)l * 1024 * 1024; J.K = 1024; J.Nsrc = 1024; J.Ndst = 1024; J.mode = 0; }
        else if (j < 14) { const int l = j - 12; J.src = P.nsa_cmp_k_w1 + (size_t)l * 2048 * 256; J.dst = (bf16_t*)(ws + WS_CW1) + (size_t)l * 512 * 2048; J.K = 2048; J.Nsrc = 256; J.Ndst = 256; J.mode = 0; }
        else if (j < 16) { const int l = j - 14; J.src = P.nsa_cmp_v_w1 + (size_t)l * 2048 * 256; J.dst = (bf16_t*)(ws + WS_CW1) + (size_t)l * 512 * 2048 + (size_t)256 * 2048; J.K = 2048; J.Nsrc = 256; J.Ndst = 256; J.mode = 0; }
        else if (j == 16) { J.src = P.sgu_w_in; J.dst = (bf16_t*)(ws + WS_SWIN); J.K = 1024; J.Nsrc = 2048; J.Ndst = 2048; J.mode = 0; }
        else if (j == 17) { J.src = P.sgu_w_out; J.dst = (bf16_t*)(ws + WS_SWOUT); J.K = 1024; J.Nsrc = 1024; J.Ndst = 1024; J.mode = 0; }
        else if (j == 18) { J.src = P.pool_w_in; J.dst = (bf16_t*)(ws + WS_PWIN); J.K = 1024; J.Nsrc = 1024; J.Ndst = 1024; J.mode = 0; }
        else { J.src = P.pool_w_out; J.dst = (bf16_t*)(ws + WS_PWOUT); J.K = 1024; J.Nsrc = 1024; J.Ndst = 1024; J.mode = 0; }
        J.tiles = (J.Ndst >> 6) * (J.K >> 6);
    }
__device__ void prologue_phase(const Params& P, LAS unsigned char* lds) {
    unsigned char* ws = P.ws;
    const int tid = otid();
    constexpr int NJ = 22;
    int total = 0;
    (void)NJ; (void)total;
    {
        int base = 0;
        for (int j = 0; j < 20; ++j) {
            TJob J; get_job(P, ws, j, J);
            int first = (obid() - base % ogdim() + ogdim()) % ogdim();
            for (int t = first; t < J.tiles; t += ogdim()) transpose_tile((LAS float*)lds, J, t);
            base += J.tiles;
        }
    }
    const size_t gtid = (size_t)obid() * 512 + tid, gsz = (size_t)ogdim() * 512;
    {
        bf16_t* dst = (bf16_t*)(ws + WS_PGRP);
        for (size_t i = gtid; i < (size_t)1024 * 1024; i += gsz) {
            const int n = (int)(i >> 10), k = (int)(i & 1023); const int g = n >> 8;
            float v = 0.f; if ((k >> 8) == g) v = P.pool_w_grp[((size_t)g * 256 + (k & 255)) * 256 + (n & 255)];
            dst[i] = f2bf(v);
        }
    }
    {
        bf16_t* dst = (bf16_t*)(ws + WS_SWS);
        for (size_t i = gtid; i < (size_t)8 * 128 * 128; i += gsz) { const int t = (int)((i >> 7) & 127), s = (int)(i & 127); dst[i] = f2bf(s <= t ? P.sgu_w_s[i] : 0.f); }
    }
    {
        float* cs = (float*)(ws + WS_CS);
        for (size_t i = gtid; i < (size_t)MTOK * 8; i += gsz) {
            const int row = (int)(i >> 3), f = (int)(i & 7);
            const float inv = (float)pow(500000.0, -(double)(2 * f) / 16.0);
            const float ang = (float)P.positions[row] * inv;
            float sv, cv; sincosf(ang, &sv, &cv);
            cs[(size_t)row * 16 + f] = cv; cs[(size_t)row * 16 + 8 + f] = sv;
        }
    }
    if (obid() < 4) {
        const int l = obid() >> 1, kv = obid() & 1;
        const float* pos = (kv ? P.nsa_cmp_pos_v : P.nsa_cmp_pos_k) + (size_t)l * 2048;
        const float* w1 = (kv ? P.nsa_cmp_v_w1 : P.nsa_cmp_k_w1) + (size_t)l * 2048 * 256;
        const int c = tid & 255, hf = tid >> 8;
        float a = 0.f;
        for (int r = hf * 1024; r < hf * 1024 + 1024; ++r) a += pos[r] * w1[(size_t)r * 256 + c];
        LAS float* red = (LAS float*)lds;
        __syncthreads();
        if (hf == 1) red[c] = a;
        __syncthreads();
        if (hf == 0) ((float*)(ws + WS_CBIAS))[l * 512 + kv * 256 + c] = a + red[c];
        __syncthreads();
    }
}

__device__ void rmsnorm_phase(const float* X, const float* g, bf16_t* H, float* outf) {
    const int lane = otid() & 63; const int gw = obid() * 8 + (otid() >> 6), nw = ogdim() * 8;
    f32x4 gv[4];
#pragma unroll
    for (int i = 0; i < 4; ++i) gv[i] = ((const f32x4*)g)[lane + 64 * i];
    for (int row = gw; row < MTOK; row += nw) {
        const f32x4* xr = (const f32x4*)(X + (size_t)row * 1024);
        f32x4 v[4]; float ss = 0.f;
#pragma unroll
        for (int i = 0; i < 4; ++i) { v[i] = xr[lane + 64 * i]; ss += v[i][0] * v[i][0] + v[i][1] * v[i][1] + v[i][2] * v[i][2] + v[i][3] * v[i][3]; }
#pragma unroll
        for (int o = 32; o >= 1; o >>= 1) ss += __shfl_xor(ss, o);
        const float rstd = rsqrtf(ss * (1.0f / 1024.0f) + 1e-6f);
        if (outf) {
#pragma unroll
            for (int i = 0; i < 4; ++i) ((f32x4*)(outf + (size_t)row * 1024))[lane + 64 * i] = v[i] * rstd * gv[i];
        } else {
#pragma unroll
            for (int i = 0; i < 4; ++i) { const f32x4 y = v[i] * rstd * gv[i]; u32x2 w; w.x = pk_bf16(y[0], y[1]); w.y = pk_bf16(y[2], y[3]); ((u32x2*)(H + (size_t)row * 1024))[lane + 64 * i] = w; }
        }
    }
}

__device__ void cmp2_phase(const bf16_t* CH, const float* w2k, const float* w2v, bf16_t* KCMP, bf16_t* VCMPT, LAS unsigned char* lds) {
    LAS float* w2s = (LAS float*)lds;
    const int tid = otid(), d = tid & 63, rr = tid >> 6;
    for (int type = 0; type < 2; ++type) {
        const float* w2 = type ? w2v : w2k;
        __syncthreads();
        for (int i = tid; i < 256 * 64; i += 512) w2s[i] = w2[i];
        __syncthreads();
        for (int rg = obid(); rg < 1024; rg += ogdim()) {
            const int Rl = rg * 8 + rr;
            const u32x4* hp = (const u32x4*)(CH + ((size_t)type * 8192 + Rl) * 256);
            float a = 0.f;
#pragma unroll 2
            for (int c8 = 0; c8 < 32; ++c8) {
                const u32x4 hv = hp[c8];
#pragma unroll
                for (int j = 0; j < 4; ++j) {
                    const unsigned wv = hv[j];
                    a += __uint_as_float(wv << 16) * w2s[(c8 * 8 + 2 * j) * 64 + d];
                    a += __uint_as_float(wv & 0xffff0000u) * w2s[(c8 * 8 + 2 * j + 1) * 64 + d];
                }
            }
            if (type == 0) KCMP[(size_t)Rl * 64 + d] = f2bf(a);
            else { const int bg = Rl >> 8, n = Rl & 255; VCMPT[((size_t)bg * 64 + d) * 256 + n] = f2bf(a); }
        }
    }
    __syncthreads();
}

#define MFMA32(a, b, c) __builtin_amdgcn_mfma_f32_32x32x16_bf16((a), (b), (c), 0, 0, 0)
__device__ __forceinline__ int crow16(int i, int h) { return (i & 3) + 8 * (i >> 2) + 4 * h; }
__device__ __forceinline__ f32x16 zero16() { f32x16 z; for (int i = 0; i < 16; ++i) z[i] = 0.f; return z; }

__device__ __forceinline__ void qk_tile(const bf16_t* Kt  , const bf16x8 (&Qf)[4], f32x16 (&ST)[2], int r, int h) {
#pragma unroll
    for (int kb = 0; kb < 2; ++kb) {
        f32x16 a = zero16();
#pragma unroll
        for (int s = 0; s < 4; ++s) { const bf16x8 kf = *(const bf16x8*)(Kt + (size_t)(32 * kb + r) * 64 + 16 * s + 8 * h); a = MFMA32(kf, Qf[s], a); }
        ST[kb] = a;
    }
}
__device__ __forceinline__ bf16x8 pack8(const f32x16& x, int s2) {
    u32x4 p; p.x = pk_bf16(x[8 * s2 + 0], x[8 * s2 + 1]); p.y = pk_bf16(x[8 * s2 + 2], x[8 * s2 + 3]); p.z = pk_bf16(x[8 * s2 + 4], x[8 * s2 + 5]); p.w = pk_bf16(x[8 * s2 + 6], x[8 * s2 + 7]);
    return __builtin_bit_cast(bf16x8, p);
}
__device__ __forceinline__ void pv_tile(const bf16_t* Vt  , int ldv, const f32x16 (&Pm)[2], f32x16 (&O)[2], int r, int h) {
#pragma unroll
    for (int kb = 0; kb < 2; ++kb)
#pragma unroll
        for (int s2 = 0; s2 < 2; ++s2) {
            const bf16x8 pf = pack8(Pm[kb], s2);
#pragma unroll
            for (int db = 0; db < 2; ++db) {
                const bf16_t* vp = Vt + (size_t)(32 * db + r) * ldv + 32 * kb + 16 * s2 + 4 * h;
                const s16x4 lo = *(const s16x4*)vp, hi = *(const s16x4*)(vp + 8);
                const bf16x8 vf = __builtin_shufflevector(lo, hi, 0, 1, 2, 3, 4, 5, 6, 7);
                O[db] = MFMA32(vf, pf, O[db]);
            }
        }
}
__device__ __forceinline__ void softmax_step(f32x16 (&ST)[2], unsigned vm, float& m_run, float& l_run, f32x16 (&O)[2]) {
    float mx = -1e30f;
#pragma unroll
    for (int kb = 0; kb < 2; ++kb)
#pragma unroll
        for (int i = 0; i < 16; ++i) { const bool v = (vm >> (16 * kb + i)) & 1u; mx = fmaxf(mx, v ? ST[kb][i] : -1e30f); }
    mx = fmaxf(mx, __shfl_xor(mx, 32));
    const float m_new = fmaxf(m_run, mx);
    const float alpha = __expf(m_run - m_new);
    float rs = 0.f;
#pragma unroll
    for (int kb = 0; kb < 2; ++kb)
#pragma unroll
        for (int i = 0; i < 16; ++i) { const bool v = (vm >> (16 * kb + i)) & 1u; const float p = v ? __expf(ST[kb][i] - m_new) : 0.f; ST[kb][i] = p; rs += p; }
    rs += __shfl_xor(rs, 32);
    l_run = l_run * alpha + rs; m_run = m_new;
#pragma unroll
    for (int db = 0; db < 2; ++db) O[db] = O[db] * alpha;
}

__device__ void nsa_attn_phase(const bf16_t* Q, const bf16_t* KV, const bf16_t* KCMP, const bf16_t* VCMPT, const float* gates, bf16_t* AO, LAS unsigned char* lds) {
    const int tid = otid(), wid = tid >> 6, lane = tid & 63, r = lane & 31, h = lane >> 5;
    LAS float* psw = (LAS float*)lds + wid * 2048;
    LAS unsigned long long* selw = (LAS unsigned long long*)(lds + 65536) + wid * 8;
    const int G = ogdim();
    for (int idx = obid(); idx < 2048; idx += G) {
        const int vb = idx & 255, jj = idx >> 8;
        const int xcd = vb & 7, slot = vb >> 3;
        const int bg = xcd * 4 + (slot >> 3), kq = slot & 7;
        const int qb = (jj & 1) ? (16 * (jj >> 1) + 15 - kq) : (16 * (jj >> 1) + kq);
        const int b = bg >> 2, g = bg & 3;
        const int head = g * 4 + (r >> 3);
        const int tok = wid * 8 + (r & 7);
        const int t = qb * 64 + tok;
        const size_t rowg = (size_t)b * 4096 + t;
        bf16x8 Qf[4];
        { const bf16_t* qp = Q + ((size_t)(b * 16 + head) * 4096 + t) * 64 + 8 * h;
#pragma unroll
          for (int s = 0; s < 4; ++s) Qf[s] = *(const bf16x8*)(qp + 16 * s); }
        f32x16 OUT[2];

        __syncthreads();
#pragma unroll
        for (int i = 0; i < 32; ++i) psw[lane + 64 * i] = 0.f;
        __syncthreads();

        {
            const bf16_t* Kc = KCMP + (size_t)bg * 256 * 64; const bf16_t* Vc = VCMPT + (size_t)bg * 64 * 256;
            int ntc = ((4 * qb + 2) >> 6) + 1; if (ntc > 4) ntc = 4;
            float m_run = -1e30f, l_run = 0.f;
            for (int T = 0; T < ntc; ++T) {
                f32x16 ST[2]; qk_tile(Kc + (size_t)T * 64 * 64, Qf, ST, r, h);
                float mx = -1e30f;
#pragma unroll
                for (int kb = 0; kb < 2; ++kb)
#pragma unroll
                    for (int i = 0; i < 16; ++i) { const int n = 64 * T + 32 * kb + crow16(i, h); const bool v = (16 * n + 31) <= t; mx = fmaxf(mx, v ? ST[kb][i] : -1e30f); }
                mx = fmaxf(mx, __shfl_xor(mx, 32));
                const float m_new = fmaxf(m_run, mx);
                float rs = 0.f;
#pragma unroll
                for (int kb = 0; kb < 2; ++kb)
#pragma unroll
                    for (int i = 0; i < 16; ++i) { const int n = 64 * T + 32 * kb + crow16(i, h); const bool v = (16 * n + 31) <= t; rs += v ? __expf(ST[kb][i] - m_new) : 0.f; }
                rs += __shfl_xor(rs, 32);
                l_run = l_run * __expf(m_run - m_new) + rs; m_run = m_new;
            }
            const float inv_l = l_run > 0.f ? 1.0f / l_run : 0.f;
            f32x16 O[2]; O[0] = zero16(); O[1] = zero16();
            for (int T = 0; T < ntc; ++T) {
                f32x16 ST[2]; qk_tile(Kc + (size_t)T * 64 * 64, Qf, ST, r, h);
#pragma unroll
                for (int kb = 0; kb < 2; ++kb)
#pragma unroll
                    for (int i = 0; i < 16; ++i) {
                        const int n = 64 * T + 32 * kb + crow16(i, h); const bool v = (16 * n + 31) <= t;
                        const float p = v ? __expf(ST[kb][i] - m_run) * inv_l : 0.f; ST[kb][i] = p;
                        float ps = p; ps += __shfl_xor(ps, 8); ps += __shfl_xor(ps, 16);
                        if (r < 8) psw[r * 256 + n] = ps;
                    }
                pv_tile(Vc + (size_t)T * 64, 256, ST, O, r, h);
            }
            const float g_c = gates[rowg * 48 + head];
#pragma unroll
            for (int db = 0; db < 2; ++db) OUT[db] = O[db] * g_c;
        }
        __syncthreads();
        for (int tk = 0; tk < 8; ++tk) {
            const int mblk = lane;
            float imp = 0.f;
#pragma unroll
            for (int j = -1; j <= 3; ++j) { const int n = 4 * mblk + j; if (n >= 0) imp += psw[tk * 256 + n]; }
            if (mblk == 0 || mblk == qb || mblk == qb - 1) imp = 1e9f;
            if (mblk > qb) imp = -1e30f;
            int rank = 0;
            for (int mp = 0; mp < 64; ++mp) { const float o = __shfl(imp, mp); rank += (o > imp || (o == imp && mp < mblk)) ? 1 : 0; }
            unsigned long long msk = __ballot(rank < 16);
            msk &= (qb >= 63) ? ~0ull : ((2ull << qb) - 1ull);
            if (lane == 0) selw[tk] = msk;
        }
        __syncthreads();
        const unsigned long long mysel = selw[r & 7];
#pragma unroll
        for (int db = 0; db < 2; ++db)
#pragma unroll
            for (int i = 0; i < 16; ++i) psw[(db * 16 + i) * 64 + lane] = OUT[db][i];
        {
            const bf16_t* Ks = KV + 2 * KVSZ + (size_t)bg * 4096 * 64; const bf16_t* Vs = KV + 3 * KVSZ + (size_t)bg * 64 * 4096;
            float m_run = -1e30f, l_run = 0.f; f32x16 O[2]; O[0] = zero16(); O[1] = zero16();
            for (int kt = 0; kt <= qb; ++kt) {
                f32x16 ST[2]; qk_tile(Ks + (size_t)kt * 64 * 64, Qf, ST, r, h);
                const bool selb = (mysel >> kt) & 1ull;
                unsigned vm = 0u;
#pragma unroll
                for (int kb = 0; kb < 2; ++kb)
#pragma unroll
                    for (int i = 0; i < 16; ++i) { const int kp = 64 * kt + 32 * kb + crow16(i, h); if (selb && kp <= t) vm |= 1u << (16 * kb + i); }
                softmax_step(ST, vm, m_run, l_run, O);
                pv_tile(Vs + (size_t)kt * 64, 4096, ST, O, r, h);
            }
            const float sc = (l_run > 0.f ? 1.0f / l_run : 0.f) * gates[rowg * 48 + 16 + head];
#pragma unroll
            for (int db = 0; db < 2; ++db)
#pragma unroll
                for (int i = 0; i < 16; ++i) psw[(db * 16 + i) * 64 + lane] += O[db][i] * sc;
        }
        {
            const bf16_t* Kw = KV + 4 * KVSZ + (size_t)bg * 4096 * 64; const bf16_t* Vw = KV + 5 * KVSZ + (size_t)bg * 64 * 4096;
            float m_run = -1e30f, l_run = 0.f; f32x16 O[2]; O[0] = zero16(); O[1] = zero16();
            for (int kt = (qb > 8 ? qb - 8 : 0); kt <= qb; ++kt) {
                f32x16 ST[2]; qk_tile(Kw + (size_t)kt * 64 * 64, Qf, ST, r, h);
                unsigned vm = 0u;
#pragma unroll
                for (int kb = 0; kb < 2; ++kb)
#pragma unroll
                    for (int i = 0; i < 16; ++i) { const int kp = 64 * kt + 32 * kb + crow16(i, h); if (kp <= t && kp + 512 > t) vm |= 1u << (16 * kb + i); }
                softmax_step(ST, vm, m_run, l_run, O);
                pv_tile(Vw + (size_t)kt * 64, 4096, ST, O, r, h);
            }
            const float sc = (l_run > 0.f ? 1.0f / l_run : 0.f) * gates[rowg * 48 + 32 + head];
#pragma unroll
            for (int db = 0; db < 2; ++db)
#pragma unroll
                for (int i = 0; i < 16; ++i) OUT[db][i] = psw[(db * 16 + i) * 64 + lane] + O[db][i] * sc;
        }
        {
            bf16_t* op = AO + rowg * 1024 + head * 64;
#pragma unroll
            for (int db = 0; db < 2; ++db)
#pragma unroll
                for (int q4 = 0; q4 < 4; ++q4) {
                    u32x2 w; w.x = pk_bf16(OUT[db][4 * q4 + 0], OUT[db][4 * q4 + 1]); w.y = pk_bf16(OUT[db][4 * q4 + 2], OUT[db][4 * q4 + 3]);
                    *(u32x2*)(op + 32 * db + 8 * q4 + 4 * h) = w;
                }
        }
    }
    __syncthreads();
}

__device__ void sgu_spatial_phase(const bf16_t* UV, const float* lng, const float* lnb, const bf16_t* SWS, const float* bs, bf16_t* GATED, LAS unsigned char* lds) {
    constexpr int LDV = 136;
    LAS bf16_t* vnT = (LAS bf16_t*)lds;
    LAS float* mu = (LAS float*)(lds + 128 * LDV * 2); LAS float* rsd = mu + 128;
    const int tid = otid(), wid = tid >> 6, lane = tid & 63, r = lane & 31, h = lane >> 5;
    for (int cn = obid(); cn < 256; cn += ogdim()) {
        const size_t tok0 = (size_t)cn * 128;
        __syncthreads();
        for (int rr = 0; rr < 16; ++rr) {
            const int sl = wid * 16 + rr;
            const u32x4* vp = (const u32x4*)(UV + (tok0 + sl) * 2048 + 1024);
            float s1 = 0.f, s2 = 0.f;
#pragma unroll
            for (int i = 0; i < 2; ++i) { const u32x4 w = vp[lane + 64 * i];
#pragma unroll
                for (int j = 0; j < 4; ++j) { const float a = __uint_as_float(w[j] << 16), c = __uint_as_float(w[j] & 0xffff0000u); s1 += a + c; s2 += a * a + c * c; } }
#pragma unroll
            for (int o = 32; o >= 1; o >>= 1) { s1 += __shfl_xor(s1, o); s2 += __shfl_xor(s2, o); }
            const float mean = s1 * (1.0f / 1024.0f); const float var = fmaxf(s2 * (1.0f / 1024.0f) - mean * mean, 0.f);
            if (lane == 0) { mu[sl] = mean; rsd[sl] = rsqrtf(var + 1e-5f); }
        }
        __syncthreads();
        for (int g = 0; g < 8; ++g) {
            {
                const int sl = tid >> 2, cq = tid & 3;
                const float mean = mu[sl], rs = rsd[sl];
                const bf16_t* vp = UV + (tok0 + sl) * 2048 + 1024 + g * 128 + cq * 32;
#pragma unroll
                for (int i = 0; i < 4; ++i) {
                    const u32x4 w = *(const u32x4*)(vp + i * 8);
                    const int c0 = cq * 32 + i * 8;
                    const f32x4 ga = *(const f32x4*)(lng + g * 128 + c0), gb = *(const f32x4*)(lng + g * 128 + c0 + 4);
                    const f32x4 ba = *(const f32x4*)(lnb + g * 128 + c0), bb = *(const f32x4*)(lnb + g * 128 + c0 + 4);
#pragma unroll
                    for (int j = 0; j < 4; ++j) {
                        const float a = __uint_as_float(w[j] << 16), c = __uint_as_float(w[j] & 0xffff0000u);
                        const float gA = (2 * j < 4) ? ga[(2 * j) & 3] : gb[(2 * j) & 3], gB = (2 * j + 1 < 4) ? ga[(2 * j + 1) & 3] : gb[(2 * j + 1) & 3];
                        const float bA = (2 * j < 4) ? ba[(2 * j) & 3] : bb[(2 * j) & 3], bB = (2 * j + 1 < 4) ? ba[(2 * j + 1) & 3] : bb[(2 * j + 1) & 3];
                        vnT[(c0 + 2 * j) * LDV + sl] = f2bf((a - mean) * rs * gA + bA);
                        vnT[(c0 + 2 * j + 1) * LDV + sl] = f2bf((c - mean) * rs * gB + bB);
                    }
                }
            }
            __syncthreads();
            const int tb = wid & 3, ch = wid >> 2;
            f32x16 acc[2]; acc[0] = zero16(); acc[1] = zero16();
            const bf16_t* wsp = SWS + ((size_t)g * 128 + tb * 32 + r) * 128 + 8 * h;
            for (int ks = 0; ks <= 2 * tb + 1; ++ks) {
                const bf16x8 bfrag = *(const bf16x8*)(wsp + 16 * ks);
#pragma unroll
                for (int cb = 0; cb < 2; ++cb) {
                    const bf16x8 afrag = *(const LAS bf16x8*)(vnT + (ch * 64 + cb * 32 + r) * LDV + 16 * ks + 8 * h);
                    acc[cb] = MFMA32(afrag, bfrag, acc[cb]);
                }
            }
            const int tl = tb * 32 + r; const size_t token = tok0 + tl;
            const float bias = bs[g * 128 + tl];
#pragma unroll
            for (int cb = 0; cb < 2; ++cb)
#pragma unroll
                for (int q4 = 0; q4 < 4; ++q4) {
                    const int c0 = g * 128 + ch * 64 + cb * 32 + 8 * q4 + 4 * h;
                    const u32x2 uw = *(const u32x2*)(UV + token * 2048 + c0);
                    const float u0 = __uint_as_float(uw.x << 16), u1 = __uint_as_float(uw.x & 0xffff0000u), u2 = __uint_as_float(uw.y << 16), u3 = __uint_as_float(uw.y & 0xffff0000u);
                    u32x2 w; w.x = pk_bf16(u0 * (acc[cb][4 * q4 + 0] + bias), u1 * (acc[cb][4 * q4 + 1] + bias)); w.y = pk_bf16(u2 * (acc[cb][4 * q4 + 2] + bias), u3 * (acc[cb][4 * q4 + 3] + bias));
                    *(u32x2*)(GATED + token * 1024 + c0) = w;
                }
            __syncthreads();
        }
    }
    __syncthreads();
}

__device__ void pool_diff_phase(const float* Z, bf16_t* Dd) {
    const size_t gtid = (size_t)obid() * 512 + otid(), gsz = (size_t)ogdim() * 512;
    for (size_t idx = gtid; idx < (size_t)256 * 1024; idx += gsz) {
        const int c4 = (int)(idx & 255), seg = (int)(idx >> 8);
        const int t0 = seg * 32, s0 = t0 & 4095; const int w = 2 << (c4 >> 6);
        const f32x4* zp = (const f32x4*)Z + c4;
        f32x4 S = {0.f, 0.f, 0.f, 0.f};
        const int jlo = (s0 - w > 0) ? (s0 - w) : 0;
        for (int j = jlo; j < s0; ++j) S = S + zp[(size_t)(t0 - s0 + j) * 256];
        for (int i = 0; i < 32; ++i) {
            const int s = s0 + i; const f32x4 zt = zp[(size_t)(t0 + i) * 256];
            S = S + zt; if (s - w >= 0) S = S - zp[(size_t)(t0 + i - w) * 256];
            const float inv = 1.0f / (float)((s + 1 < w) ? (s + 1) : w);
            const f32x4 d = S * inv - zt;
            u32x2 o; o.x = pk_bf16(d[0], d[1]); o.y = pk_bf16(d[2], d[3]);
            *(u32x2*)(Dd + (size_t)(t0 + i) * 1024 + c4 * 4) = o;
        }
    }
}

constexpr int NPH = 34;
__constant__ unsigned char PROG[NPH][2] = {
    {0, 0},
    {1, 0}, {3, 0}, {4, 0}, {5, 0}, {6, 0}, {7, 0}, {2, 0}, {13, 0}, {14, 0},
    {1, 1}, {8, 1}, {9, 1}, {7, 1}, {2, 1}, {13, 1}, {14, 1},
    {1, 2}, {10, 2}, {11, 2}, {12, 2}, {7, 2}, {2, 2}, {13, 2}, {14, 2},
    {1, 3}, {3, 3}, {4, 3}, {5, 3}, {6, 3}, {7, 3}, {2, 3}, {13, 3}, {14, 3},
};
__global__ void __launch_bounds__(512, 2) fwd_megakernel(Params P) {
    extern __shared__ __attribute__((aligned(16))) unsigned char lds_raw[];
    LAS unsigned char* lds = (LAS unsigned char*)lds_raw;
    cg::grid_group grid = cg::this_grid();
    prologue_phase(P, lds);
    if (obid() == 0 && otid() == 0) {
        const float** tb = (const float**)(P.ws + WS_TBL);
        tb[0] = P.x; tb[1] = P.mix_norm; tb[2] = P.ffn_norm; tb[3] = P.final_norm; tb[4] = P.nsa_cmp_k_w2; tb[5] = P.nsa_cmp_v_w2;
        tb[6] = P.sgu_ln_g; tb[7] = P.sgu_ln_b; tb[8] = P.sgu_b_s; tb[9] = P.pool_scale;
    }
    grid.sync();
    unsigned char* const ws_k = P.ws; float* const out_k = P.out;
#pragma unroll 1
    for (int ph = 1; ph <= NPH; ++ph) {
        const int type = (ph < NPH) ? (int)PROG[ph][0] : 15, layer = (ph < NPH) ? (int)PROG[ph][1] : 0;
        unsigned char* ws = ws_k;
        const float* const* tb = (const float* const*)(ws + WS_TBL);
        bf16_t* H = (bf16_t*)(ws + WS_H);
        bf16_t* BIG = (bf16_t*)(ws + WS_BIG);
        float* X = out_k;
        const int kind = layer % 3, j = layer / 3;
        switch (type) {
        case 1: rmsnorm_phase(layer == 0 ? tb[0] : X, tb[1] + layer * 1024, H, nullptr); break;
        case 2: rmsnorm_phase(X, tb[2] + layer * 1024, H, nullptr); break;
        case 15: rmsnorm_phase(X, tb[3], nullptr, X); break;
        case 3: { EpiNsaIn E; E.Q = BIG; E.KV = BIG + (size_t)MTOK * 1024; E.gates = (float*)(ws + WS_GATES); E.cs = (const float*)(ws + WS_CS);
                  run_gemm(lds, H, 1024, (const bf16_t*)(ws + WS_NWIN) + (size_t)j * NSA_NP * 1024, MTOK, NSA_NP, 1024, E); } break;
        case 4: { EpiBf16<2> E; E.O = (bf16_t*)(ws + WS_CH); E.ldc = 256; E.aux = (const float*)(ws + WS_CBIAS) + j * 512;
                  pg8::Gemm g; g.A = BIG + (size_t)MTOK * 1024; g.Bt = (const bf16_t*)(ws + WS_CW1) + (size_t)j * 512 * 2048; g.M = 16384; g.N = 512; g.K = 2048; g.lda = 1024;
                  CmpOrder S; S.G = ogdim(); S.c = obid();
                  pg8::gemm_phase<EpiBf16<2>, CmpOrder, false>(lds, g, S, E, nullptr); } break;
        case 5: cmp2_phase((const bf16_t*)(ws + WS_CH), tb[4] + (size_t)j * 256 * 64, tb[5] + (size_t)j * 256 * 64, (bf16_t*)(ws + WS_KCMP), (bf16_t*)(ws + WS_VCMPT), lds); break;
        case 6: nsa_attn_phase(BIG, BIG + (size_t)MTOK * 1024, (const bf16_t*)(ws + WS_KCMP), (const bf16_t*)(ws + WS_VCMPT), (const float*)(ws + WS_GATES), H, lds); break;
        case 7: case 14: {
                  EpiResid E; E.base = (type == 7 && layer == 0) ? tb[0] : X; E.out = X;
                  const bf16_t* A = H; int K = 1024; const bf16_t* Bt;
                  if (type == 14) { A = BIG; K = FH; Bt = (const bf16_t*)(ws + WS_WDN) + (size_t)layer * 1024 * FH; }
                  else if (kind == 0) Bt = (const bf16_t*)(ws + WS_NWOUT) + (size_t)j * 1024 * 1024;
                  else if (kind == 1) Bt = (const bf16_t*)(ws + WS_SWOUT);
                  else { A = BIG; Bt = (const bf16_t*)(ws + WS_PWOUT); }
                  run_gemm(lds, A, K, Bt, MTOK, 1024, K, E); } break;
        case 8: { EpiBf16<0> E; E.O = BIG; E.ldc = 2048; E.aux = nullptr;
                  run_gemm(lds, H, 1024, (const bf16_t*)(ws + WS_SWIN), MTOK, 2048, 1024, E); } break;
        case 9: sgu_spatial_phase(BIG, tb[6], tb[7], (const bf16_t*)(ws + WS_SWS), tb[8], H, lds); break;
        case 10: { EpiF32 E; E.C = (float*)BIG;
                  run_gemm(lds, H, 1024, (const bf16_t*)(ws + WS_PWIN), MTOK, 1024, 1024, E); } break;
        case 11: pool_diff_phase((const float*)BIG, H); break;
        case 12: { EpiBf16<1> E; E.O = BIG; E.ldc = 1024; E.aux = tb[9];
                  run_gemm(lds, H, 1024, (const bf16_t*)(ws + WS_PGRP), MTOK, 1024, 1024, E); } break;
        case 13: { EpiGU E; E.HID = BIG;
                  run_gemm(lds, H, 1024, (const bf16_t*)(ws + WS_WGU) + (size_t)layer * 5632 * 1024, MTOK, 5632, 1024, E); } break;
        default: break;
        }
        if (ph < NPH) grid.sync();
    }
}

extern "C" void kernel_launch(void* const* d_in, const int* in_sizes, int n_in, void* d_out, int out_size, void* d_ws, size_t ws_size, hipStream_t stream) {
    static int grid_blocks = 0;
    if (grid_blocks == 0) {
        if (n_in != 25 || out_size != MTOK * DM || ws_size < WS_END) { fprintf(stderr, "kernel_launch: unexpected shapes (n_in %d, out %d, ws %zu need %zu)\n", n_in, out_size, ws_size, (size_t)WS_END); grid_blocks = -1; return; }
        int dev = 0, cus = 0, per_cu = 0;
        hipGetDevice(&dev);
        hipDeviceGetAttribute(&cus, hipDeviceAttributeMultiprocessorCount, dev);
        if (hipFuncSetAttribute((const void*)fwd_megakernel, hipFuncAttributeMaxDynamicSharedMemorySize, LDS_BYTES) != hipSuccess) { fprintf(stderr, "kernel_launch: hipFuncSetAttribute failed\n"); grid_blocks = -1; return; }
        if (hipOccupancyMaxActiveBlocksPerMultiprocessor(&per_cu, (const void*)fwd_megakernel, 512, LDS_BYTES) != hipSuccess || per_cu < 1) { fprintf(stderr, "kernel_launch: occupancy query gave %d\n", per_cu); per_cu = 1; }
        (void)hipGetLastError();
        grid_blocks = cus * 1;
    }
    if (grid_blocks < 0) return;
    Params p{};
    p.x = (const float*)d_in[0]; p.positions = (const int*)d_in[1]; p.mix_norm = (const float*)d_in[2]; p.ffn_norm = (const float*)d_in[3]; p.final_norm = (const float*)d_in[4];
    p.nsa_w_in = (const float*)d_in[5]; p.nsa_cmp_pos_k = (const float*)d_in[6]; p.nsa_cmp_k_w1 = (const float*)d_in[7]; p.nsa_cmp_k_w2 = (const float*)d_in[8];
    p.nsa_cmp_pos_v = (const float*)d_in[9]; p.nsa_cmp_v_w1 = (const float*)d_in[10]; p.nsa_cmp_v_w2 = (const float*)d_in[11]; p.nsa_w_out = (const float*)d_in[12];
    p.sgu_w_in = (const float*)d_in[13]; p.sgu_ln_g = (const float*)d_in[14]; p.sgu_ln_b = (const float*)d_in[15]; p.sgu_w_s = (const float*)d_in[16]; p.sgu_b_s = (const float*)d_in[17]; p.sgu_w_out = (const float*)d_in[18];
    p.pool_w_in = (const float*)d_in[19]; p.pool_w_grp = (const float*)d_in[20]; p.pool_scale = (const float*)d_in[21]; p.pool_w_out = (const float*)d_in[22];
    p.ffn_w_gate_up = (const float*)d_in[23]; p.ffn_w_down = (const float*)d_in[24];
    p.out = (float*)d_out; p.ws = (unsigned char*)d_ws;
    void* args[] = {&p};
    hipError_t e = hipLaunchCooperativeKernel((const void*)fwd_megakernel, dim3(grid_blocks), dim3(512), args, LDS_BYTES, stream);
    if (e != hipSuccess) fprintf(stderr, "cooperative launch failed: %s (grid %d)\n", hipGetErrorString(e), grid_blocks);
}
```

```cpp
#include <hip/hip_runtime.h>
#include <hip/hip_cooperative_groups.h>
#include <cstdio>
namespace cg = cooperative_groups;
namespace pg8 {
#define PG8_LAS __attribute__((address_space(3)))
typedef unsigned short bf16_t;
typedef short bf16x8 __attribute__((ext_vector_type(8)));
typedef float f32x4 __attribute__((ext_vector_type(4)));
typedef unsigned u32x4 __attribute__((ext_vector_type(4)));
constexpr int BM = 256, BK = 64, HALF = 128, HTB = HALF * BK * 2  , STAGE_BYTES = 8 * HTB, NXCD = 8, WGM = 8;

__host__ __device__ __forceinline__ int lds_byte(int r, int c) { const int st = (r >> 4) * 2 + (c >> 5), rr = r & 15, cc = c & 31, ob = rr * 64 + cc * 2; return st * 1024 + (ob ^ (((ob >> 9) & 1) << 5)); }
__host__ __device__ __forceinline__ void stage_rc(int b, int& R, int& C) { const int st = b / 1024, sb = b % 1024, swz = sb ^ (((sb >> 9) & 1) << 5); R = (st >> 1) * 16 + swz / 64; C = (st & 1) * 32 + (swz % 64) / 2; }
__host__ __device__ __forceinline__ int perm32(int rho) { const int n = rho >> 4, i = rho & 15; return 8 * (i >> 2) + 4 * n + (i & 3); }

struct Unit { int pm, pn; };
struct Gemm { const bf16_t* A; const bf16_t* Bt; int M, N, K, lda, acs; };

struct StaticOrder {
    int nM, nN, nwg, G, c;
    __host__ __device__ void init(int M, int N, int G_, int c_) { nM = M / BM; nN = N / BM; nwg = nM * nN; G = G_; c = c_; }
    __host__ __device__ bool next(int i, Unit& u) const {
        const long L = (long)i * G + c; if (L >= nwg) return false;
        int wgid = (int)L; { const int q = nwg / NXCD, r = nwg % NXCD, xcd = wgid % NXCD, off = wgid / NXCD; wgid = (xcd < r ? xcd * (q + 1) : r * (q + 1) + (xcd - r) * q) + off; }
        const int nig = WGM * nN, gid = wgid / nig, fm = gid * WGM, gsz = (nM - fm) < WGM ? (nM - fm) : WGM;
        u.pm = fm + ((wgid % nig) % gsz); u.pn = (wgid % nig) / gsz; return true;
    }
    __device__ __forceinline__ void a_ready(const Unit&) const {}
    __device__ __forceinline__ void done(const Unit&) const {}
};
template <class Epi, class Sched, bool STAMP = false>
__device__ __forceinline__ void gemm_phase(PG8_LAS unsigned char* lds, const Gemm g, const Sched& S, const Epi& E, unsigned long long* stamps) {
    int tid_ = threadIdx.x; asm volatile("" : "+v"(tid_)); const int tid = tid_, wid = __builtin_amdgcn_readfirstlane(tid >> 6), lane = tid & 63, wr = wid >> 2, wc = wid & 3, fr = lane & 15, fq = lane >> 4;
    const int K = g.K, nt = K / BK;
    int ts_lo = 0, ts_hi = 0, nts = 0; const unsigned long long rt_entry = STAMP ? (unsigned long long)wall_clock64() : 0ull;
#define PG8_STAMP() do { if (STAMP && wid == 0 && nts < 64) { const unsigned long long _c = (unsigned long long)clock64(); \
        ts_lo = (lane == nts) ? (int)(unsigned)_c : ts_lo; ts_hi = (lane == nts) ? (int)(unsigned)(_c >> 32) : ts_hi; ++nts; } } while (0)
    PG8_STAMP();
    unsigned voffA[2], voffB[2];
#pragma unroll
    for (int i = 0; i < 2; ++i) { int R, C; stage_rc(tid * 16 + i * 8192, R, C); const int Rb = Epi::PERM ? ((R & ~31) + perm32(R & 31)) : R;
        voffA[i] = (unsigned)(R * g.lda + C) * 2u; voffB[i] = (unsigned)(Rb * K + C) * 2u; }
    const size_t kstep = (size_t)(BK * 2);
    const size_t hstep = (size_t)HALF * K * 2;
    const size_t tstep = 2 * hstep; const size_t hstepA = (size_t)HALF * g.lda * 2; const size_t tstepA = 2 * hstepA;
    const unsigned ldsw = (unsigned)wid * 1024u;
    const int aoff = lds_byte(wr * 64 + fr, fq * 8), boff = lds_byte(wc * 32 + fr, fq * 8);
#define PG8_SA(b, h) (((b) * 2 + (h)) * HTB)
#define PG8_SB(b, h) ((4 + (b) * 2 + (h)) * HTB)
#define PG8_STAGE(bufoff, gbase, voff) do { _Pragma("unroll") for (int _i = 0; _i < 2; ++_i) \
        __builtin_amdgcn_global_load_lds((const unsigned*)((const char*)(gbase) + (voff)[_i]), (PG8_LAS unsigned*)(lds + (bufoff) + ldsw + _i * 8192), 16, 0, 0); } while (0)
#define PG8_LDA(dst, b, h) do { _Pragma("unroll") for (int m = 0; m < 4; ++m) _Pragma("unroll") for (int k = 0; k < 2; ++k) dst[m][k] = *(const PG8_LAS bf16x8*)(lds + PG8_SA(b, h) + aoff + m * 2048 + k * 1024); } while (0)
#define PG8_LDB(dst, b, h) do { _Pragma("unroll") for (int n = 0; n < 2; ++n) _Pragma("unroll") for (int k = 0; k < 2; ++k) dst[n][k] = *(const PG8_LAS bf16x8*)(lds + PG8_SB(b, h) + boff + n * 2048 + k * 1024); } while (0)
#define PG8_MMA(ai, bj, At, Bt) do { __builtin_amdgcn_s_setprio(1); _Pragma("unroll") for (int m = 0; m < 4; ++m) _Pragma("unroll") for (int n = 0; n < 2; ++n) _Pragma("unroll") for (int k = 0; k < 2; ++k) \
        acc[ai][bj][m][n] = __builtin_amdgcn_mfma_f32_16x16x32_bf16(Bt[n][k], At[m][k], acc[ai][bj][m][n], 0, 0, 0); __builtin_amdgcn_s_setprio(0); } while (0)
#define PG8_WAIT_V(n) asm volatile("s_waitcnt vmcnt(" #n ")" ::: "memory")
#define PG8_WAIT_L(n) asm volatile("s_waitcnt lgkmcnt(" #n ")" ::: "memory")
#define PG8_BAR __builtin_amdgcn_s_barrier()
#define PG8_SCHED __builtin_amdgcn_sched_barrier(0)
    Unit cur, nxt; int ui = 0;
    if (!S.next(0, cur)) return;
    f32x4 acc[2][2][4][2];
#pragma unroll
    for (int a = 0; a < 2; ++a)
#pragma unroll
        for (int b = 0; b < 2; ++b)
#pragma unroll
            for (int m = 0; m < 4; ++m)
#pragma unroll
                for (int n = 0; n < 2; ++n) acc[a][b][m][n] = (f32x4){0.f, 0.f, 0.f, 0.f};
    bf16x8 At[4][2], B0[2][2], B1[2][2];
    const char* cA = (const char*)g.A + (size_t)cur.pm * tstepA + (size_t)cur.pn * g.acs; const char* cB = (const char*)g.Bt + (size_t)cur.pn * tstep;
    S.a_ready(cur);
    PG8_STAGE(PG8_SB(0, 0), cB, voffB); PG8_STAGE(PG8_SB(0, 1), cB + hstep, voffB); PG8_STAGE(PG8_SA(0, 0), cA, voffA); PG8_STAGE(PG8_SA(0, 1), cA + hstepA, voffA);
    if (wr == 1) PG8_BAR;
    PG8_WAIT_V(2); PG8_BAR;
    PG8_STAGE(PG8_SB(1, 0), cB + kstep, voffB); PG8_STAGE(PG8_SA(1, 0), cA + kstep, voffA); PG8_STAGE(PG8_SB(1, 1), cB + hstep + kstep, voffB);
    PG8_WAIT_V(6); PG8_BAR;
    PG8_STAMP();
    for (;;) {
        const bool has_next = S.next(ui + 1, nxt);
        const char* nA = has_next ? (const char*)g.A + (size_t)nxt.pm * tstepA + (size_t)nxt.pn * g.acs : cA; const char* nB = has_next ? (const char*)g.Bt + (size_t)nxt.pn * tstep : cB;
        for (int t = 0; t < nt; t += 2) {
            const bool last = (t == nt - 2);
            const char* a1 = cA + (size_t)(t + 1) * kstep;
            const char* a2 = last ? nA : cA + (size_t)(t + 2) * kstep; const char* b2 = last ? nB : cB + (size_t)(t + 2) * kstep;
            const char* a3 = a2 + kstep; const char* b3 = b2 + kstep;
            if (last && has_next) S.a_ready(nxt);
            PG8_LDB(B0, 0, 0); PG8_LDB(B1, 0, 1); PG8_SCHED; PG8_LDA(At, 0, 0); PG8_STAGE(PG8_SA(1, 1), a1 + hstepA, voffA);
            PG8_WAIT_V(8); PG8_WAIT_L(0); PG8_BAR; PG8_MMA(0, 0, At, B0); PG8_MMA(0, 1, At, B1); PG8_BAR; PG8_SCHED;
            PG8_LDA(At, 0, 1); PG8_STAGE(PG8_SB(0, 0), b2, voffB); PG8_STAGE(PG8_SB(0, 1), b2 + hstep, voffB); PG8_STAGE(PG8_SA(0, 0), a2, voffA);
            PG8_WAIT_V(8); PG8_WAIT_L(0); PG8_BAR; PG8_MMA(1, 0, At, B0); PG8_MMA(1, 1, At, B1); PG8_BAR; PG8_SCHED;
            PG8_LDB(B0, 1, 0); PG8_LDB(B1, 1, 1); PG8_SCHED; PG8_LDA(At, 1, 0); PG8_STAGE(PG8_SA(0, 1), a2 + hstepA, voffA);
            PG8_WAIT_V(8); PG8_WAIT_L(0); PG8_BAR; PG8_MMA(0, 0, At, B0); PG8_MMA(0, 1, At, B1); PG8_BAR; PG8_SCHED;
            PG8_LDA(At, 1, 1); PG8_STAGE(PG8_SB(1, 0), b3, voffB); PG8_STAGE(PG8_SB(1, 1), b3 + hstep, voffB); PG8_STAGE(PG8_SA(1, 0), a3, voffA);
            PG8_WAIT_V(8); PG8_WAIT_L(0); PG8_BAR; PG8_MMA(1, 0, At, B0); PG8_MMA(1, 1, At, B1); PG8_BAR; PG8_SCHED;
        }
        PG8_STAMP();
        if (wr == 0) PG8_BAR;
        if constexpr (!Epi::AFTER_DRAIN) { E(acc, cur, wr, wc, fr, fq); S.done(cur); }
        PG8_STAMP();
        if (!has_next) break;
#pragma unroll
        for (int a = 0; a < 2; ++a)
#pragma unroll
            for (int b = 0; b < 2; ++b)
#pragma unroll
                for (int m = 0; m < 4; ++m)
#pragma unroll
                    for (int n = 0; n < 2; ++n) acc[a][b][m][n] = (f32x4){0.f, 0.f, 0.f, 0.f};
        cur = nxt; cA = nA; cB = nB; ++ui;
        if (wr == 1) PG8_BAR;
    }
    PG8_WAIT_V(0);
    PG8_BAR;
    if constexpr (Epi::AFTER_DRAIN) { E.fused(acc, cur, wr, wc, fr, fq, lds, wid, lane); S.done(cur); }
    PG8_STAMP();
    if (STAMP && wid == 0) { stamps[lane] = lane < nts ? (((unsigned long long)(unsigned)ts_hi << 32) | (unsigned)ts_lo) : 0ull;
        if (lane == 62) stamps[62] = rt_entry; if (lane == 63) stamps[63] = (unsigned long long)wall_clock64(); }
#undef PG8_STAMP
#undef PG8_SA
#undef PG8_SB
#undef PG8_STAGE
#undef PG8_LDA
#undef PG8_LDB
#undef PG8_MMA
#undef PG8_WAIT_V
#undef PG8_WAIT_L
#undef PG8_BAR
#undef PG8_SCHED
}
}

#define LAS __attribute__((address_space(3)))
typedef unsigned short bf16_t;
typedef short bf16x8 __attribute__((ext_vector_type(8)));
typedef short s16x4 __attribute__((ext_vector_type(4)));
typedef float f32x4 __attribute__((ext_vector_type(4)));
typedef float f32x16 __attribute__((ext_vector_type(16)));
typedef unsigned u32x4 __attribute__((ext_vector_type(4)));
typedef unsigned u32x2 __attribute__((ext_vector_type(2)));
typedef __bf16 bf16x2_t __attribute__((ext_vector_type(2)));
typedef float f32x2_t __attribute__((ext_vector_type(2)));

__device__ __forceinline__ int otid() { int t = threadIdx.x; asm volatile("" : "+v"(t)); return t; }
__device__ __forceinline__ int obid() { int t = blockIdx.x; asm volatile("" : "+s"(t)); return t; }
__device__ __forceinline__ int ogdim() { int t = gridDim.x; asm volatile("" : "+s"(t)); return t; }
constexpr int NB = 8, SEQ = 4096, DM = 1024, MTOK = NB * SEQ;
constexpr int FH = 2816;
constexpr int NSA_IN = 2608, NSA_NP = 2816;
constexpr size_t KVSZ = (size_t)32 * 4096 * 64;
constexpr int LDS_BYTES = 131072 + 16;

__device__ __forceinline__ unsigned pk_bf16(float a, float b) { f32x2_t v = {a, b}; bf16x2_t r = __builtin_convertvector(v, bf16x2_t); return __builtin_bit_cast(unsigned, r); }
__device__ __forceinline__ bf16_t f2bf(float a) { return (bf16_t)(pk_bf16(a, 0.f) & 0xffffu); }
__device__ __forceinline__ float bf2f(unsigned short x) { return __uint_as_float(((unsigned)x) << 16); }
__device__ __forceinline__ float gelu_tanh(float x) { const float y = 0.7978845608f * (x + 0.044715f * x * x * x); return x * __builtin_amdgcn_rcpf(1.0f + __builtin_amdgcn_exp2f(-2.885390082f * y)); }
__device__ __forceinline__ float silu_f(float x) { return x * __builtin_amdgcn_rcpf(1.0f + __builtin_amdgcn_exp2f(-1.442695041f * x)); }
__device__ __forceinline__ float sigmoid_f(float x) { return __builtin_amdgcn_rcpf(1.0f + __builtin_amdgcn_exp2f(-1.442695041f * x)); }

constexpr size_t al256(size_t x) { return (x + 255) & ~(size_t)255; }
constexpr size_t WS_WGU = 0;
constexpr size_t WS_WDN = WS_WGU + (size_t)4 * 5632 * 1024 * 2;
constexpr size_t WS_NWIN = WS_WDN + (size_t)4 * 1024 * 2816 * 2;
constexpr size_t WS_NWOUT = WS_NWIN + (size_t)2 * NSA_NP * 1024 * 2;
constexpr size_t WS_CW1 = WS_NWOUT + (size_t)2 * 1024 * 1024 * 2;
constexpr size_t WS_SWIN = WS_CW1 + (size_t)2 * 512 * 2048 * 2;
constexpr size_t WS_SWOUT = WS_SWIN + (size_t)2048 * 1024 * 2;
constexpr size_t WS_SWS = WS_SWOUT + (size_t)1024 * 1024 * 2;
constexpr size_t WS_PWIN = WS_SWS + (size_t)8 * 128 * 128 * 2;
constexpr size_t WS_PGRP = WS_PWIN + (size_t)1024 * 1024 * 2;
constexpr size_t WS_PWOUT = WS_PGRP + (size_t)1024 * 1024 * 2;
constexpr size_t WS_CBIAS = WS_PWOUT + (size_t)1024 * 1024 * 2;
constexpr size_t WS_CS = WS_CBIAS + 4096;
constexpr size_t WS_GATES = WS_CS + (size_t)MTOK * 16 * 4;
constexpr size_t WS_CH = WS_GATES + (size_t)MTOK * 48 * 4;
constexpr size_t WS_KCMP = WS_CH + (size_t)16384 * 256 * 2;
constexpr size_t WS_VCMPT = WS_KCMP + (size_t)32 * 256 * 64 * 2;
constexpr size_t WS_H = WS_VCMPT + (size_t)32 * 64 * 256 * 2;
constexpr size_t WS_BIG = WS_H + (size_t)MTOK * 1024 * 2;
constexpr size_t WS_TBL = WS_BIG + (size_t)MTOK * 2816 * 2 + 65536;
constexpr size_t WS_CBPART = WS_TBL + 4096;
constexpr size_t WS_W2T = WS_CBPART + (size_t)256 * 256 * 4;
constexpr size_t WS_H2 = WS_W2T + (size_t)4 * 64 * 256 * 2;
constexpr size_t WS_RSS = WS_H2 + (size_t)MTOK * 1024 * 2;
constexpr size_t WS_BAR = WS_RSS + (size_t)8 * MTOK * 16 * 4;
constexpr size_t WS_END = WS_BAR + 16384;

struct Params {
    const float* x; const int* positions; const float* mix_norm; const float* ffn_norm; const float* final_norm;
    const float* nsa_w_in; const float* nsa_cmp_pos_k; const float* nsa_cmp_k_w1; const float* nsa_cmp_k_w2;
    const float* nsa_cmp_pos_v; const float* nsa_cmp_v_w1; const float* nsa_cmp_v_w2; const float* nsa_w_out;
    const float* sgu_w_in; const float* sgu_ln_g; const float* sgu_ln_b; const float* sgu_w_s; const float* sgu_b_s; const float* sgu_w_out;
    const float* pool_w_in; const float* pool_w_grp; const float* pool_scale; const float* pool_w_out;
    const float* ffn_w_gate_up; const float* ffn_w_down;
    float* out; unsigned char* ws;
};


__device__ __forceinline__ float row_rstd(const float* rss, int row) {
    const f32x4* q = (const f32x4*)(rss + (size_t)row * 16);
    const f32x4 s = (q[0] + q[1]) + (q[2] + q[3]);
    return rsqrtf(((s[0] + s[1]) + (s[2] + s[3])) * (1.0f / 1024.0f) + 1e-6f);
}
__device__ __forceinline__ void load_rstd(const float* rss, int row0, float (&rs)[2][4]) {
#pragma unroll
    for (int ai = 0; ai < 2; ++ai)
#pragma unroll
        for (int m = 0; m < 4; ++m) rs[ai][m] = rss ? row_rstd(rss, row0 + ai * 128 + m * 16) : 1.0f;
}
struct EpiResid {
    static constexpr bool PERM = true, AFTER_DRAIN = false;
    bf16_t* XB; float* rss;
    __device__ __forceinline__ void operator()(const f32x4 (&acc)[2][2][4][2], const pg8::Unit& u, int wr, int wc, int fr, int fq) const {
        const int row0 = u.pm * 256 + wr * 64 + fr, col0 = u.pn * 256 + wc * 32 + 8 * fq;
#pragma unroll
        for (int ai = 0; ai < 2; ++ai)
#pragma unroll
            for (int m = 0; m < 4; ++m) {
                const int row = row0 + ai * 128 + m * 16;
                bf16_t* rp = XB + (size_t)row * 1024 + col0;
                float ss = 0.f;
#pragma unroll
                for (int bj = 0; bj < 2; ++bj) {
                    const u32x4 bw = *(const u32x4*)(rp + bj * 128);
                    const f32x4 a0 = acc[ai][bj][m][0], a1 = acc[ai][bj][m][1];
                    float x[8];
                    x[0] = __uint_as_float(bw.x << 16) + a0[0]; x[1] = __uint_as_float(bw.x & 0xffff0000u) + a0[1];
                    x[2] = __uint_as_float(bw.y << 16) + a0[2]; x[3] = __uint_as_float(bw.y & 0xffff0000u) + a0[3];
                    x[4] = __uint_as_float(bw.z << 16) + a1[0]; x[5] = __uint_as_float(bw.z & 0xffff0000u) + a1[1];
                    x[6] = __uint_as_float(bw.w << 16) + a1[2]; x[7] = __uint_as_float(bw.w & 0xffff0000u) + a1[3];
#pragma unroll
                    for (int e = 0; e < 8; ++e) ss += x[e] * x[e];
                    u32x4 w; w.x = pk_bf16(x[0], x[1]); w.y = pk_bf16(x[2], x[3]); w.z = pk_bf16(x[4], x[5]); w.w = pk_bf16(x[6], x[7]);
                    *(u32x4*)(rp + bj * 128) = w;
                }
                if (rss) {
                    ss += __shfl_xor(ss, 16); ss += __shfl_xor(ss, 32);
                    if (fq == 0) rss[(size_t)row * 16 + u.pn * 4 + wc] = ss;
                }
            }
    }
};
struct EpiF32 {
    static constexpr bool PERM = false, AFTER_DRAIN = false;
    float* C; const float* rss;
    __device__ __forceinline__ void operator()(const f32x4 (&acc)[2][2][4][2], const pg8::Unit& u, int wr, int wc, int fr, int fq) const {
        const int row0 = u.pm * 256 + wr * 64 + fr, col0 = u.pn * 256 + wc * 32 + 4 * fq;
        float rs[2][4]; load_rstd(rss, row0, rs);
#pragma unroll
        for (int ai = 0; ai < 2; ++ai)
#pragma unroll
            for (int m = 0; m < 4; ++m) {
                const size_t off = (size_t)(row0 + ai * 128 + m * 16) * 1024 + col0;
#pragma unroll
                for (int bj = 0; bj < 2; ++bj)
#pragma unroll
                    for (int n = 0; n < 2; ++n) *(f32x4*)(C + off + bj * 128 + n * 16) = acc[ai][bj][m][n] * rs[ai][m];
            }
    }
};
struct EpiGU {
    static constexpr bool PERM = true, AFTER_DRAIN = false;
    bf16_t* HID; const float* rss;
    __device__ __forceinline__ void operator()(const f32x4 (&acc)[2][2][4][2], const pg8::Unit& u, int wr, int wc, int fr, int fq) const {
        const int row0 = u.pm * 256 + wr * 64 + fr, col0 = u.pn * 128 + wc * 32 + 8 * fq;
        float rs[2][4]; load_rstd(rss, row0, rs);
#pragma unroll
        for (int ai = 0; ai < 2; ++ai)
#pragma unroll
            for (int m = 0; m < 4; ++m) {
                const float rr = rs[ai][m];
                const f32x4 g0 = acc[ai][0][m][0] * rr, g1 = acc[ai][0][m][1] * rr, u0 = acc[ai][1][m][0] * rr, u1 = acc[ai][1][m][1] * rr;
                u32x4 w;
                w.x = pk_bf16(silu_f(g0[0]) * u0[0], silu_f(g0[1]) * u0[1]); w.y = pk_bf16(silu_f(g0[2]) * u0[2], silu_f(g0[3]) * u0[3]);
                w.z = pk_bf16(silu_f(g1[0]) * u1[0], silu_f(g1[1]) * u1[1]); w.w = pk_bf16(silu_f(g1[2]) * u1[2], silu_f(g1[3]) * u1[3]);
                *(u32x4*)(HID + (size_t)(row0 + ai * 128 + m * 16) * FH + col0) = w;
            }
    }
};
template <int MODE> struct EpiBf16 {
    static constexpr bool PERM = true, AFTER_DRAIN = false;
    bf16_t* O; int ldc; const float* aux; const float* rss;
    __device__ __forceinline__ void operator()(const f32x4 (&acc)[2][2][4][2], const pg8::Unit& u, int wr, int wc, int fr, int fq) const {
        const int row0 = u.pm * 256 + wr * 64 + fr; const int ct = wc * 32 + 8 * fq;
        const int colbase = (MODE == 2) ? 0 : u.pn * 256;
        float rs[2][4]; if (MODE == 0) load_rstd(rss, row0, rs);
        f32x4 av[2][2];
#pragma unroll
        for (int bj = 0; bj < 2; ++bj)
#pragma unroll
            for (int n = 0; n < 2; ++n) av[bj][n] = (MODE == 0) ? (f32x4){0.f, 0.f, 0.f, 0.f} : *(const f32x4*)(aux + u.pn * 256 + ct + bj * 128 + 4 * n);
#pragma unroll
        for (int ai = 0; ai < 2; ++ai)
#pragma unroll
            for (int m = 0; m < 4; ++m) {
                bf16_t* rowp = O + (size_t)(row0 + ai * 128 + m * 16) * ldc + colbase + ct;
#pragma unroll
                for (int bj = 0; bj < 2; ++bj) {
                    f32x4 v0 = acc[ai][bj][m][0], v1 = acc[ai][bj][m][1];
                    if (MODE == 0) { v0 = v0 * rs[ai][m]; v1 = v1 * rs[ai][m]; }
                    if (MODE == 1) { v0 = v0 * av[bj][0]; v1 = v1 * av[bj][1]; }
                    if (MODE == 2) { v0 = v0 + av[bj][0]; v1 = v1 + av[bj][1]; }
                    if (MODE != 1) {
#pragma unroll
                        for (int j = 0; j < 4; ++j) { v0[j] = gelu_tanh(v0[j]); v1[j] = gelu_tanh(v1[j]); }
                    }
                    u32x4 w; w.x = pk_bf16(v0[0], v0[1]); w.y = pk_bf16(v0[2], v0[3]); w.z = pk_bf16(v1[0], v1[1]); w.w = pk_bf16(v1[2], v1[3]);
                    *(u32x4*)(rowp + bj * 128) = w;
                }
            }
    }
};
struct EpiNsaIn {
    static constexpr bool PERM = true, AFTER_DRAIN = false;
    bf16_t* Q; bf16_t* KV; float* gates; const float* cs; const float* rss;
    template <int VAR> __device__ __forceinline__ void variant(const f32x4 (&acc)[2][2][4][2], const pg8::Unit& u, int wr, int wc, int fr, int fq) const {
        const int pn = u.pn; const int jkv = pn - 4;
        const int row0 = u.pm * 256 + wr * 64 + fr;
        const bool rope_w = (VAR <= 1) && ((wc & 1) == 0);
#pragma unroll
        for (int ai = 0; ai < 2; ++ai)
#pragma unroll
            for (int m = 0; m < 4; ++m) {
                const int row = row0 + ai * 128 + m * 16; const int b = row >> 12, s = row & 4095;
                const float rr = rss ? row_rstd(rss, row) : 1.0f;
#pragma unroll
                for (int bj = 0; bj < 2; ++bj) {
                    const int cb = bj * 128 + wc * 32 + fq * 8;
                    f32x4 v0 = acc[ai][bj][m][0] * rr, v1 = acc[ai][bj][m][1] * rr;
                    if (rope_w) {
                        f32x4 p0, p1;
#pragma unroll
                        for (int j = 0; j < 4; ++j) { p0[j] = __shfl_xor(v0[j], 16); p1[j] = __shfl_xor(v1[j], 16); }
                        if (fq < 2) {
                            const f32x4* c4 = (const f32x4*)(cs + (size_t)row * 16);
                            const f32x4 cA = c4[0], cB = c4[1], sA = c4[2], sB = c4[3];
                            if (fq == 0) { v0 = v0 * cA - p0 * sA; v1 = v1 * cB - p1 * sB; }
                            else { v0 = v0 * cA + p0 * sA; v1 = v1 * cB + p1 * sB; }
                        }
                    }
                    const int hh = cb >> 6, d0 = cb & 63;
                    if (VAR == 0) {
                        v0 = v0 * 0.18033688f; v1 = v1 * 0.18033688f;
                        u32x4 w; w.x = pk_bf16(v0[0], v0[1]); w.y = pk_bf16(v0[2], v0[3]); w.z = pk_bf16(v1[0], v1[1]); w.w = pk_bf16(v1[2], v1[3]);
                        *(u32x4*)(Q + ((size_t)(b * 16 + pn * 4 + hh) * 4096 + s) * 64 + d0) = w;
                    } else if (VAR == 1 || VAR == 2) {
                        u32x4 w; w.x = pk_bf16(v0[0], v0[1]); w.y = pk_bf16(v0[2], v0[3]); w.z = pk_bf16(v1[0], v1[1]); w.w = pk_bf16(v1[2], v1[3]);
                        *(u32x4*)(KV + (size_t)jkv * KVSZ + ((size_t)(b * 4 + hh) * 4096 + s) * 64 + d0) = w;
                    } else if (VAR == 3) {
                        bf16_t* tp = KV + (size_t)jkv * KVSZ + ((size_t)(b * 4 + hh) * 64 + d0) * 4096 + s;
#pragma unroll
                        for (int j = 0; j < 4; ++j) { tp[(size_t)j * 4096] = f2bf(v0[j]); tp[(size_t)(j + 4) * 4096] = f2bf(v1[j]); }
                    } else if (cb < 48) {
                        f32x4 g0, g1;
#pragma unroll
                        for (int j = 0; j < 4; ++j) { g0[j] = sigmoid_f(v0[j]); g1[j] = sigmoid_f(v1[j]); }
                        float* gp = gates + (size_t)row * 48 + cb;
                        *(f32x4*)gp = g0; *(f32x4*)(gp + 4) = g1;
                    }
                }
            }
    }
    __device__ __forceinline__ void operator()(const f32x4 (&acc)[2][2][4][2], const pg8::Unit& u, int wr_, int wc_, int fr_, int fq_) const {
        const int pn = u.pn;
        const int t_ = otid(); const int wid_ = __builtin_amdgcn_readfirstlane(t_ >> 6); const int wr = wid_ >> 2, wc = wid_ & 3, fr = t_ & 15, fq = (t_ & 63) >> 4;
        (void)wr_; (void)wc_; (void)fr_; (void)fq_;
        if (pn < 4) variant<0>(acc, u, wr, wc, fr, fq);
        else if (pn == 4 || pn == 6 || pn == 8) variant<1>(acc, u, wr, wc, fr, fq);
        else if (pn == 5) variant<2>(acc, u, wr, wc, fr, fq);
        else if (pn == 7 || pn == 9) variant<3>(acc, u, wr, wc, fr, fq);
        else variant<4>(acc, u, wr, wc, fr, fq);
    }
};
struct EpiGates {
    static constexpr bool PERM = false, AFTER_DRAIN = false;
    float* gates; const float* rss;
    __device__ __forceinline__ void operator()(const f32x4 (&acc)[2][2][4][2], const pg8::Unit& u, int wr, int wc, int fr, int fq) const {
        if (wc > 1) return;
        const int row0 = u.pm * 256 + wr * 64 + fr;
#pragma unroll
        for (int ai = 0; ai < 2; ++ai)
#pragma unroll
            for (int m = 0; m < 4; ++m) {
                const int row = row0 + ai * 128 + m * 16;
                const float rr = rss ? row_rstd(rss, row) : 1.0f;
#pragma unroll
                for (int n = 0; n < 2; ++n) {
                    const int cb = wc * 32 + 16 * n + 4 * fq;
                    if (cb < 48) {
                        const f32x4 v = acc[ai][0][m][n] * rr; f32x4 gsig;
#pragma unroll
                        for (int e = 0; e < 4; ++e) gsig[e] = sigmoid_f(v[e]);
                        *(f32x4*)(gates + (size_t)row * 48 + cb) = gsig;
                    }
                }
            }
    }
};
struct GateOrder {
    int G, c;
    __device__ bool next(int i, pg8::Unit& u) const { const int L = i * G + c; if (L >= 128 || G <= 0) return false; u.pm = L; u.pn = 10; return true; }
    __device__ __forceinline__ void a_ready(const pg8::Unit&) const {}
    __device__ __forceinline__ void done(const pg8::Unit&) const {}
};
struct CmpOrder {
    int G, c;
    __device__ bool next(int i, pg8::Unit& u) const { const int L = i * G + c; if (L >= 64) return false; u.pm = L; u.pn = L >> 5; return true; }
    __device__ __forceinline__ void a_ready(const pg8::Unit&) const {}
    __device__ __forceinline__ void done(const pg8::Unit&) const {}
};

template <class Epi> __device__ __forceinline__ void run_gemm(LAS unsigned char* lds, const bf16_t* A, int lda, const bf16_t* Bt, int M, int N, int K, const Epi& E, int acs = 0) {
    pg8::Gemm g; g.A = A; g.Bt = Bt; g.M = M; g.N = N; g.K = K; g.lda = lda; g.acs = acs;
    pg8::StaticOrder S; S.init(M, N, ogdim(), obid());
    pg8::gemm_phase<Epi, pg8::StaticOrder, false>(lds, g, S, E, nullptr);
}

struct TJob { const float* src; bf16_t* dst; const float* gk; int K, Nsrc, Ndst, mode, tiles; };
__device__ __forceinline__ int job_colmap(int mode, int n) {
    if (mode == 0) return n;
    if (mode == 1) { const int t = n >> 8, r = n & 255; return (r < 128) ? (t * 128 + r) : (FH + t * 128 + (r - 128)); }
    return (n < NSA_IN) ? n : -1;
}
__device__ void transpose_tile(LAS float* tile, const TJob& J, int t) {
    const int tid = otid(), tx = tid & 63, ty = tid >> 6;
    const int nkt = J.K >> 6; const int tn = t / nkt, tk = t - tn * nkt; const int n0 = tn * 64, k0 = tk * 64;
    const int sc = job_colmap(J.mode, n0 + tx);
#pragma unroll
    for (int i = 0; i < 8; ++i) { const int k = k0 + ty + 8 * i; const float gs = J.gk ? J.gk[k] : 1.0f; tile[(ty + 8 * i) * 65 + tx] = (sc >= 0) ? J.src[(size_t)k * J.Nsrc + sc] * gs : 0.f; }
    __syncthreads();
    {
        const int nn = tid >> 3, kg = tid & 7;
        float v[8];
#pragma unroll
        for (int e = 0; e < 8; ++e) v[e] = tile[(kg * 8 + e) * 65 + nn];
        u32x4 w; w.x = pk_bf16(v[0], v[1]); w.y = pk_bf16(v[2], v[3]); w.z = pk_bf16(v[4], v[5]); w.w = pk_bf16(v[6], v[7]);
        *(u32x4*)(J.dst + (size_t)(n0 + nn) * J.K + k0 + kg * 8) = w;
    }
    __syncthreads();
}
__device__ __forceinline__ void get_job(const Params& P, unsigned char* ws, int j, TJob& J) {
        J.gk = nullptr;
        if (j < 4) { J.gk = P.ffn_norm + j * 1024; J.src = P.ffn_w_gate_up + (size_t)j * 1024 * 5632; J.dst = (bf16_t*)(ws + WS_WGU) + (size_t)j * 5632 * 1024; J.K = 1024; J.Nsrc = 5632; J.Ndst = 5632; J.mode = 1; }
        else if (j < 8) { const int l = j - 4; J.src = P.ffn_w_down + (size_t)l * 2816 * 1024; J.dst = (bf16_t*)(ws + WS_WDN) + (size_t)l * 1024 * 2816; J.K = 2816; J.Nsrc = 1024; J.Ndst = 1024; J.mode = 0; }
        else if (j < 10) { const int l = j - 8; J.gk = P.mix_norm + (3 * l) * 1024; J.src = P.nsa_w_in + (size_t)l * 1024 * NSA_IN; J.dst = (bf16_t*)(ws + WS_NWIN) + (size_t)l * NSA_NP * 1024; J.K = 1024; J.Nsrc = NSA_IN; J.Ndst = NSA_NP; J.mode = 2; }
        else if (j < 12) { const int l = j - 10; J.src = P.nsa_w_out + (size_t)l * 1024 * 1024; J.dst = (bf16_t*)(ws + WS_NWOUT) + (size_t)l * 1024 * 1024; J.K = 1024; J.Nsrc = 1024; J.Ndst = 1024; J.mode = 0; }
        else if (j < 14) { const int l = j - 12; J.src = P.nsa_cmp_k_w1 + (size_t)l * 2048 * 256; J.dst = (bf16_t*)(ws + WS_CW1) + (size_t)l * 512 * 2048; J.K = 2048; J.Nsrc = 256; J.Ndst = 256; J.mode = 0; }
        else if (j < 16) { const int l = j - 14; J.src = P.nsa_cmp_v_w1 + (size_t)l * 2048 * 256; J.dst = (bf16_t*)(ws + WS_CW1) + (size_t)l * 512 * 2048 + (size_t)256 * 2048; J.K = 2048; J.Nsrc = 256; J.Ndst = 256; J.mode = 0; }
        else if (j == 16) { J.gk = P.mix_norm + 1024; J.src = P.sgu_w_in; J.dst = (bf16_t*)(ws + WS_SWIN); J.K = 1024; J.Nsrc = 2048; J.Ndst = 2048; J.mode = 0; }
        else if (j == 17) { J.src = P.sgu_w_out; J.dst = (bf16_t*)(ws + WS_SWOUT); J.K = 1024; J.Nsrc = 1024; J.Ndst = 1024; J.mode = 0; }
        else if (j == 18) { J.gk = P.mix_norm + 2048; J.src = P.pool_w_in; J.dst = (bf16_t*)(ws + WS_PWIN); J.K = 1024; J.Nsrc = 1024; J.Ndst = 1024; J.mode = 0; }
        else { J.src = P.pool_w_out; J.dst = (bf16_t*)(ws + WS_PWOUT); J.K = 1024; J.Nsrc = 1024; J.Ndst = 1024; J.mode = 0; }
        J.tiles = (J.Ndst >> 6) * (J.K >> 6);
    }
__device__ void prologue_phase(const Params& P, LAS unsigned char* lds) {
    unsigned char* ws = P.ws;
    const int tid = otid();
    constexpr int NJ = 22;
    int total = 0;
    (void)NJ; (void)total;
    {
        int base = 0;
        for (int j = 0; j < 19; ++j) {
            TJob J; get_job(P, ws, j, J);
            int first = (obid() - base % ogdim() + ogdim()) % ogdim();
            for (int t = first; t < J.tiles; t += ogdim()) transpose_tile((LAS float*)lds, J, t);
            base += J.tiles;
        }
    }
    const size_t gtid = (size_t)obid() * 512 + tid, gsz = (size_t)ogdim() * 512;
    {
        bf16_t* dst = (bf16_t*)(ws + WS_PWOUT);
        for (size_t i = gtid; i < (size_t)256 * 256; i += gsz) {
            const int e0 = (int)(i & 255) * 4, c0 = (int)(i >> 8) * 4; const int g = c0 >> 8;
            const f32x4* wg = (const f32x4*)(P.pool_w_grp + ((size_t)g * 256 + (c0 & 255)) * 256);
            const f32x4* sc = (const f32x4*)(P.pool_scale + g * 256);
            const float* wo = P.pool_w_out + (size_t)g * 256 * 1024 + e0;
            f32x4 acc[4];
#pragma unroll
            for (int j = 0; j < 4; ++j) acc[j] = (f32x4){0.f, 0.f, 0.f, 0.f};
#pragma unroll 2
            for (int m4 = 0; m4 < 64; ++m4) {
                const f32x4 s4 = sc[m4];
                f32x4 wv[4];
#pragma unroll
                for (int j = 0; j < 4; ++j) wv[j] = wg[j * 64 + m4] * s4;
#pragma unroll
                for (int mm = 0; mm < 4; ++mm) {
                    const f32x4 o4 = *(const f32x4*)(wo + (size_t)(m4 * 4 + mm) * 1024);
#pragma unroll
                    for (int j = 0; j < 4; ++j) acc[j] = acc[j] + o4 * wv[j][mm];
                }
            }
#pragma unroll
            for (int ii = 0; ii < 4; ++ii) {
                u32x2 w; w.x = pk_bf16(acc[0][ii], acc[1][ii]); w.y = pk_bf16(acc[2][ii], acc[3][ii]);
                *(u32x2*)(dst + (size_t)(e0 + ii) * 1024 + c0) = w;
            }
        }
    }
    {
        bf16_t* dst = (bf16_t*)(ws + WS_W2T);
        for (size_t i = gtid; i < (size_t)4 * 64 * 256; i += gsz) {
            const int c = (int)(i & 255), d = (int)((i >> 8) & 63), kv = (int)((i >> 14) & 1), l = (int)(i >> 15);
            const float* w2 = (kv ? P.nsa_cmp_v_w2 : P.nsa_cmp_k_w2) + (size_t)l * 256 * 64;
            dst[i] = f2bf(w2[c * 64 + d]);
        }
    }
    {
        bf16_t* dst = (bf16_t*)(ws + WS_SWS);
        for (size_t i = gtid; i < (size_t)8 * 128 * 128; i += gsz) { const int t = (int)((i >> 7) & 127), s = (int)(i & 127); dst[i] = f2bf(s <= t ? P.sgu_w_s[i] : 0.f); }
    }
    {
        float* cs = (float*)(ws + WS_CS);
        for (size_t i = gtid; i < (size_t)MTOK * 8; i += gsz) {
            const int row = (int)(i >> 3), f = (int)(i & 7);
            const float inv = (float)pow(500000.0, -(double)(2 * f) / 16.0);
            const float ang = (float)P.positions[row] * inv;
            float sv, cv; sincosf(ang, &sv, &cv);
            cs[(size_t)row * 16 + f] = cv; cs[(size_t)row * 16 + 8 + f] = sv;
        }
    }
    {
        const int lane = tid & 63; const int gw = obid() * 8 + (tid >> 6), nw = ogdim() * 8;
        bf16_t* XBp = (bf16_t*)(ws + WS_H2); float* rss7 = (float*)(ws + WS_RSS) + (size_t)7 * MTOK * 16;
        for (int row = gw; row < MTOK; row += nw) {
            const f32x4* xr = (const f32x4*)(P.x + (size_t)row * 1024); float ss = 0.f;
#pragma unroll
            for (int i = 0; i < 4; ++i) { const f32x4 v = xr[lane + 64 * i]; ss += v[0] * v[0] + v[1] * v[1] + v[2] * v[2] + v[3] * v[3];
                u32x2 w; w.x = pk_bf16(v[0], v[1]); w.y = pk_bf16(v[2], v[3]); ((u32x2*)(XBp + (size_t)row * 1024))[lane + 64 * i] = w; }
#pragma unroll
            for (int o = 32; o >= 1; o >>= 1) ss += __shfl_xor(ss, o);
            if (lane < 16) rss7[(size_t)row * 16 + lane] = (lane == 0) ? ss : 0.f;
        }
    }
    for (int item = obid(); item < 256; item += ogdim()) {
        const int job = item >> 6, chunk = item & 63; const int l = job >> 1, kv = job & 1;
        const float* pos = (kv ? P.nsa_cmp_pos_v : P.nsa_cmp_pos_k) + (size_t)l * 2048;
        const float* w1 = (kv ? P.nsa_cmp_v_w1 : P.nsa_cmp_k_w1) + (size_t)l * 2048 * 256;
        const int c = tid & 255, hf = tid >> 8;
        float a = 0.f;
        const int r0 = chunk * 32 + hf * 16;
#pragma unroll
        for (int r = 0; r < 16; ++r) a += pos[r0 + r] * w1[(size_t)(r0 + r) * 256 + c];
        LAS float* red = (LAS float*)lds;
        __syncthreads();
        if (hf == 1) red[c] = a;
        __syncthreads();
        if (hf == 0) ((float*)(ws + WS_CBPART))[(size_t)item * 256 + c] = a + red[c];
        __syncthreads();
    }
}
__device__ void cbias_reduce(unsigned char* ws, int l) {
    const int tid = otid(); const int kv = tid >> 8, c = tid & 255;
    const float* part = (const float*)(ws + WS_CBPART) + (size_t)(l * 2 + kv) * 64 * 256 + c;
    float a = 0.f;
#pragma unroll 16
    for (int ch = 0; ch < 64; ++ch) a += part[(size_t)ch * 256];
    ((float*)(ws + WS_CBIAS))[l * 512 + tid] = a;
}

__device__ void rmsnorm_phase(const float* X, const float* g, bf16_t* H, float* outf) {
    const int lane = otid() & 63; const int gw = obid() * 8 + (otid() >> 6), nw = ogdim() * 8;
    f32x4 gv[4];
#pragma unroll
    for (int i = 0; i < 4; ++i) gv[i] = ((const f32x4*)g)[lane + 64 * i];
    for (int row = gw; row < MTOK; row += nw) {
        const f32x4* xr = (const f32x4*)(X + (size_t)row * 1024);
        f32x4 v[4]; float ss = 0.f;
#pragma unroll
        for (int i = 0; i < 4; ++i) { v[i] = xr[lane + 64 * i]; ss += v[i][0] * v[i][0] + v[i][1] * v[i][1] + v[i][2] * v[i][2] + v[i][3] * v[i][3]; }
#pragma unroll
        for (int o = 32; o >= 1; o >>= 1) ss += __shfl_xor(ss, o);
        const float rstd = rsqrtf(ss * (1.0f / 1024.0f) + 1e-6f);
        if (outf) {
#pragma unroll
            for (int i = 0; i < 4; ++i) ((f32x4*)(outf + (size_t)row * 1024))[lane + 64 * i] = v[i] * rstd * gv[i];
        } else {
#pragma unroll
            for (int i = 0; i < 4; ++i) { const f32x4 y = v[i] * rstd * gv[i]; u32x2 w; w.x = pk_bf16(y[0], y[1]); w.y = pk_bf16(y[2], y[3]); ((u32x2*)(H + (size_t)row * 1024))[lane + 64 * i] = w; }
        }
    }
}

__device__ void final_norm_phase(const bf16_t* XB, const float* g, float* out) {
    const int lane = otid() & 63; const int gw = obid() * 8 + (otid() >> 6), nw = ogdim() * 8;
    for (int row = gw; row < MTOK; row += nw) {
        const u32x4* xr = (const u32x4*)(XB + (size_t)row * 1024);
        float v[2][8]; float ss = 0.f;
#pragma unroll
        for (int i = 0; i < 2; ++i) { const u32x4 w = xr[lane + 64 * i];
            v[i][0] = __uint_as_float(w.x << 16); v[i][1] = __uint_as_float(w.x & 0xffff0000u); v[i][2] = __uint_as_float(w.y << 16); v[i][3] = __uint_as_float(w.y & 0xffff0000u);
            v[i][4] = __uint_as_float(w.z << 16); v[i][5] = __uint_as_float(w.z & 0xffff0000u); v[i][6] = __uint_as_float(w.w << 16); v[i][7] = __uint_as_float(w.w & 0xffff0000u);
#pragma unroll
            for (int e = 0; e < 8; ++e) ss += v[i][e] * v[i][e]; }
#pragma unroll
        for (int o = 32; o >= 1; o >>= 1) ss += __shfl_xor(ss, o);
        const float rstd = rsqrtf(ss * (1.0f / 1024.0f) + 1e-6f);
#pragma unroll
        for (int i = 0; i < 2; ++i) { const int c0 = (lane + 64 * i) * 8;
            const f32x4 g0 = *(const f32x4*)(g + c0), g1 = *(const f32x4*)(g + c0 + 4);
            f32x4 o0, o1;
#pragma unroll
            for (int e = 0; e < 4; ++e) { o0[e] = v[i][e] * rstd * g0[e]; o1[e] = v[i][4 + e] * rstd * g1[e]; }
            *(f32x4*)(out + (size_t)row * 1024 + c0) = o0; *(f32x4*)(out + (size_t)row * 1024 + c0 + 4) = o1; }
    }
}

#define MFMA32(a, b, c) __builtin_amdgcn_mfma_f32_32x32x16_bf16((a), (b), (c), 0, 0, 0)
__device__ __forceinline__ int crow16(int i, int h) { return (i & 3) + 8 * (i >> 2) + 4 * h; }
__device__ __forceinline__ f32x16 zero16() { f32x16 z; for (int i = 0; i < 16; ++i) z[i] = 0.f; return z; }
__device__ void cmp2_local(const bf16_t* CH, const bf16_t* w2T, bf16_t* KCMP, bf16_t* VCMPT, int L) {
    const int tid = otid(), w = tid >> 6, lane = tid & 63, r = lane & 31, h = lane >> 5;
    const int type = L >> 5;
    const bf16_t* wp = w2T + (size_t)type * 64 * 256 + 8 * h;
    const bf16_t* chp = CH + ((size_t)L * 256 + w * 32 + r) * 256 + 8 * h;
    f32x16 acc[2]; acc[0] = zero16(); acc[1] = zero16();
#pragma unroll 4
    for (int s = 0; s < 16; ++s) {
        const bf16x8 cf = *(const bf16x8*)(chp + 16 * s);
#pragma unroll
        for (int db = 0; db < 2; ++db) {
            const bf16x8 wf = *(const bf16x8*)(wp + (size_t)(32 * db + r) * 256 + 16 * s);
            acc[db] = (type == 0) ? MFMA32(wf, cf, acc[db]) : MFMA32(cf, wf, acc[db]);
        }
    }
    const int Rl0 = (L & 31) * 256 + w * 32;
#pragma unroll
    for (int db = 0; db < 2; ++db)
#pragma unroll
        for (int q4 = 0; q4 < 4; ++q4) {
            u32x2 o; o.x = pk_bf16(acc[db][4 * q4 + 0], acc[db][4 * q4 + 1]); o.y = pk_bf16(acc[db][4 * q4 + 2], acc[db][4 * q4 + 3]);
            if (type == 0) *(u32x2*)(KCMP + (size_t)(Rl0 + r) * 64 + 32 * db + 8 * q4 + 4 * h) = o;
            else *(u32x2*)(VCMPT + ((size_t)(Rl0 >> 8) * 64 + 32 * db + r) * 256 + (Rl0 & 255) + 8 * q4 + 4 * h) = o;
        }
}


__device__ __forceinline__ void qk_tile(const bf16_t* Kt  , const bf16x8 (&Qf)[4], f32x16 (&ST)[2], int r, int h) {
#pragma unroll
    for (int kb = 0; kb < 2; ++kb) {
        f32x16 a = zero16();
#pragma unroll
        for (int s = 0; s < 4; ++s) { const bf16x8 kf = *(const bf16x8*)(Kt + (size_t)(32 * kb + r) * 64 + 16 * s + 8 * h); a = MFMA32(kf, Qf[s], a); }
        ST[kb] = a;
    }
}
__device__ __forceinline__ bf16x8 pack8(const f32x16& x, int s2) {
    u32x4 p; p.x = pk_bf16(x[8 * s2 + 0], x[8 * s2 + 1]); p.y = pk_bf16(x[8 * s2 + 2], x[8 * s2 + 3]); p.z = pk_bf16(x[8 * s2 + 4], x[8 * s2 + 5]); p.w = pk_bf16(x[8 * s2 + 6], x[8 * s2 + 7]);
    return __builtin_bit_cast(bf16x8, p);
}
__device__ __forceinline__ void pv_tile(const bf16_t* Vt  , int ldv, const f32x16 (&Pm)[2], f32x16 (&O)[2], int r, int h) {
#pragma unroll
    for (int kb = 0; kb < 2; ++kb)
#pragma unroll
        for (int s2 = 0; s2 < 2; ++s2) {
            const bf16x8 pf = pack8(Pm[kb], s2);
#pragma unroll
            for (int db = 0; db < 2; ++db) {
                const bf16_t* vp = Vt + (size_t)(32 * db + r) * ldv + 32 * kb + 16 * s2 + 4 * h;
                const s16x4 lo = *(const s16x4*)vp, hi = *(const s16x4*)(vp + 8);
                const bf16x8 vf = __builtin_shufflevector(lo, hi, 0, 1, 2, 3, 4, 5, 6, 7);
                O[db] = MFMA32(vf, pf, O[db]);
            }
        }
}
constexpr int KB_BYTES = 64 * 144, VB_BYTES = 64 * 136, STG_BYTES = KB_BYTES + VB_BYTES;
constexpr int ATT_STAGE_OFF = 65536 + 512;
__device__ __forceinline__ float ex2(float x) { return __builtin_amdgcn_exp2f(x); }
__device__ __forceinline__ float xor8_add(float x) { const int y = __builtin_amdgcn_update_dpp(0, __float_as_int(x), 0x128, 0xf, 0xf, false); return x + __int_as_float(y); }
__device__ __forceinline__ float xor16_add(float x) { auto rr = __builtin_amdgcn_permlane16_swap(__float_as_uint(x), __float_as_uint(x), false, false); return __uint_as_float(rr[0]) + __uint_as_float(rr[1]); }
__device__ __forceinline__ float max3f(float a, float b, float c) { float r; asm("v_max3_f32 %0, %1, %2, %3" : "=v"(r) : "v"(a), "v"(b), "v"(c)); return r; }

__device__ __forceinline__ void qk_lds(const LAS unsigned char* kb_, unsigned kr_off, const bf16x8 (&Qf)[4], f32x16 (&ST)[2]) {
#pragma unroll
    for (int kb = 0; kb < 2; ++kb) {
        f32x16 a = zero16();
#pragma unroll
        for (int s = 0; s < 4; ++s) { const bf16x8 kf = *(const LAS bf16x8*)(kb_ + kr_off + kb * 32 * 144 + s * 32); a = MFMA32(kf, Qf[s], a); }
        ST[kb] = a;
    }
}
__device__ __forceinline__ void pv_lds(const LAS unsigned char* vb_, unsigned vr_off, const f32x16 (&Pm)[2], f32x16 (&O)[2]) {
#pragma unroll
    for (int kb = 0; kb < 2; ++kb)
#pragma unroll
        for (int s2 = 0; s2 < 2; ++s2) {
            const bf16x8 pf = pack8(Pm[kb], s2);
#pragma unroll
            for (int db = 0; db < 2; ++db) {
                const LAS unsigned char* vp = vb_ + vr_off + db * 32 * 136 + kb * 64 + s2 * 32;
                const s16x4 lo = *(const LAS s16x4*)vp, hi = *(const LAS s16x4*)(vp + 16);
                const bf16x8 vf = __builtin_shufflevector(lo, hi, 0, 1, 2, 3, 4, 5, 6, 7);
                O[db] = MFMA32(vf, pf, O[db]);
            }
        }
}
template <bool MASKED> __device__ __forceinline__ void softmax2(f32x16 (&ST)[2], unsigned vm, bool rowon, float& m_run, float& l_run, f32x16 (&O)[2]) {
    float mx = -1e30f;
    if (MASKED) {
#pragma unroll
        for (int kb = 0; kb < 2; ++kb)
#pragma unroll
            for (int i = 0; i < 16; ++i) { const bool v = (vm >> (16 * kb + i)) & 1u; mx = fmaxf(mx, v ? ST[kb][i] : -1e30f); }
    } else {
#pragma unroll
        for (int kb = 0; kb < 2; ++kb)
#pragma unroll
            for (int i = 0; i < 16; i += 2) mx = max3f(mx, ST[kb][i], ST[kb][i + 1]);
        mx = rowon ? mx : -1e30f;
    }
    if (__any(mx > m_run + 8.0f)) {
        const float mo = fmaxf(mx, __shfl_xor(mx, 32));
        const float m_new = fmaxf(m_run, mo);
        const float alpha = ex2(m_run - m_new);
        l_run *= alpha; m_run = m_new;
#pragma unroll
        for (int db = 0; db < 2; ++db) O[db] = O[db] * alpha;
    }
    float rs0 = 0.f, rs1 = 0.f;
    if (MASKED) {
#pragma unroll
        for (int kb = 0; kb < 2; ++kb)
#pragma unroll
            for (int i = 0; i < 16; ++i) { const bool v = (vm >> (16 * kb + i)) & 1u; const float p = v ? ex2(ST[kb][i] - m_run) : 0.f; ST[kb][i] = p; rs0 += p; }
    } else {
        const float m_use = rowon ? m_run : __builtin_inff();
#pragma unroll
        for (int kb = 0; kb < 2; ++kb)
#pragma unroll
            for (int i = 0; i < 16; i += 2) { const float p0 = ex2(ST[kb][i] - m_use), p1 = ex2(ST[kb][i + 1] - m_use); ST[kb][i] = p0; ST[kb][i + 1] = p1; rs0 += p0; rs1 += p1; }
    }
    l_run += rs0 + rs1;
}

template <int MODE> __device__ __forceinline__ void attn_branch(const bf16_t* Kg, const bf16_t* Vg, int ldv, int kt0, int kt1, const bf16x8 (&Qf)[4], int t, int qb, unsigned long long mysel,
                                                                float& m_run, float& l_run, float inv_l, f32x16 (&O)[2], LAS float* psw, LAS unsigned char* stage, int tid, int r, int h,
                                                                u32x4& kreg, u32x4& vreg, bool pre, const bf16_t* nK, const bf16_t* nV, int nldv) {
    const int srow = tid >> 3, sch = tid & 7;
    const bf16_t* kp = Kg + (size_t)kt0 * 4096 + srow * 64 + sch * 8;
    const bf16_t* vp = Vg + (size_t)srow * ldv + (size_t)kt0 * 64 + sch * 8;
    if (!pre) { kreg = *(const u32x4*)kp; if (MODE != 0) vreg = *(const u32x4*)vp; }
    const unsigned kw_off = srow * 144 + sch * 16, vw_off = srow * 136 + sch * 16;
    const unsigned kr_off = r * 144 + h * 16, vr_off = r * 136 + h * 8;
    const int nmax = (t >= 31) ? ((t - 31) >> 4) : -1;
    __syncthreads();
    *(LAS u32x4*)(stage + kw_off) = kreg;
    if (MODE != 0) { *(LAS u32x2*)(stage + KB_BYTES + vw_off) = (u32x2){vreg.x, vreg.y}; *(LAS u32x2*)(stage + KB_BYTES + vw_off + 8) = (u32x2){vreg.z, vreg.w}; }
    __syncthreads();
    for (int kt = kt0; kt <= kt1; ++kt) {
        const int cur = (kt - kt0) & 1;
        if (kt < kt1) { kp += 4096; kreg = *(const u32x4*)kp; if (MODE != 0) { vp += 64; vreg = *(const u32x4*)vp; } }
        else if (nK) { kreg = *(const u32x4*)(nK + srow * 64 + sch * 8); if (nV) vreg = *(const u32x4*)(nV + (size_t)srow * nldv + sch * 8); }
        const LAS unsigned char* kb_ = stage + cur * STG_BYTES; const LAS unsigned char* vb_ = kb_ + KB_BYTES;
        bool selb = true, active = true;
        if (MODE == 2) { selb = (mysel >> kt) & 1ull; active = (__ballot(selb) != 0ull); }
        if (active) {
            f32x16 ST[2]; qk_lds(kb_, kr_off, Qf, ST);
            if (MODE == 0) {
                unsigned vm = 0u;
#pragma unroll
                for (int kb = 0; kb < 2; ++kb)
#pragma unroll
                    for (int i = 0; i < 16; ++i) { const int n = 64 * kt + 32 * kb + crow16(i, h); if (n <= nmax) vm |= 1u << (16 * kb + i); }
                softmax2<true>(ST, vm, true, m_run, l_run, O);
            } else if (MODE == 1) {
#pragma unroll
                for (int kb = 0; kb < 2; ++kb)
#pragma unroll
                    for (int i = 0; i < 16; ++i) {
                        const int n = 64 * kt + 32 * kb + crow16(i, h);
                        const float p = (n <= nmax) ? ex2(ST[kb][i] - m_run) * inv_l : 0.f; ST[kb][i] = p;
                        const float ps = xor16_add(xor8_add(p));
                        if (r < 8) psw[r * 256 + n] = ps;
                    }
                pv_lds(vb_, vr_off, ST, O);
            } else {
                const bool edge = (MODE == 2) ? (kt == qb) : (kt == qb || kt == qb - 8);
                if (edge) {
                    unsigned vm = 0u;
#pragma unroll
                    for (int kb = 0; kb < 2; ++kb)
#pragma unroll
                        for (int i = 0; i < 16; ++i) {
                            const int kp_ = 64 * kt + 32 * kb + crow16(i, h);
                            const bool v = (MODE == 2) ? (selb && kp_ <= t) : (kp_ <= t && kp_ + 512 > t);
                            if (v) vm |= 1u << (16 * kb + i);
                        }
                    softmax2<true>(ST, vm, true, m_run, l_run, O);
                } else {
                    softmax2<false>(ST, 0u, selb, m_run, l_run, O);
                }
                pv_lds(vb_, vr_off, ST, O);
            }
        }
        if (kt < kt1) {
            LAS unsigned char* nb = stage + (cur ^ 1) * STG_BYTES;
            *(LAS u32x4*)(nb + kw_off) = kreg;
            if (MODE != 0) { *(LAS u32x2*)(nb + KB_BYTES + vw_off) = (u32x2){vreg.x, vreg.y}; *(LAS u32x2*)(nb + KB_BYTES + vw_off + 8) = (u32x2){vreg.z, vreg.w}; }
        }
        __syncthreads();
    }
}

__device__ void nsa_attn_phase(const bf16_t* Q, const bf16_t* KV, const bf16_t* KCMP, const bf16_t* VCMPT, const float* gates, bf16_t* AO, LAS unsigned char* lds) {
    const int tid = otid(), wid = tid >> 6, lane = tid & 63, r = lane & 31, h = lane >> 5;
    LAS float* psw = (LAS float*)lds + wid * 2048;
    LAS unsigned long long* selw = (LAS unsigned long long*)(lds + 65536) + wid * 8;
    LAS unsigned char* stage = lds + ATT_STAGE_OFF;
    if (wid < 4) __builtin_amdgcn_s_setprio(2);
    const int G = ogdim();
    for (int idx = obid(); idx < 2048; idx += G) {
        const int vb = idx & 255, jj = idx >> 8;
        const int xcd = vb & 7, slot = vb >> 3;
        const int bg = xcd * 4 + (jj >> 1);
        const int qb = (jj & 1) ? (63 - slot) : slot;
        const int b = bg >> 2, g = bg & 3;
        const int head = g * 4 + (r >> 3);
        const int tok = wid * 8 + (r & 7);
        const int t = qb * 64 + tok;
        bf16x8 Qf[4];
        { const bf16_t* qp = Q + ((size_t)(b * 16 + head) * 4096 + t) * 64 + 8 * h;
#pragma unroll
          for (int s = 0; s < 4; ++s) Qf[s] = *(const bf16x8*)(qp + 16 * s); }
        f32x16 OUT[2];
#pragma unroll
        for (int i = 0; i < 32; ++i) psw[lane + 64 * i] = 0.f;
        {
            const bf16_t* Kc = KCMP + (size_t)bg * 256 * 64; const bf16_t* Vc = VCMPT + (size_t)bg * 64 * 256;
            int ntc = ((4 * qb + 2) >> 6) + 1; if (ntc > 4) ntc = 4;
            float m_run = -1e30f, l_run = 0.f;
            f32x16 O[2]; O[0] = zero16(); O[1] = zero16();
            u32x4 kst = {0u, 0u, 0u, 0u}, vst = {0u, 0u, 0u, 0u};
            attn_branch<0>(Kc, Vc, 256, 0, ntc - 1, Qf, t, qb, 0ull, m_run, l_run, 0.f, O, psw, stage, tid, r, h, kst, vst, false, Kc, Vc, 256);
            l_run += __shfl_xor(l_run, 32);
            const float inv_l = l_run > 0.f ? __builtin_amdgcn_rcpf(l_run) : 0.f;
            attn_branch<1>(Kc, Vc, 256, 0, ntc - 1, Qf, t, qb, 0ull, m_run, l_run, inv_l, O, psw, stage, tid, r, h, kst, vst, true, nullptr, nullptr, 0);
            const int t_ = otid(); const int r_ = t_ & 31; const size_t rowg_ = (size_t)b * 4096 + qb * 64 + (t_ >> 6) * 8 + (r_ & 7);
            const float g_c = gates[rowg_ * 48 + g * 4 + (r_ >> 3)];
#pragma unroll
            for (int db = 0; db < 2; ++db) OUT[db] = O[db] * g_c;
        }
        __syncthreads();
        for (int tk = 0; tk < 8; ++tk) {
            const int mblk = lane;
            float imp = 0.f;
#pragma unroll
            for (int j = -1; j <= 3; ++j) { const int n = 4 * mblk + j; if (n >= 0) imp += psw[tk * 256 + n]; }
            if (mblk == 0 || mblk == qb || mblk == qb - 1) imp = 1e9f;
            if (mblk > qb) imp = -1e30f;
            int rank = 0;
#pragma unroll 8
            for (int mp = 0; mp < 64; ++mp) { const float o = __int_as_float(__builtin_amdgcn_readlane(__float_as_int(imp), mp)); rank += (o > imp || (o == imp && mp < mblk)) ? 1 : 0; }
            unsigned long long msk = __ballot(rank < 16);
            msk &= (qb >= 63) ? ~0ull : ((2ull << qb) - 1ull);
            if (lane == 0) selw[tk] = msk;
        }
        __syncthreads();
        const unsigned long long mysel = selw[r & 7];
#pragma unroll
        for (int db = 0; db < 2; ++db)
#pragma unroll
            for (int i = 0; i < 16; ++i) psw[(db * 16 + i) * 64 + lane] = OUT[db][i];
        u32x4 kst2 = {0u, 0u, 0u, 0u}, vst2 = {0u, 0u, 0u, 0u};
        {
            const bf16_t* Ks = KV + 2 * KVSZ + (size_t)bg * 4096 * 64; const bf16_t* Vs = KV + 3 * KVSZ + (size_t)bg * 64 * 4096;
            float m_run = -1e30f, l_run = 0.f; f32x16 O[2]; O[0] = zero16(); O[1] = zero16();
            attn_branch<2>(Ks, Vs, 4096, 0, qb, Qf, t, qb, mysel, m_run, l_run, 0.f, O, psw, stage, tid, r, h, kst2, vst2, false,
                           KV + 4 * KVSZ + (size_t)bg * 4096 * 64 + (size_t)(qb > 8 ? qb - 8 : 0) * 4096, KV + 5 * KVSZ + (size_t)bg * 64 * 4096 + (size_t)(qb > 8 ? qb - 8 : 0) * 64, 4096);
            l_run += __shfl_xor(l_run, 32);
            const int t_ = otid(); const int r_ = t_ & 31; const size_t rowg_ = (size_t)b * 4096 + qb * 64 + (t_ >> 6) * 8 + (r_ & 7);
            const float sc = (l_run > 0.f ? __builtin_amdgcn_rcpf(l_run) : 0.f) * gates[rowg_ * 48 + 16 + g * 4 + (r_ >> 3)];
#pragma unroll
            for (int db = 0; db < 2; ++db)
#pragma unroll
                for (int i = 0; i < 16; ++i) psw[(db * 16 + i) * 64 + lane] += O[db][i] * sc;
        }
        {
            const bf16_t* Kw = KV + 4 * KVSZ + (size_t)bg * 4096 * 64; const bf16_t* Vw = KV + 5 * KVSZ + (size_t)bg * 64 * 4096;
            float m_run = -1e30f, l_run = 0.f; f32x16 O[2]; O[0] = zero16(); O[1] = zero16();
            attn_branch<3>(Kw, Vw, 4096, (qb > 8 ? qb - 8 : 0), qb, Qf, t, qb, 0ull, m_run, l_run, 0.f, O, psw, stage, tid, r, h, kst2, vst2, true, nullptr, nullptr, 0);
            l_run += __shfl_xor(l_run, 32);
            const int t_ = otid(); const int r_ = t_ & 31; const size_t rowg_ = (size_t)b * 4096 + qb * 64 + (t_ >> 6) * 8 + (r_ & 7);
            const float sc = (l_run > 0.f ? __builtin_amdgcn_rcpf(l_run) : 0.f) * gates[rowg_ * 48 + 32 + g * 4 + (r_ >> 3)];
#pragma unroll
            for (int db = 0; db < 2; ++db)
#pragma unroll
                for (int i = 0; i < 16; ++i) OUT[db][i] = psw[(db * 16 + i) * 64 + lane] + O[db][i] * sc;
        }
        {
            const int t_ = otid(); const int r_ = t_ & 31, h_ = (t_ >> 5) & 1; const size_t rowg_ = (size_t)b * 4096 + qb * 64 + (t_ >> 6) * 8 + (r_ & 7);
            bf16_t* op = AO + rowg_ * 1024 + (g * 4 + (r_ >> 3)) * 64;
#pragma unroll
            for (int db = 0; db < 2; ++db)
#pragma unroll
                for (int q4 = 0; q4 < 4; ++q4) {
                    u32x2 w; w.x = pk_bf16(OUT[db][4 * q4 + 0], OUT[db][4 * q4 + 1]); w.y = pk_bf16(OUT[db][4 * q4 + 2], OUT[db][4 * q4 + 3]);
                    *(u32x2*)(op + 32 * db + 8 * q4 + 4 * h_) = w;
                }
        }
    }
    __builtin_amdgcn_s_setprio(0);
    __syncthreads();
}


__device__ void sgu_spatial_phase(const bf16_t* UV, const float* lng, const float* lnb, const bf16_t* SWS, const float* bs, bf16_t* GATED, LAS unsigned char* lds) {
    constexpr int LDV = 136;
    LAS bf16_t* vnT = (LAS bf16_t*)lds;
    LAS float* mu = (LAS float*)(lds + 128 * LDV * 2); LAS float* rsd = mu + 128;
    const int tid = otid(), wid = tid >> 6, lane = tid & 63, r = lane & 31, h = lane >> 5;
    for (int cn = obid(); cn < 256; cn += ogdim()) {
        const size_t tok0 = (size_t)cn * 128;
        __syncthreads();
#pragma unroll 4
        for (int rr = 0; rr < 16; ++rr) {
            const int sl = wid * 16 + rr;
            const u32x4* vp = (const u32x4*)(UV + (tok0 + sl) * 2048 + 1024);
            float s1 = 0.f, s2 = 0.f;
#pragma unroll
            for (int i = 0; i < 2; ++i) { const u32x4 w = vp[lane + 64 * i];
#pragma unroll
                for (int j = 0; j < 4; ++j) { const float a = __uint_as_float(w[j] << 16), c = __uint_as_float(w[j] & 0xffff0000u); s1 += a + c; s2 += a * a + c * c; } }
#pragma unroll
            for (int o = 32; o >= 1; o >>= 1) { s1 += __shfl_xor(s1, o); s2 += __shfl_xor(s2, o); }
            const float mean = s1 * (1.0f / 1024.0f); const float var = fmaxf(s2 * (1.0f / 1024.0f) - mean * mean, 0.f);
            if (lane == 0) { mu[sl] = mean; rsd[sl] = rsqrtf(var + 1e-5f); }
        }
        __syncthreads();
        for (int g = 0; g < 8; ++g) {
            {
                const int sl = tid >> 2, cq = tid & 3;
                const float mean = mu[sl], rs = rsd[sl];
                const bf16_t* vp = UV + (tok0 + sl) * 2048 + 1024 + g * 128 + cq * 32;
#pragma unroll
                for (int i = 0; i < 4; ++i) {
                    const u32x4 w = *(const u32x4*)(vp + i * 8);
                    const int c0 = cq * 32 + i * 8;
                    const f32x4 ga = *(const f32x4*)(lng + g * 128 + c0), gb = *(const f32x4*)(lng + g * 128 + c0 + 4);
                    const f32x4 ba = *(const f32x4*)(lnb + g * 128 + c0), bb = *(const f32x4*)(lnb + g * 128 + c0 + 4);
#pragma unroll
                    for (int j = 0; j < 4; ++j) {
                        const float a = __uint_as_float(w[j] << 16), c = __uint_as_float(w[j] & 0xffff0000u);
                        const float gA = (2 * j < 4) ? ga[(2 * j) & 3] : gb[(2 * j) & 3], gB = (2 * j + 1 < 4) ? ga[(2 * j + 1) & 3] : gb[(2 * j + 1) & 3];
                        const float bA = (2 * j < 4) ? ba[(2 * j) & 3] : bb[(2 * j) & 3], bB = (2 * j + 1 < 4) ? ba[(2 * j + 1) & 3] : bb[(2 * j + 1) & 3];
                        vnT[(c0 + 2 * j) * LDV + sl] = f2bf((a - mean) * rs * gA + bA);
                        vnT[(c0 + 2 * j + 1) * LDV + sl] = f2bf((c - mean) * rs * gB + bB);
                    }
                }
            }
            __syncthreads();
            const int tb = wid & 3, ch = wid >> 2;
            f32x16 acc[2]; acc[0] = zero16(); acc[1] = zero16();
            const bf16_t* wsp = SWS + ((size_t)g * 128 + tb * 32 + r) * 128 + 8 * h;
            for (int ks = 0; ks <= 2 * tb + 1; ++ks) {
                const bf16x8 bfrag = *(const bf16x8*)(wsp + 16 * ks);
#pragma unroll
                for (int cb = 0; cb < 2; ++cb) {
                    const bf16x8 afrag = *(const LAS bf16x8*)(vnT + (ch * 64 + cb * 32 + r) * LDV + 16 * ks + 8 * h);
                    acc[cb] = MFMA32(afrag, bfrag, acc[cb]);
                }
            }
            const int tl = tb * 32 + r; const size_t token = tok0 + tl;
            const float bias = bs[g * 128 + tl];
#pragma unroll
            for (int cb = 0; cb < 2; ++cb)
#pragma unroll
                for (int q4 = 0; q4 < 4; ++q4) {
                    const int c0 = g * 128 + ch * 64 + cb * 32 + 8 * q4 + 4 * h;
                    const u32x2 uw = *(const u32x2*)(UV + token * 2048 + c0);
                    const float u0 = __uint_as_float(uw.x << 16), u1 = __uint_as_float(uw.x & 0xffff0000u), u2 = __uint_as_float(uw.y << 16), u3 = __uint_as_float(uw.y & 0xffff0000u);
                    u32x2 w; w.x = pk_bf16(u0 * (acc[cb][4 * q4 + 0] + bias), u1 * (acc[cb][4 * q4 + 1] + bias)); w.y = pk_bf16(u2 * (acc[cb][4 * q4 + 2] + bias), u3 * (acc[cb][4 * q4 + 3] + bias));
                    *(u32x2*)(GATED + token * 1024 + c0) = w;
                }
            __syncthreads();
        }
    }
    __syncthreads();
}

__device__ void pool_diff_phase(const float* __restrict__ Z, bf16_t* __restrict__ Dd) {
    const size_t gtid = (size_t)obid() * 512 + otid(), gsz = (size_t)ogdim() * 512;
    for (size_t idx = gtid; idx < (size_t)256 * 1024; idx += gsz) {
        const int c4 = (int)(idx & 255), seg = (int)(idx >> 8);
        const int t0 = seg * 32, s0 = t0 & 4095; const int w = 2 << (c4 >> 6);
        const f32x4* zp = (const f32x4*)Z + c4;
        f32x4 S = {0.f, 0.f, 0.f, 0.f};
        const int jlo = (s0 - w > 0) ? (s0 - w) : 0;
        for (int j = jlo; j < s0; ++j) S = S + zp[(size_t)(t0 - s0 + j) * 256];
#pragma unroll 8
        for (int i = 0; i < 32; ++i) {
            const int s = s0 + i; const f32x4 zt = zp[(size_t)(t0 + i) * 256];
            S = S + zt; if (s - w >= 0) S = S - zp[(size_t)(t0 + i - w) * 256];
            const float inv = 1.0f / (float)((s + 1 < w) ? (s + 1) : w);
            const f32x4 d = S * inv - zt;
            u32x2 o; o.x = pk_bf16(d[0], d[1]); o.y = pk_bf16(d[2], d[3]);
            *(u32x2*)(Dd + (size_t)(t0 + i) * 1024 + c4 * 4) = o;
        }
    }
}

#define XB_TMO      128
#define XB_XCNT(j)  (256  + 64 * (j))
#define XB_XSUB(j)  (1280 + 64 * (j))
#define XB_XGEN(j)  (2304 + 64 * (j))
#define XB_TOP      3328
#define XB_TOPGEN   3392
#define XCD_BAR_WORDS 3456
#define XB_SPIN_CAP (1u << 18)

__device__ __forceinline__ unsigned xb_ld(unsigned* p)              { return __hip_atomic_load(p, __ATOMIC_RELAXED, __HIP_MEMORY_SCOPE_AGENT); }
__device__ __forceinline__ unsigned xb_add(unsigned* p, unsigned v) { return __hip_atomic_fetch_add(p, v, __ATOMIC_RELAXED, __HIP_MEMORY_SCOPE_AGENT); }
__device__ __forceinline__ unsigned xb_xcc_id() { return (unsigned)__builtin_amdgcn_s_getreg((3 << 11) | 20) & 0xFu; }
#define XB_SPIN(cond, bar) do { unsigned _sp = 0; while (cond) { __builtin_amdgcn_s_sleep(1); \
    if ((++_sp & 255u) == 0u) { if (xb_ld(&(bar)[XB_TMO])) break; if (_sp > XB_SPIN_CAP) { atomicAdd(&(bar)[XB_TMO], 1u); break; } } } } while (0)

struct XcdBarrier {
    unsigned* bar; unsigned x;
    volatile LAS unsigned* st;
};

__device__ __forceinline__ XcdBarrier xcd_barrier_post(unsigned* bar, volatile LAS unsigned* st) {
    XcdBarrier b; b.bar = bar; b.x = xb_xcc_id(); b.st = st;
    if (threadIdx.x == 0) (void)xb_add(&bar[XB_XCNT(b.x)], 1u);
    return b;
}
__device__ __forceinline__ void xcd_barrier_complete(unsigned* bar, unsigned x, unsigned& nloc, unsigned& nx) {
    const unsigned G = gridDim.x * gridDim.y * gridDim.z;
    unsigned sum, cnt, mine, sp = 0u;
    for (;;) {
        sum = 0u; cnt = 0u; mine = 0u;
#pragma unroll
        for (unsigned j = 0; j < 16; ++j) { const unsigned c = xb_ld(&bar[XB_XCNT(j)]); sum += c; cnt += (c > 0u) ? 1u : 0u; mine = (j == x) ? c : mine; }
        if (sum == G) break;
        __builtin_amdgcn_s_sleep(1);
        if ((++sp & 255u) == 0u) { if (xb_ld(&bar[XB_TMO])) break; if (sp > XB_SPIN_CAP) { atomicAdd(&bar[XB_TMO], 1u); break; } }
    }
    nloc = mine > 0u ? mine : 1u; nx = cnt > 0u ? cnt : 1u;
}

__device__ __forceinline__ void xcd_barrier(const XcdBarrier& b) {
    asm volatile("s_waitcnt vmcnt(0)" ::: "memory");
    __syncthreads();
    if (threadIdx.x == 0) {
        unsigned* bar = b.bar;
        __builtin_amdgcn_s_waitcnt(0);
        unsigned nloc = b.st[0], nx = b.st[1];
        if (nloc == 0u) { xcd_barrier_complete(bar, b.x, nloc, nx); b.st[0] = nloc; b.st[1] = nx; }
        const unsigned old = xb_add(&bar[XB_XSUB(b.x)], 1u);
        const unsigned gen = old / nloc;
        if (old + 1u == (gen + 1u) * nloc) {
            __builtin_amdgcn_fence(__ATOMIC_RELEASE, "agent");
            asm volatile("s_waitcnt vmcnt(0)" ::: "memory");
            const unsigned og = xb_add(&bar[XB_TOP], 1u);
            const unsigned tg = og / nx;
            if (og + 1u == (tg + 1u) * nx) xb_add(&bar[XB_TOPGEN], 1u);
            else XB_SPIN(xb_ld(&bar[XB_TOPGEN]) == tg, bar);
            __builtin_amdgcn_fence(__ATOMIC_ACQUIRE, "agent");
            xb_add(&bar[XB_XGEN(b.x)], 1u);
            asm volatile("s_waitcnt vmcnt(0)" ::: "memory");
        } else {
            XB_SPIN(xb_ld(&bar[XB_XGEN(b.x)]) == gen, bar);
            __builtin_amdgcn_fence(__ATOMIC_ACQUIRE, "agent");
            asm volatile("s_waitcnt vmcnt(0)" ::: "memory");
        }
    }
    __syncthreads();
}

constexpr int NPH = 25;
__constant__ unsigned char PROG[NPH][2] = {
    {0, 0},
    {3, 0}, {4, 0}, {5, 0}, {6, 0}, {7, 0}, {13, 0}, {14, 0},
    {8, 1}, {9, 1}, {7, 1}, {13, 1}, {14, 1},
    {10, 2}, {11, 2}, {7, 2}, {13, 2}, {14, 2},
    {3, 3}, {4, 3}, {5, 3}, {6, 3}, {7, 3}, {13, 3}, {14, 3},
};
__global__ void __launch_bounds__(512, 2) fwd_megakernel(Params P) {
    extern __shared__ __attribute__((aligned(16))) unsigned char lds_raw[];
    LAS unsigned char* lds = (LAS unsigned char*)lds_raw;
    cg::grid_group grid = cg::this_grid();
    { volatile LAS unsigned* st0 = (volatile LAS unsigned*)(lds + 131072); if (threadIdx.x == 0) { st0[0] = 0u; st0[1] = 0u; } __syncthreads(); }
    (void)xcd_barrier_post((unsigned*)(P.ws + WS_BAR), (volatile LAS unsigned*)(lds + 131072));
    prologue_phase(P, lds);
    if (obid() == 0 && otid() == 0) {
        const float** tb = (const float**)(P.ws + WS_TBL);
        tb[0] = P.x; tb[1] = P.mix_norm; tb[2] = P.ffn_norm; tb[3] = P.final_norm; tb[4] = P.nsa_cmp_k_w2; tb[5] = P.nsa_cmp_v_w2;
        tb[6] = P.sgu_ln_g; tb[7] = P.sgu_ln_b; tb[8] = P.sgu_b_s; tb[9] = P.pool_scale;
    }
    grid.sync();
    unsigned char* const ws_k = P.ws; float* const out_k = P.out;
#pragma unroll 1
    for (int ph = 1; ph <= NPH; ++ph) {
        const int type = (ph < NPH) ? (int)PROG[ph][0] : 15, layer = (ph < NPH) ? (int)PROG[ph][1] : 0;
        unsigned char* ws = ws_k; asm volatile("" : "+s"(ws));
        const float* const* tb = (const float* const*)(ws + WS_TBL);
        bf16_t* H = (bf16_t*)(ws + WS_H);
        bf16_t* BIG = (bf16_t*)(ws + WS_BIG);
        bf16_t* H2 = (bf16_t*)(ws + WS_H2);
        float* RSS = (float*)(ws + WS_RSS);
        const float* rss_in = RSS + (size_t)((layer == 0) ? 7 : (2 * layer - 1)) * MTOK * 16;
        bf16_t* XB = H2;
        float* X = out_k; asm volatile("" : "+s"(X));
        const int kind = layer % 3, j = layer / 3;
        switch (type) {
        case 15: final_norm_phase(XB, tb[3], X); break;
        case 3: { if (obid() == 0) cbias_reduce(ws, j);
                  EpiNsaIn E; E.Q = BIG; E.KV = BIG + (size_t)MTOK * 1024; E.gates = (float*)(ws + WS_GATES); E.cs = (const float*)(ws + WS_CS); E.rss = rss_in;
                  run_gemm(lds, XB, 1024, (const bf16_t*)(ws + WS_NWIN) + (size_t)j * NSA_NP * 1024, MTOK, 2560, 1024, E); } break;
        case 4: if (obid() >= 64) {
                  EpiGates E; E.gates = (float*)(ws + WS_GATES); E.rss = rss_in;
                  pg8::Gemm g; g.A = XB; g.Bt = (const bf16_t*)(ws + WS_NWIN) + (size_t)j * NSA_NP * 1024; g.M = MTOK; g.N = NSA_NP; g.K = 1024; g.lda = 1024; g.acs = 0;
                  GateOrder S; S.G = ogdim() - 64; S.c = obid() - 64;
                  pg8::gemm_phase<EpiGates, GateOrder, false>(lds, g, S, E, nullptr);
                } else { EpiBf16<2> E; E.O = (bf16_t*)(ws + WS_CH); E.ldc = 256; E.aux = (const float*)(ws + WS_CBIAS) + j * 512; E.rss = nullptr;
                  pg8::Gemm g; g.A = BIG + (size_t)MTOK * 1024; g.Bt = (const bf16_t*)(ws + WS_CW1) + (size_t)j * 512 * 2048; g.M = 16384; g.N = 512; g.K = 2048; g.lda = 1024; g.acs = 0;
                  CmpOrder S; S.G = ogdim(); S.c = obid();
                  pg8::gemm_phase<EpiBf16<2>, CmpOrder, false>(lds, g, S, E, nullptr); } break;
        case 5: if (obid() < 64) cmp2_local((const bf16_t*)(ws + WS_CH), (const bf16_t*)(ws + WS_W2T) + (size_t)j * 2 * 64 * 256, (bf16_t*)(ws + WS_KCMP), (bf16_t*)(ws + WS_VCMPT), obid()); break;
        case 6: nsa_attn_phase(BIG, BIG + (size_t)MTOK * 1024, (const bf16_t*)(ws + WS_KCMP), (const bf16_t*)(ws + WS_VCMPT), (const float*)(ws + WS_GATES), H, lds); break;
        case 7: case 14: {
                  EpiResid E; E.XB = XB;
                  if (type == 7) E.rss = RSS + (size_t)(2 * layer) * MTOK * 16; else E.rss = (layer < 3) ? RSS + (size_t)(2 * layer + 1) * MTOK * 16 : nullptr;
                  const bf16_t* A = H; int K = 1024; const bf16_t* Bt;
                  if (type == 14) { A = BIG; K = FH; Bt = (const bf16_t*)(ws + WS_WDN) + (size_t)layer * 1024 * FH; }
                  else if (kind == 0) Bt = (const bf16_t*)(ws + WS_NWOUT) + (size_t)j * 1024 * 1024;
                  else if (kind == 1) Bt = (const bf16_t*)(ws + WS_SWOUT);
                  else Bt = (const bf16_t*)(ws + WS_PWOUT);
                  run_gemm(lds, A, K, Bt, MTOK, 1024, K, E); } break;
        case 8: { EpiBf16<0> E; E.O = BIG; E.ldc = 2048; E.aux = nullptr; E.rss = rss_in;
                  run_gemm(lds, XB, 1024, (const bf16_t*)(ws + WS_SWIN), MTOK, 2048, 1024, E); } break;
        case 9: sgu_spatial_phase(BIG, tb[6], tb[7], (const bf16_t*)(ws + WS_SWS), tb[8], H, lds); break;
        case 10: { EpiF32 E; E.C = (float*)BIG; E.rss = rss_in;
                  run_gemm(lds, XB, 1024, (const bf16_t*)(ws + WS_PWIN), MTOK, 1024, 1024, E); } break;
        case 11: pool_diff_phase((const float*)BIG, H); break;
        case 12: { EpiBf16<1> E; E.O = BIG; E.ldc = 1024; E.aux = tb[9]; E.rss = nullptr;
                  int kk = 256; asm volatile("" : "+s"(kk));
                  run_gemm(lds, H, 1024, (const bf16_t*)(ws + WS_PGRP), MTOK, 1024, kk, E, 512); } break;
        case 13: { EpiGU E; E.HID = BIG; E.rss = RSS + (size_t)(2 * layer) * MTOK * 16;
                  run_gemm(lds, XB, 1024, (const bf16_t*)(ws + WS_WGU) + (size_t)layer * 5632 * 1024, MTOK, 5632, 1024, E); } break;
        default: break;
        }
        if (ph < NPH && type != 4) { XcdBarrier xb; xb.bar = (unsigned*)(ws + WS_BAR); xb.x = xb_xcc_id(); xb.st = (volatile LAS unsigned*)(lds + 131072); xcd_barrier(xb); }
    }
}

extern "C" void kernel_launch(void* const* d_in, const int* in_sizes, int n_in, void* d_out, int out_size, void* d_ws, size_t ws_size, hipStream_t stream) {
    static int grid_blocks = 0;
    if (grid_blocks == 0) {
        if (n_in != 25 || out_size != MTOK * DM || ws_size < WS_END) { fprintf(stderr, "kernel_launch: unexpected shapes (n_in %d, out %d, ws %zu need %zu)\n", n_in, out_size, ws_size, (size_t)WS_END); grid_blocks = -1; return; }
        int dev = 0, cus = 0, per_cu = 0;
        hipGetDevice(&dev);
        hipDeviceGetAttribute(&cus, hipDeviceAttributeMultiprocessorCount, dev);
        if (hipFuncSetAttribute((const void*)fwd_megakernel, hipFuncAttributeMaxDynamicSharedMemorySize, LDS_BYTES) != hipSuccess) { fprintf(stderr, "kernel_launch: hipFuncSetAttribute failed\n"); grid_blocks = -1; return; }
        if (hipOccupancyMaxActiveBlocksPerMultiprocessor(&per_cu, (const void*)fwd_megakernel, 512, LDS_BYTES) != hipSuccess || per_cu < 1) { fprintf(stderr, "kernel_launch: occupancy query gave %d\n", per_cu); per_cu = 1; }
        (void)hipGetLastError();
        grid_blocks = cus * 1;
    }
    if (grid_blocks < 0) return;
    Params p{};
    p.x = (const float*)d_in[0]; p.positions = (const int*)d_in[1]; p.mix_norm = (const float*)d_in[2]; p.ffn_norm = (const float*)d_in[3]; p.final_norm = (const float*)d_in[4];
    p.nsa_w_in = (const float*)d_in[5]; p.nsa_cmp_pos_k = (const float*)d_in[6]; p.nsa_cmp_k_w1 = (const float*)d_in[7]; p.nsa_cmp_k_w2 = (const float*)d_in[8];
    p.nsa_cmp_pos_v = (const float*)d_in[9]; p.nsa_cmp_v_w1 = (const float*)d_in[10]; p.nsa_cmp_v_w2 = (const float*)d_in[11]; p.nsa_w_out = (const float*)d_in[12];
    p.sgu_w_in = (const float*)d_in[13]; p.sgu_ln_g = (const float*)d_in[14]; p.sgu_ln_b = (const float*)d_in[15]; p.sgu_w_s = (const float*)d_in[16]; p.sgu_b_s = (const float*)d_in[17]; p.sgu_w_out = (const float*)d_in[18];
    p.pool_w_in = (const float*)d_in[19]; p.pool_w_grp = (const float*)d_in[20]; p.pool_scale = (const float*)d_in[21]; p.pool_w_out = (const float*)d_in[22];
    p.ffn_w_gate_up = (const float*)d_in[23]; p.ffn_w_down = (const float*)d_in[24];
    p.out = (float*)d_out; p.ws = (unsigned char*)d_ws;
    if (hipMemsetAsync((unsigned char*)d_ws + WS_BAR, 0, 16384, stream) != hipSuccess) { fprintf(stderr, "kernel_launch: memset of barrier words failed\n"); return; }
    void* args[] = {&p};
    hipError_t e = hipLaunchCooperativeKernel((const void*)fwd_megakernel, dim3(grid_blocks), dim3(512), args, LDS_BYTES, stream);
    if (e != hipSuccess) fprintf(stderr, "cooperative launch failed: %s (grid %d)\n", hipGetErrorString(e), grid_blocks);
}
```

```cpp
#include <hip/hip_runtime.h>
#include <hip/hip_cooperative_groups.h>
#include <cstdio>
namespace cg = cooperative_groups;
namespace pg8 {
#define PG8_LAS __attribute__((address_space(3)))
typedef unsigned short bf16_t;
typedef short bf16x8 __attribute__((ext_vector_type(8)));
typedef float f32x4 __attribute__((ext_vector_type(4)));
typedef unsigned u32x4 __attribute__((ext_vector_type(4)));
constexpr int BM = 256, BK = 64, HALF = 128, HTB = HALF * BK * 2  , STAGE_BYTES = 8 * HTB, NXCD = 8, WGM = 8;

__host__ __device__ __forceinline__ int lds_byte(int r, int c) { const int st = (r >> 4) * 2 + (c >> 5), rr = r & 15, cc = c & 31, ob = rr * 64 + cc * 2; return st * 1024 + (ob ^ (((ob >> 9) & 1) << 5)); }
__host__ __device__ __forceinline__ void stage_rc(int b, int& R, int& C) { const int st = b / 1024, sb = b % 1024, swz = sb ^ (((sb >> 9) & 1) << 5); R = (st >> 1) * 16 + swz / 64; C = (st & 1) * 32 + (swz % 64) / 2; }
__host__ __device__ __forceinline__ int perm32(int rho) { const int n = rho >> 4, i = rho & 15; return 8 * (i >> 2) + 4 * n + (i & 3); }

struct Unit { int pm, pn; };
struct Gemm { const bf16_t* A; const bf16_t* Bt; int M, N, K, lda, acs; };

struct StaticOrder {
    int nM, nN, nwg, G, c;
    __host__ __device__ void init(int M, int N, int G_, int c_) { nM = M / BM; nN = N / BM; nwg = nM * nN; G = G_; c = c_; }
    __host__ __device__ bool next(int i, Unit& u) const {
        const long L = (long)i * G + c; if (L >= nwg) return false;
        int wgid = (int)L; { const int q = nwg / NXCD, r = nwg % NXCD, xcd = wgid % NXCD, off = wgid / NXCD; wgid = (xcd < r ? xcd * (q + 1) : r * (q + 1) + (xcd - r) * q) + off; }
        const int nig = WGM * nN, gid = wgid / nig, fm = gid * WGM, gsz = (nM - fm) < WGM ? (nM - fm) : WGM;
        u.pm = fm + ((wgid % nig) % gsz); u.pn = (wgid % nig) / gsz; return true;
    }
    __device__ __forceinline__ void a_ready(const Unit&) const {}
    __device__ __forceinline__ void done(const Unit&) const {}
};
template <class Epi, class Sched, bool STAMP = false>
__device__ __forceinline__ void gemm_phase(PG8_LAS unsigned char* lds, const Gemm g, const Sched& S, const Epi& E, unsigned long long* stamps) {
    int tid_ = threadIdx.x; asm volatile("" : "+v"(tid_)); const int tid = tid_, wid = __builtin_amdgcn_readfirstlane(tid >> 6), lane = tid & 63, wr = wid >> 2, wc = wid & 3, fr = lane & 15, fq = lane >> 4;
    const int K = g.K, nt = K / BK;
    int ts_lo = 0, ts_hi = 0, nts = 0; const unsigned long long rt_entry = STAMP ? (unsigned long long)wall_clock64() : 0ull;
#define PG8_STAMP() do { if (STAMP && wid == 0 && nts < 64) { const unsigned long long _c = (unsigned long long)clock64(); \
        ts_lo = (lane == nts) ? (int)(unsigned)_c : ts_lo; ts_hi = (lane == nts) ? (int)(unsigned)(_c >> 32) : ts_hi; ++nts; } } while (0)
    PG8_STAMP();
    unsigned voffA[2], voffB[2];
#pragma unroll
    for (int i = 0; i < 2; ++i) { int R, C; stage_rc(tid * 16 + i * 8192, R, C); const int Rb = Epi::PERM ? ((R & ~31) + perm32(R & 31)) : R;
        voffA[i] = (unsigned)(R * g.lda + C) * 2u; voffB[i] = (unsigned)(Rb * K + C) * 2u; }
    const size_t kstep = (size_t)(BK * 2);
    const size_t hstep = (size_t)HALF * K * 2;
    const size_t tstep = 2 * hstep; const size_t hstepA = (size_t)HALF * g.lda * 2; const size_t tstepA = 2 * hstepA;
    const unsigned ldsw = (unsigned)wid * 1024u;
    const int aoff = lds_byte(wr * 64 + fr, fq * 8), boff = lds_byte(wc * 32 + fr, fq * 8);
#define PG8_SA(b, h) (((b) * 2 + (h)) * HTB)
#define PG8_SB(b, h) ((4 + (b) * 2 + (h)) * HTB)
#define PG8_STAGE(bufoff, gbase, voff) do { _Pragma("unroll") for (int _i = 0; _i < 2; ++_i) \
        __builtin_amdgcn_global_load_lds((const unsigned*)((const char*)(gbase) + (voff)[_i]), (PG8_LAS unsigned*)(lds + (bufoff) + ldsw + _i * 8192), 16, 0, 0); } while (0)
#define PG8_LDA(dst, b, h) do { _Pragma("unroll") for (int m = 0; m < 4; ++m) _Pragma("unroll") for (int k = 0; k < 2; ++k) dst[m][k] = *(const PG8_LAS bf16x8*)(lds + PG8_SA(b, h) + aoff + m * 2048 + k * 1024); } while (0)
#define PG8_LDB(dst, b, h) do { _Pragma("unroll") for (int n = 0; n < 2; ++n) _Pragma("unroll") for (int k = 0; k < 2; ++k) dst[n][k] = *(const PG8_LAS bf16x8*)(lds + PG8_SB(b, h) + boff + n * 2048 + k * 1024); } while (0)
#define PG8_MMA(ai, bj, At, Bt) do { __builtin_amdgcn_s_setprio(1); _Pragma("unroll") for (int m = 0; m < 4; ++m) _Pragma("unroll") for (int n = 0; n < 2; ++n) _Pragma("unroll") for (int k = 0; k < 2; ++k) \
        acc[ai][bj][m][n] = __builtin_amdgcn_mfma_f32_16x16x32_bf16(Bt[n][k], At[m][k], acc[ai][bj][m][n], 0, 0, 0); __builtin_amdgcn_s_setprio(0); } while (0)
#define PG8_WAIT_V(n) asm volatile("s_waitcnt vmcnt(" #n ")" ::: "memory")
#define PG8_WAIT_L(n) asm volatile("s_waitcnt lgkmcnt(" #n ")" ::: "memory")
#define PG8_BAR __builtin_amdgcn_s_barrier()
#define PG8_SCHED __builtin_amdgcn_sched_barrier(0)
    Unit cur, nxt; int ui = 0;
    if (!S.next(0, cur)) return;
    f32x4 acc[2][2][4][2];
#pragma unroll
    for (int a = 0; a < 2; ++a)
#pragma unroll
        for (int b = 0; b < 2; ++b)
#pragma unroll
            for (int m = 0; m < 4; ++m)
#pragma unroll
                for (int n = 0; n < 2; ++n) acc[a][b][m][n] = (f32x4){0.f, 0.f, 0.f, 0.f};
    bf16x8 At[4][2], B0[2][2], B1[2][2];
    const char* cA = (const char*)g.A + (size_t)cur.pm * tstepA + (size_t)cur.pn * g.acs; const char* cB = (const char*)g.Bt + (size_t)cur.pn * tstep;
    S.a_ready(cur);
    PG8_STAGE(PG8_SB(0, 0), cB, voffB); PG8_STAGE(PG8_SB(0, 1), cB + hstep, voffB); PG8_STAGE(PG8_SA(0, 0), cA, voffA); PG8_STAGE(PG8_SA(0, 1), cA + hstepA, voffA);
    if (wr == 1) PG8_BAR;
    PG8_WAIT_V(2); PG8_BAR;
    PG8_STAGE(PG8_SB(1, 0), cB + kstep, voffB); PG8_STAGE(PG8_SA(1, 0), cA + kstep, voffA); PG8_STAGE(PG8_SB(1, 1), cB + hstep + kstep, voffB);
    PG8_WAIT_V(6); PG8_BAR;
    PG8_STAMP();
    for (;;) {
        const bool has_next = S.next(ui + 1, nxt);
        const char* nA = has_next ? (const char*)g.A + (size_t)nxt.pm * tstepA + (size_t)nxt.pn * g.acs : cA; const char* nB = has_next ? (const char*)g.Bt + (size_t)nxt.pn * tstep : cB;
        for (int t = 0; t < nt; t += 2) {
            const bool last = (t == nt - 2);
            const char* a1 = cA + (size_t)(t + 1) * kstep;
            const char* a2 = last ? nA : cA + (size_t)(t + 2) * kstep; const char* b2 = last ? nB : cB + (size_t)(t + 2) * kstep;
            const char* a3 = a2 + kstep; const char* b3 = b2 + kstep;
            if (last && has_next) S.a_ready(nxt);
            PG8_LDB(B0, 0, 0); PG8_LDB(B1, 0, 1); PG8_SCHED; PG8_LDA(At, 0, 0); PG8_STAGE(PG8_SA(1, 1), a1 + hstepA, voffA);
            PG8_WAIT_V(8); PG8_WAIT_L(0); PG8_BAR; PG8_MMA(0, 0, At, B0); PG8_MMA(0, 1, At, B1); PG8_BAR; PG8_SCHED;
            PG8_LDA(At, 0, 1); PG8_STAGE(PG8_SB(0, 0), b2, voffB); PG8_STAGE(PG8_SB(0, 1), b2 + hstep, voffB); PG8_STAGE(PG8_SA(0, 0), a2, voffA);
            PG8_WAIT_V(8); PG8_WAIT_L(0); PG8_BAR; PG8_MMA(1, 0, At, B0); PG8_MMA(1, 1, At, B1); PG8_BAR; PG8_SCHED;
            PG8_LDB(B0, 1, 0); PG8_LDB(B1, 1, 1); PG8_SCHED; PG8_LDA(At, 1, 0); PG8_STAGE(PG8_SA(0, 1), a2 + hstepA, voffA);
            PG8_WAIT_V(8); PG8_WAIT_L(0); PG8_BAR; PG8_MMA(0, 0, At, B0); PG8_MMA(0, 1, At, B1); PG8_BAR; PG8_SCHED;
            PG8_LDA(At, 1, 1); PG8_STAGE(PG8_SB(1, 0), b3, voffB); PG8_STAGE(PG8_SB(1, 1), b3 + hstep, voffB); PG8_STAGE(PG8_SA(1, 0), a3, voffA);
            PG8_WAIT_V(8); PG8_WAIT_L(0); PG8_BAR; PG8_MMA(1, 0, At, B0); PG8_MMA(1, 1, At, B1); PG8_BAR; PG8_SCHED;
        }
        PG8_STAMP();
        if (wr == 0) PG8_BAR;
        if constexpr (!Epi::AFTER_DRAIN) { E(acc, cur, wr, wc, fr, fq); S.done(cur); }
        PG8_STAMP();
        if (!has_next) break;
#pragma unroll
        for (int a = 0; a < 2; ++a)
#pragma unroll
            for (int b = 0; b < 2; ++b)
#pragma unroll
                for (int m = 0; m < 4; ++m)
#pragma unroll
                    for (int n = 0; n < 2; ++n) acc[a][b][m][n] = (f32x4){0.f, 0.f, 0.f, 0.f};
        cur = nxt; cA = nA; cB = nB; ++ui;
        if (wr == 1) PG8_BAR;
    }
    PG8_WAIT_V(0);
    PG8_BAR;
    if constexpr (Epi::AFTER_DRAIN) { E.fused(acc, cur, wr, wc, fr, fq, lds, wid, lane); S.done(cur); }
    PG8_STAMP();
    if (STAMP && wid == 0) { stamps[lane] = lane < nts ? (((unsigned long long)(unsigned)ts_hi << 32) | (unsigned)ts_lo) : 0ull;
        if (lane == 62) stamps[62] = rt_entry; if (lane == 63) stamps[63] = (unsigned long long)wall_clock64(); }
#undef PG8_STAMP
#undef PG8_SA
#undef PG8_SB
#undef PG8_STAGE
#undef PG8_LDA
#undef PG8_LDB
#undef PG8_MMA
#undef PG8_WAIT_V
#undef PG8_WAIT_L
#undef PG8_BAR
#undef PG8_SCHED
}
}

#define LAS __attribute__((address_space(3)))
typedef unsigned short bf16_t;
typedef short bf16x8 __attribute__((ext_vector_type(8)));
typedef short s16x4 __attribute__((ext_vector_type(4)));
typedef float f32x4 __attribute__((ext_vector_type(4)));
typedef float f32x16 __attribute__((ext_vector_type(16)));
typedef unsigned u32x4 __attribute__((ext_vector_type(4)));
typedef unsigned u32x2 __attribute__((ext_vector_type(2)));
typedef __bf16 bf16x2_t __attribute__((ext_vector_type(2)));
typedef float f32x2_t __attribute__((ext_vector_type(2)));

__device__ __forceinline__ int otid() { int t = threadIdx.x; asm volatile("" : "+v"(t)); return t; }
__device__ __forceinline__ int obid() { int t = blockIdx.x; asm volatile("" : "+s"(t)); return t; }
__device__ __forceinline__ int ogdim() { int t = gridDim.x; asm volatile("" : "+s"(t)); return t; }
constexpr int NB = 8, SEQ = 4096, DM = 1024, MTOK = NB * SEQ;
constexpr int FH = 2816;
constexpr int NSA_IN = 2608, NSA_NP = 2816;
constexpr size_t KVSZ = (size_t)32 * 4096 * 64;
constexpr int LDS_BYTES = 131072 + 16;

__device__ __forceinline__ unsigned pk_bf16(float a, float b) { f32x2_t v = {a, b}; bf16x2_t r = __builtin_convertvector(v, bf16x2_t); return __builtin_bit_cast(unsigned, r); }
__device__ __forceinline__ bf16_t f2bf(float a) { return (bf16_t)(pk_bf16(a, 0.f) & 0xffffu); }
__device__ __forceinline__ float bf2f(unsigned short x) { return __uint_as_float(((unsigned)x) << 16); }
__device__ __forceinline__ float gelu_tanh(float x) { const float y = 0.7978845608f * (x + 0.044715f * x * x * x); return x * __builtin_amdgcn_rcpf(1.0f + __builtin_amdgcn_exp2f(-2.885390082f * y)); }
__device__ __forceinline__ float silu_f(float x) { return x * __builtin_amdgcn_rcpf(1.0f + __builtin_amdgcn_exp2f(-1.442695041f * x)); }
__device__ __forceinline__ float sigmoid_f(float x) { return __builtin_amdgcn_rcpf(1.0f + __builtin_amdgcn_exp2f(-1.442695041f * x)); }

constexpr size_t al256(size_t x) { return (x + 255) & ~(size_t)255; }
constexpr size_t WS_WGU = 0;
constexpr size_t WS_WDN = WS_WGU + (size_t)4 * 5632 * 1024 * 2;
constexpr size_t WS_NWIN = WS_WDN + (size_t)4 * 1024 * 2816 * 2;
constexpr size_t WS_NWOUT = WS_NWIN + (size_t)2 * NSA_NP * 1024 * 2;
constexpr size_t WS_CW1 = WS_NWOUT + (size_t)2 * 1024 * 1024 * 2;
constexpr size_t WS_SWIN = WS_CW1 + (size_t)2 * 512 * 2048 * 2;
constexpr size_t WS_SWOUT = WS_SWIN + (size_t)2048 * 1024 * 2;
constexpr size_t WS_SWS = WS_SWOUT + (size_t)1024 * 1024 * 2;
constexpr size_t WS_PWIN = WS_SWS + (size_t)8 * 128 * 128 * 2;
constexpr size_t WS_PGRP = WS_PWIN + (size_t)1024 * 1024 * 2;
constexpr size_t WS_PWOUT = WS_PGRP + (size_t)1024 * 1024 * 2;
constexpr size_t WS_CBIAS = WS_PWOUT + (size_t)1024 * 1024 * 2;
constexpr size_t WS_CS = WS_CBIAS + 4096;
constexpr size_t WS_GATES = WS_CS + (size_t)MTOK * 16 * 4;
constexpr size_t WS_CH = WS_GATES + (size_t)MTOK * 48 * 4;
constexpr size_t WS_KCMP = WS_CH + (size_t)16384 * 256 * 2;
constexpr size_t WS_VCMPT = WS_KCMP + (size_t)32 * 256 * 64 * 2;
constexpr size_t WS_H = WS_VCMPT + (size_t)32 * 64 * 256 * 2;
constexpr size_t WS_BIG = WS_H + (size_t)MTOK * 1024 * 2;
constexpr size_t WS_TBL = WS_BIG + (size_t)MTOK * 2816 * 2 + 65536;
constexpr size_t WS_CBPART = WS_TBL + 4096;
constexpr size_t WS_W2T = WS_CBPART + (size_t)256 * 256 * 4;
constexpr size_t WS_H2 = WS_W2T + (size_t)4 * 64 * 256 * 2;
constexpr size_t WS_RSS = WS_H2 + (size_t)MTOK * 1024 * 2;
constexpr size_t WS_BAR = WS_RSS + (size_t)8 * MTOK * 16 * 4;
constexpr size_t WS_END = WS_BAR + 16384;

struct Params {
    const float* x; const int* positions; const float* mix_norm; const float* ffn_norm; const float* final_norm;
    const float* nsa_w_in; const float* nsa_cmp_pos_k; const float* nsa_cmp_k_w1; const float* nsa_cmp_k_w2;
    const float* nsa_cmp_pos_v; const float* nsa_cmp_v_w1; const float* nsa_cmp_v_w2; const float* nsa_w_out;
    const float* sgu_w_in; const float* sgu_ln_g; const float* sgu_ln_b; const float* sgu_w_s; const float* sgu_b_s; const float* sgu_w_out;
    const float* pool_w_in; const float* pool_w_grp; const float* pool_scale; const float* pool_w_out;
    const float* ffn_w_gate_up; const float* ffn_w_down;
    float* out; unsigned char* ws;
};


__device__ __forceinline__ float row_rstd(const float* rss, int row) {
    const f32x4* q = (const f32x4*)(rss + (size_t)row * 16);
    const f32x4 s = (q[0] + q[1]) + (q[2] + q[3]);
    return rsqrtf(((s[0] + s[1]) + (s[2] + s[3])) * (1.0f / 1024.0f) + 1e-6f);
}
__device__ __forceinline__ void load_rstd(const float* rss, int row0, float (&rs)[2][4]) {
#pragma unroll
    for (int ai = 0; ai < 2; ++ai)
#pragma unroll
        for (int m = 0; m < 4; ++m) rs[ai][m] = rss ? row_rstd(rss, row0 + ai * 128 + m * 16) : 1.0f;
}
struct EpiResid {
    static constexpr bool PERM = true, AFTER_DRAIN = false;
    bf16_t* XB; float* rss;
    __device__ __forceinline__ void operator()(const f32x4 (&acc)[2][2][4][2], const pg8::Unit& u, int wr, int wc, int fr, int fq) const {
        const int row0 = u.pm * 256 + wr * 64 + fr, col0 = u.pn * 256 + wc * 32 + 8 * fq;
#pragma unroll
        for (int ai = 0; ai < 2; ++ai)
#pragma unroll
            for (int m = 0; m < 4; ++m) {
                const int row = row0 + ai * 128 + m * 16;
                bf16_t* rp = XB + (size_t)row * 1024 + col0;
                float ss = 0.f;
#pragma unroll
                for (int bj = 0; bj < 2; ++bj) {
                    const u32x4 bw = *(const u32x4*)(rp + bj * 128);
                    const f32x4 a0 = acc[ai][bj][m][0], a1 = acc[ai][bj][m][1];
                    float x[8];
                    x[0] = __uint_as_float(bw.x << 16) + a0[0]; x[1] = __uint_as_float(bw.x & 0xffff0000u) + a0[1];
                    x[2] = __uint_as_float(bw.y << 16) + a0[2]; x[3] = __uint_as_float(bw.y & 0xffff0000u) + a0[3];
                    x[4] = __uint_as_float(bw.z << 16) + a1[0]; x[5] = __uint_as_float(bw.z & 0xffff0000u) + a1[1];
                    x[6] = __uint_as_float(bw.w << 16) + a1[2]; x[7] = __uint_as_float(bw.w & 0xffff0000u) + a1[3];
#pragma unroll
                    for (int e = 0; e < 8; ++e) ss += x[e] * x[e];
                    u32x4 w; w.x = pk_bf16(x[0], x[1]); w.y = pk_bf16(x[2], x[3]); w.z = pk_bf16(x[4], x[5]); w.w = pk_bf16(x[6], x[7]);
                    *(u32x4*)(rp + bj * 128) = w;
                }
                if (rss) {
                    ss += __shfl_xor(ss, 16); ss += __shfl_xor(ss, 32);
                    if (fq == 0) rss[(size_t)row * 16 + u.pn * 4 + wc] = ss;
                }
            }
    }
};
struct EpiF32 {
    static constexpr bool PERM = false, AFTER_DRAIN = false;
    float* C; const float* rss;
    __device__ __forceinline__ void operator()(const f32x4 (&acc)[2][2][4][2], const pg8::Unit& u, int wr, int wc, int fr, int fq) const {
        const int row0 = u.pm * 256 + wr * 64 + fr, col0 = u.pn * 256 + wc * 32 + 4 * fq;
        float rs[2][4]; load_rstd(rss, row0, rs);
#pragma unroll
        for (int ai = 0; ai < 2; ++ai)
#pragma unroll
            for (int m = 0; m < 4; ++m) {
                const size_t off = (size_t)(row0 + ai * 128 + m * 16) * 1024 + col0;
#pragma unroll
                for (int bj = 0; bj < 2; ++bj)
#pragma unroll
                    for (int n = 0; n < 2; ++n) *(f32x4*)(C + off + bj * 128 + n * 16) = acc[ai][bj][m][n] * rs[ai][m];
            }
    }
};
struct EpiGU {
    static constexpr bool PERM = true, AFTER_DRAIN = false;
    bf16_t* HID; const float* rss;
    __device__ __forceinline__ void operator()(const f32x4 (&acc)[2][2][4][2], const pg8::Unit& u, int wr, int wc, int fr, int fq) const {
        const int row0 = u.pm * 256 + wr * 64 + fr, col0 = u.pn * 128 + wc * 32 + 8 * fq;
        float rs[2][4]; load_rstd(rss, row0, rs);
#pragma unroll
        for (int ai = 0; ai < 2; ++ai)
#pragma unroll
            for (int m = 0; m < 4; ++m) {
                const float rr = rs[ai][m];
                const f32x4 g0 = acc[ai][0][m][0] * rr, g1 = acc[ai][0][m][1] * rr, u0 = acc[ai][1][m][0] * rr, u1 = acc[ai][1][m][1] * rr;
                u32x4 w;
                w.x = pk_bf16(silu_f(g0[0]) * u0[0], silu_f(g0[1]) * u0[1]); w.y = pk_bf16(silu_f(g0[2]) * u0[2], silu_f(g0[3]) * u0[3]);
                w.z = pk_bf16(silu_f(g1[0]) * u1[0], silu_f(g1[1]) * u1[1]); w.w = pk_bf16(silu_f(g1[2]) * u1[2], silu_f(g1[3]) * u1[3]);
                *(u32x4*)(HID + (size_t)(row0 + ai * 128 + m * 16) * FH + col0) = w;
            }
    }
};
template <int MODE> struct EpiBf16 {
    static constexpr bool PERM = true, AFTER_DRAIN = false;
    bf16_t* O; int ldc; const float* aux; const float* rss;
    __device__ __forceinline__ void operator()(const f32x4 (&acc)[2][2][4][2], const pg8::Unit& u, int wr, int wc, int fr, int fq) const {
        const int row0 = u.pm * 256 + wr * 64 + fr; const int ct = wc * 32 + 8 * fq;
        const int colbase = (MODE == 2) ? 0 : u.pn * 256;
        float rs[2][4]; if (MODE == 0) load_rstd(rss, row0, rs);
        f32x4 av[2][2];
#pragma unroll
        for (int bj = 0; bj < 2; ++bj)
#pragma unroll
            for (int n = 0; n < 2; ++n) av[bj][n] = (MODE == 0) ? (f32x4){0.f, 0.f, 0.f, 0.f} : *(const f32x4*)(aux + u.pn * 256 + ct + bj * 128 + 4 * n);
#pragma unroll
        for (int ai = 0; ai < 2; ++ai)
#pragma unroll
            for (int m = 0; m < 4; ++m) {
                bf16_t* rowp = O + (size_t)(row0 + ai * 128 + m * 16) * ldc + colbase + ct;
#pragma unroll
                for (int bj = 0; bj < 2; ++bj) {
                    f32x4 v0 = acc[ai][bj][m][0], v1 = acc[ai][bj][m][1];
                    if (MODE == 0) { v0 = v0 * rs[ai][m]; v1 = v1 * rs[ai][m]; }
                    if (MODE == 1) { v0 = v0 * av[bj][0]; v1 = v1 * av[bj][1]; }
                    if (MODE == 2) { v0 = v0 + av[bj][0]; v1 = v1 + av[bj][1]; }
                    if (MODE != 1) {
#pragma unroll
                        for (int j = 0; j < 4; ++j) { v0[j] = gelu_tanh(v0[j]); v1[j] = gelu_tanh(v1[j]); }
                    }
                    u32x4 w; w.x = pk_bf16(v0[0], v0[1]); w.y = pk_bf16(v0[2], v0[3]); w.z = pk_bf16(v1[0], v1[1]); w.w = pk_bf16(v1[2], v1[3]);
                    *(u32x4*)(rowp + bj * 128) = w;
                }
            }
    }
};
struct EpiNsaIn {
    static constexpr bool PERM = true, AFTER_DRAIN = false;
    bf16_t* Q; bf16_t* KV; float* gates; const float* cs; const float* rss;
    template <int VAR> __device__ __forceinline__ void variant(const f32x4 (&acc)[2][2][4][2], const pg8::Unit& u, int wr, int wc, int fr, int fq) const {
        const int pn = u.pn; const int jkv = pn - 4;
        const int row0 = u.pm * 256 + wr * 64 + fr;
        const bool rope_w = (VAR <= 1) && ((wc & 1) == 0);
#pragma unroll
        for (int ai = 0; ai < 2; ++ai)
#pragma unroll
            for (int m = 0; m < 4; ++m) {
                const int row = row0 + ai * 128 + m * 16; const int b = row >> 12, s = row & 4095;
                const float rr = rss ? row_rstd(rss, row) : 1.0f;
#pragma unroll
                for (int bj = 0; bj < 2; ++bj) {
                    const int cb = bj * 128 + wc * 32 + fq * 8;
                    f32x4 v0 = acc[ai][bj][m][0] * rr, v1 = acc[ai][bj][m][1] * rr;
                    if (rope_w) {
                        f32x4 p0, p1;
#pragma unroll
                        for (int j = 0; j < 4; ++j) { p0[j] = __shfl_xor(v0[j], 16); p1[j] = __shfl_xor(v1[j], 16); }
                        if (fq < 2) {
                            const f32x4* c4 = (const f32x4*)(cs + (size_t)row * 16);
                            const f32x4 cA = c4[0], cB = c4[1], sA = c4[2], sB = c4[3];
                            if (fq == 0) { v0 = v0 * cA - p0 * sA; v1 = v1 * cB - p1 * sB; }
                            else { v0 = v0 * cA + p0 * sA; v1 = v1 * cB + p1 * sB; }
                        }
                    }
                    const int hh = cb >> 6, d0 = cb & 63;
                    if (VAR == 0) {
                        v0 = v0 * 0.18033688f; v1 = v1 * 0.18033688f;
                        u32x4 w; w.x = pk_bf16(v0[0], v0[1]); w.y = pk_bf16(v0[2], v0[3]); w.z = pk_bf16(v1[0], v1[1]); w.w = pk_bf16(v1[2], v1[3]);
                        *(u32x4*)(Q + ((size_t)(b * 16 + pn * 4 + hh) * 4096 + s) * 64 + d0) = w;
                    } else if (VAR == 1 || VAR == 2) {
                        u32x4 w; w.x = pk_bf16(v0[0], v0[1]); w.y = pk_bf16(v0[2], v0[3]); w.z = pk_bf16(v1[0], v1[1]); w.w = pk_bf16(v1[2], v1[3]);
                        *(u32x4*)(KV + (size_t)jkv * KVSZ + ((size_t)(b * 4 + hh) * 4096 + s) * 64 + d0) = w;
                    } else if (VAR == 3) {
                        bf16_t* tp = KV + (size_t)jkv * KVSZ + ((size_t)(b * 4 + hh) * 64 + d0) * 4096 + s;
#pragma unroll
                        for (int j = 0; j < 4; ++j) { tp[(size_t)j * 4096] = f2bf(v0[j]); tp[(size_t)(j + 4) * 4096] = f2bf(v1[j]); }
                    } else if (cb < 48) {
                        f32x4 g0, g1;
#pragma unroll
                        for (int j = 0; j < 4; ++j) { g0[j] = sigmoid_f(v0[j]); g1[j] = sigmoid_f(v1[j]); }
                        float* gp = gates + (size_t)row * 48 + cb;
                        *(f32x4*)gp = g0; *(f32x4*)(gp + 4) = g1;
                    }
                }
            }
    }
    __device__ __forceinline__ void operator()(const f32x4 (&acc)[2][2][4][2], const pg8::Unit& u, int wr_, int wc_, int fr_, int fq_) const {
        const int pn = u.pn;
        const int t_ = otid(); const int wid_ = __builtin_amdgcn_readfirstlane(t_ >> 6); const int wr = wid_ >> 2, wc = wid_ & 3, fr = t_ & 15, fq = (t_ & 63) >> 4;
        (void)wr_; (void)wc_; (void)fr_; (void)fq_;
        if (pn < 4) variant<0>(acc, u, wr, wc, fr, fq);
        else if (pn == 4 || pn == 6 || pn == 8) variant<1>(acc, u, wr, wc, fr, fq);
        else if (pn == 5) variant<2>(acc, u, wr, wc, fr, fq);
        else if (pn == 7 || pn == 9) variant<3>(acc, u, wr, wc, fr, fq);
        else variant<4>(acc, u, wr, wc, fr, fq);
    }
};
struct EpiGates {
    static constexpr bool PERM = false, AFTER_DRAIN = false;
    float* gates; const float* rss;
    __device__ __forceinline__ void operator()(const f32x4 (&acc)[2][2][4][2], const pg8::Unit& u, int wr, int wc, int fr, int fq) const {
        if (wc > 1) return;
        const int row0 = u.pm * 256 + wr * 64 + fr;
#pragma unroll
        for (int ai = 0; ai < 2; ++ai)
#pragma unroll
            for (int m = 0; m < 4; ++m) {
                const int row = row0 + ai * 128 + m * 16;
                const float rr = rss ? row_rstd(rss, row) : 1.0f;
#pragma unroll
                for (int n = 0; n < 2; ++n) {
                    const int cb = wc * 32 + 16 * n + 4 * fq;
                    if (cb < 48) {
                        const f32x4 v = acc[ai][0][m][n] * rr; f32x4 gsig;
#pragma unroll
                        for (int e = 0; e < 4; ++e) gsig[e] = sigmoid_f(v[e]);
                        *(f32x4*)(gates + (size_t)row * 48 + cb) = gsig;
                    }
                }
            }
    }
};
struct GateOrder {
    int G, c;
    __device__ bool next(int i, pg8::Unit& u) const { const int L = i * G + c; if (L >= 128 || G <= 0) return false; u.pm = L; u.pn = 10; return true; }
    __device__ __forceinline__ void a_ready(const pg8::Unit&) const {}
    __device__ __forceinline__ void done(const pg8::Unit&) const {}
};
struct CmpOrder {
    int G, c;
    __device__ bool next(int i, pg8::Unit& u) const { const int L = i * G + c; if (L >= 64) return false; u.pm = L; u.pn = L >> 5; return true; }
    __device__ __forceinline__ void a_ready(const pg8::Unit&) const {}
    __device__ __forceinline__ void done(const pg8::Unit&) const {}
};

template <class Epi> __device__ __forceinline__ void run_gemm(LAS unsigned char* lds, const bf16_t* A, int lda, const bf16_t* Bt, int M, int N, int K, const Epi& E, int acs = 0) {
    pg8::Gemm g; g.A = A; g.Bt = Bt; g.M = M; g.N = N; g.K = K; g.lda = lda; g.acs = acs;
    pg8::StaticOrder S; S.init(M, N, ogdim(), obid());
    pg8::gemm_phase<Epi, pg8::StaticOrder, false>(lds, g, S, E, nullptr);
}

struct TJob { const float* src; bf16_t* dst; const float* gk; int K, Nsrc, Ndst, mode, tiles; };
__device__ __forceinline__ int job_colmap(int mode, int n) {
    if (mode == 0) return n;
    if (mode == 1) { const int t = n >> 8, r = n & 255; return (r < 128) ? (t * 128 + r) : (FH + t * 128 + (r - 128)); }
    return (n < NSA_IN) ? n : -1;
}
__device__ void transpose_tile(LAS float* tile, const TJob& J, int t) {
    const int tid = otid(), tx = tid & 63, ty = tid >> 6;
    const int nkt = J.K >> 6; const int tn = t / nkt, tk = t - tn * nkt; const int n0 = tn * 64, k0 = tk * 64;
    const int sc = job_colmap(J.mode, n0 + tx);
#pragma unroll
    for (int i = 0; i < 8; ++i) { const int k = k0 + ty + 8 * i; const float gs = J.gk ? J.gk[k] : 1.0f; tile[(ty + 8 * i) * 65 + tx] = (sc >= 0) ? J.src[(size_t)k * J.Nsrc + sc] * gs : 0.f; }
    __syncthreads();
    {
        const int nn = tid >> 3, kg = tid & 7;
        float v[8];
#pragma unroll
        for (int e = 0; e < 8; ++e) v[e] = tile[(kg * 8 + e) * 65 + nn];
        u32x4 w; w.x = pk_bf16(v[0], v[1]); w.y = pk_bf16(v[2], v[3]); w.z = pk_bf16(v[4], v[5]); w.w = pk_bf16(v[6], v[7]);
        *(u32x4*)(J.dst + (size_t)(n0 + nn) * J.K + k0 + kg * 8) = w;
    }
    __syncthreads();
}
__device__ __forceinline__ void get_job(const Params& P, unsigned char* ws, int j, TJob& J) {
        J.gk = nullptr;
        if (j < 4) { J.gk = P.ffn_norm + j * 1024; J.src = P.ffn_w_gate_up + (size_t)j * 1024 * 5632; J.dst = (bf16_t*)(ws + WS_WGU) + (size_t)j * 5632 * 1024; J.K = 1024; J.Nsrc = 5632; J.Ndst = 5632; J.mode = 1; }
        else if (j < 8) { const int l = j - 4; J.src = P.ffn_w_down + (size_t)l * 2816 * 1024; J.dst = (bf16_t*)(ws + WS_WDN) + (size_t)l * 1024 * 2816; J.K = 2816; J.Nsrc = 1024; J.Ndst = 1024; J.mode = 0; }
        else if (j < 10) { const int l = j - 8; J.gk = P.mix_norm + (3 * l) * 1024; J.src = P.nsa_w_in + (size_t)l * 1024 * NSA_IN; J.dst = (bf16_t*)(ws + WS_NWIN) + (size_t)l * NSA_NP * 1024; J.K = 1024; J.Nsrc = NSA_IN; J.Ndst = NSA_NP; J.mode = 2; }
        else if (j < 12) { const int l = j - 10; J.src = P.nsa_w_out + (size_t)l * 1024 * 1024; J.dst = (bf16_t*)(ws + WS_NWOUT) + (size_t)l * 1024 * 1024; J.K = 1024; J.Nsrc = 1024; J.Ndst = 1024; J.mode = 0; }
        else if (j < 14) { const int l = j - 12; J.src = P.nsa_cmp_k_w1 + (size_t)l * 2048 * 256; J.dst = (bf16_t*)(ws + WS_CW1) + (size_t)l * 512 * 2048; J.K = 2048; J.Nsrc = 256; J.Ndst = 256; J.mode = 0; }
        else if (j < 16) { const int l = j - 14; J.src = P.nsa_cmp_v_w1 + (size_t)l * 2048 * 256; J.dst = (bf16_t*)(ws + WS_CW1) + (size_t)l * 512 * 2048 + (size_t)256 * 2048; J.K = 2048; J.Nsrc = 256; J.Ndst = 256; J.mode = 0; }
        else if (j == 16) { J.gk = P.mix_norm + 1024; J.src = P.sgu_w_in; J.dst = (bf16_t*)(ws + WS_SWIN); J.K = 1024; J.Nsrc = 2048; J.Ndst = 2048; J.mode = 0; }
        else if (j == 17) { J.src = P.sgu_w_out; J.dst = (bf16_t*)(ws + WS_SWOUT); J.K = 1024; J.Nsrc = 1024; J.Ndst = 1024; J.mode = 0; }
        else if (j == 18) { J.gk = P.mix_norm + 2048; J.src = P.pool_w_in; J.dst = (bf16_t*)(ws + WS_PWIN); J.K = 1024; J.Nsrc = 1024; J.Ndst = 1024; J.mode = 0; }
        else { J.src = P.pool_w_out; J.dst = (bf16_t*)(ws + WS_PWOUT); J.K = 1024; J.Nsrc = 1024; J.Ndst = 1024; J.mode = 0; }
        J.tiles = (J.Ndst >> 6) * (J.K >> 6);
    }
__device__ void prologue_phase(const Params& P, LAS unsigned char* lds) {
    unsigned char* ws = P.ws;
    const int tid = otid();
    constexpr int NJ = 22;
    int total = 0;
    (void)NJ; (void)total;
    {
        int base = 0;
        for (int j = 0; j < 19; ++j) {
            TJob J; get_job(P, ws, j, J);
            int first = (obid() - base % ogdim() + ogdim()) % ogdim();
            for (int t = first; t < J.tiles; t += ogdim()) transpose_tile((LAS float*)lds, J, t);
            base += J.tiles;
        }
    }
    const size_t gtid = (size_t)obid() * 512 + tid, gsz = (size_t)ogdim() * 512;
    {
        bf16_t* dst = (bf16_t*)(ws + WS_PWOUT);
        for (size_t i = gtid; i < (size_t)256 * 256; i += gsz) {
            const int e0 = (int)(i & 255) * 4, c0 = (int)(i >> 8) * 4; const int g = c0 >> 8;
            const f32x4* wg = (const f32x4*)(P.pool_w_grp + ((size_t)g * 256 + (c0 & 255)) * 256);
            const f32x4* sc = (const f32x4*)(P.pool_scale + g * 256);
            const float* wo = P.pool_w_out + (size_t)g * 256 * 1024 + e0;
            f32x4 acc[4];
#pragma unroll
            for (int j = 0; j < 4; ++j) acc[j] = (f32x4){0.f, 0.f, 0.f, 0.f};
#pragma unroll 2
            for (int m4 = 0; m4 < 64; ++m4) {
                const f32x4 s4 = sc[m4];
                f32x4 wv[4];
#pragma unroll
                for (int j = 0; j < 4; ++j) wv[j] = wg[j * 64 + m4] * s4;
#pragma unroll
                for (int mm = 0; mm < 4; ++mm) {
                    const f32x4 o4 = *(const f32x4*)(wo + (size_t)(m4 * 4 + mm) * 1024);
#pragma unroll
                    for (int j = 0; j < 4; ++j) acc[j] = acc[j] + o4 * wv[j][mm];
                }
            }
#pragma unroll
            for (int ii = 0; ii < 4; ++ii) {
                u32x2 w; w.x = pk_bf16(acc[0][ii], acc[1][ii]); w.y = pk_bf16(acc[2][ii], acc[3][ii]);
                *(u32x2*)(dst + (size_t)(e0 + ii) * 1024 + c0) = w;
            }
        }
    }
    {
        bf16_t* dst = (bf16_t*)(ws + WS_W2T);
        for (size_t i = gtid; i < (size_t)4 * 64 * 256; i += gsz) {
            const int c = (int)(i & 255), d = (int)((i >> 8) & 63), kv = (int)((i >> 14) & 1), l = (int)(i >> 15);
            const float* w2 = (kv ? P.nsa_cmp_v_w2 : P.nsa_cmp_k_w2) + (size_t)l * 256 * 64;
            dst[i] = f2bf(w2[c * 64 + d]);
        }
    }
    {
        bf16_t* dst = (bf16_t*)(ws + WS_SWS);
        for (size_t i = gtid; i < (size_t)8 * 128 * 128; i += gsz) { const int t = (int)((i >> 7) & 127), s = (int)(i & 127); dst[i] = f2bf(s <= t ? P.sgu_w_s[i] : 0.f); }
    }
    {
        float* cs = (float*)(ws + WS_CS);
        for (size_t i = gtid; i < (size_t)MTOK * 8; i += gsz) {
            const int row = (int)(i >> 3), f = (int)(i & 7);
            const float inv = (float)pow(500000.0, -(double)(2 * f) / 16.0);
            const float ang = (float)P.positions[row] * inv;
            float sv, cv; sincosf(ang, &sv, &cv);
            cs[(size_t)row * 16 + f] = cv; cs[(size_t)row * 16 + 8 + f] = sv;
        }
    }
    {
        const int lane = tid & 63; const int gw = obid() * 8 + (tid >> 6), nw = ogdim() * 8;
        bf16_t* XBp = (bf16_t*)(ws + WS_H2); float* rss7 = (float*)(ws + WS_RSS) + (size_t)7 * MTOK * 16;
        for (int row = gw; row < MTOK; row += nw) {
            const f32x4* xr = (const f32x4*)(P.x + (size_t)row * 1024); float ss = 0.f;
#pragma unroll
            for (int i = 0; i < 4; ++i) { const f32x4 v = xr[lane + 64 * i]; ss += v[0] * v[0] + v[1] * v[1] + v[2] * v[2] + v[3] * v[3];
                u32x2 w; w.x = pk_bf16(v[0], v[1]); w.y = pk_bf16(v[2], v[3]); ((u32x2*)(XBp + (size_t)row * 1024))[lane + 64 * i] = w; }
#pragma unroll
            for (int o = 32; o >= 1; o >>= 1) ss += __shfl_xor(ss, o);
            if (lane < 16) rss7[(size_t)row * 16 + lane] = (lane == 0) ? ss : 0.f;
        }
    }
    for (int item = obid(); item < 256; item += ogdim()) {
        const int job = item >> 6, chunk = item & 63; const int l = job >> 1, kv = job & 1;
        const float* pos = (kv ? P.nsa_cmp_pos_v : P.nsa_cmp_pos_k) + (size_t)l * 2048;
        const float* w1 = (kv ? P.nsa_cmp_v_w1 : P.nsa_cmp_k_w1) + (size_t)l * 2048 * 256;
        const int c = tid & 255, hf = tid >> 8;
        float a = 0.f;
        const int r0 = chunk * 32 + hf * 16;
#pragma unroll
        for (int r = 0; r < 16; ++r) a += pos[r0 + r] * w1[(size_t)(r0 + r) * 256 + c];
        LAS float* red = (LAS float*)lds;
        __syncthreads();
        if (hf == 1) red[c] = a;
        __syncthreads();
        if (hf == 0) ((float*)(ws + WS_CBPART))[(size_t)item * 256 + c] = a + red[c];
        __syncthreads();
    }
}
__device__ void cbias_reduce(unsigned char* ws, int l) {
    const int tid = otid(); const int kv = tid >> 8, c = tid & 255;
    const float* part = (const float*)(ws + WS_CBPART) + (size_t)(l * 2 + kv) * 64 * 256 + c;
    float a = 0.f;
#pragma unroll 16
    for (int ch = 0; ch < 64; ++ch) a += part[(size_t)ch * 256];
    ((float*)(ws + WS_CBIAS))[l * 512 + tid] = a;
}

__device__ void rmsnorm_phase(const float* X, const float* g, bf16_t* H, float* outf) {
    const int lane = otid() & 63; const int gw = obid() * 8 + (otid() >> 6), nw = ogdim() * 8;
    f32x4 gv[4];
#pragma unroll
    for (int i = 0; i < 4; ++i) gv[i] = ((const f32x4*)g)[lane + 64 * i];
    for (int row = gw; row < MTOK; row += nw) {
        const f32x4* xr = (const f32x4*)(X + (size_t)row * 1024);
        f32x4 v[4]; float ss = 0.f;
#pragma unroll
        for (int i = 0; i < 4; ++i) { v[i] = xr[lane + 64 * i]; ss += v[i][0] * v[i][0] + v[i][1] * v[i][1] + v[i][2] * v[i][2] + v[i][3] * v[i][3]; }
#pragma unroll
        for (int o = 32; o >= 1; o >>= 1) ss += __shfl_xor(ss, o);
        const float rstd = rsqrtf(ss * (1.0f / 1024.0f) + 1e-6f);
        if (outf) {
#pragma unroll
            for (int i = 0; i < 4; ++i) ((f32x4*)(outf + (size_t)row * 1024))[lane + 64 * i] = v[i] * rstd * gv[i];
        } else {
#pragma unroll
            for (int i = 0; i < 4; ++i) { const f32x4 y = v[i] * rstd * gv[i]; u32x2 w; w.x = pk_bf16(y[0], y[1]); w.y = pk_bf16(y[2], y[3]); ((u32x2*)(H + (size_t)row * 1024))[lane + 64 * i] = w; }
        }
    }
}

__device__ void final_norm_phase(const bf16_t* XB, const float* g, float* out) {
    const int lane = otid() & 63; const int gw = obid() * 8 + (otid() >> 6), nw = ogdim() * 8;
    for (int row = gw; row < MTOK; row += nw) {
        const u32x4* xr = (const u32x4*)(XB + (size_t)row * 1024);
        float v[2][8]; float ss = 0.f;
#pragma unroll
        for (int i = 0; i < 2; ++i) { const u32x4 w = xr[lane + 64 * i];
            v[i][0] = __uint_as_float(w.x << 16); v[i][1] = __uint_as_float(w.x & 0xffff0000u); v[i][2] = __uint_as_float(w.y << 16); v[i][3] = __uint_as_float(w.y & 0xffff0000u);
            v[i][4] = __uint_as_float(w.z << 16); v[i][5] = __uint_as_float(w.z & 0xffff0000u); v[i][6] = __uint_as_float(w.w << 16); v[i][7] = __uint_as_float(w.w & 0xffff0000u);
#pragma unroll
            for (int e = 0; e < 8; ++e) ss += v[i][e] * v[i][e]; }
#pragma unroll
        for (int o = 32; o >= 1; o >>= 1) ss += __shfl_xor(ss, o);
        const float rstd = rsqrtf(ss * (1.0f / 1024.0f) + 1e-6f);
#pragma unroll
        for (int i = 0; i < 2; ++i) { const int c0 = (lane + 64 * i) * 8;
            const f32x4 g0 = *(const f32x4*)(g + c0), g1 = *(const f32x4*)(g + c0 + 4);
            f32x4 o0, o1;
#pragma unroll
            for (int e = 0; e < 4; ++e) { o0[e] = v[i][e] * rstd * g0[e]; o1[e] = v[i][4 + e] * rstd * g1[e]; }
            *(f32x4*)(out + (size_t)row * 1024 + c0) = o0; *(f32x4*)(out + (size_t)row * 1024 + c0 + 4) = o1; }
    }
}

#define MFMA32(a, b, c) __builtin_amdgcn_mfma_f32_32x32x16_bf16((a), (b), (c), 0, 0, 0)
__device__ __forceinline__ int crow16(int i, int h) { return (i & 3) + 8 * (i >> 2) + 4 * h; }
__device__ __forceinline__ f32x16 zero16() { f32x16 z; for (int i = 0; i < 16; ++i) z[i] = 0.f; return z; }
__device__ void cmp2_local(const bf16_t* CH, const bf16_t* w2T, bf16_t* KCMP, bf16_t* VCMPT, int L) {
    const int tid = otid(), w = tid >> 6, lane = tid & 63, r = lane & 31, h = lane >> 5;
    const int type = L >> 5;
    const bf16_t* wp = w2T + (size_t)type * 64 * 256 + 8 * h;
    const bf16_t* chp = CH + ((size_t)L * 256 + w * 32 + r) * 256 + 8 * h;
    f32x16 acc[2]; acc[0] = zero16(); acc[1] = zero16();
#pragma unroll 4
    for (int s = 0; s < 16; ++s) {
        const bf16x8 cf = *(const bf16x8*)(chp + 16 * s);
#pragma unroll
        for (int db = 0; db < 2; ++db) {
            const bf16x8 wf = *(const bf16x8*)(wp + (size_t)(32 * db + r) * 256 + 16 * s);
            acc[db] = (type == 0) ? MFMA32(wf, cf, acc[db]) : MFMA32(cf, wf, acc[db]);
        }
    }
    const int Rl0 = (L & 31) * 256 + w * 32;
#pragma unroll
    for (int db = 0; db < 2; ++db)
#pragma unroll
        for (int q4 = 0; q4 < 4; ++q4) {
            u32x2 o; o.x = pk_bf16(acc[db][4 * q4 + 0], acc[db][4 * q4 + 1]); o.y = pk_bf16(acc[db][4 * q4 + 2], acc[db][4 * q4 + 3]);
            if (type == 0) *(u32x2*)(KCMP + (size_t)(Rl0 + r) * 64 + 32 * db + 8 * q4 + 4 * h) = o;
            else *(u32x2*)(VCMPT + ((size_t)(Rl0 >> 8) * 64 + 32 * db + r) * 256 + (Rl0 & 255) + 8 * q4 + 4 * h) = o;
        }
}


__device__ __forceinline__ void qk_tile(const bf16_t* Kt  , const bf16x8 (&Qf)[4], f32x16 (&ST)[2], int r, int h) {
#pragma unroll
    for (int kb = 0; kb < 2; ++kb) {
        f32x16 a = zero16();
#pragma unroll
        for (int s = 0; s < 4; ++s) { const bf16x8 kf = *(const bf16x8*)(Kt + (size_t)(32 * kb + r) * 64 + 16 * s + 8 * h); a = MFMA32(kf, Qf[s], a); }
        ST[kb] = a;
    }
}
__device__ __forceinline__ bf16x8 pack8(const f32x16& x, int s2) {
    u32x4 p; p.x = pk_bf16(x[8 * s2 + 0], x[8 * s2 + 1]); p.y = pk_bf16(x[8 * s2 + 2], x[8 * s2 + 3]); p.z = pk_bf16(x[8 * s2 + 4], x[8 * s2 + 5]); p.w = pk_bf16(x[8 * s2 + 6], x[8 * s2 + 7]);
    return __builtin_bit_cast(bf16x8, p);
}
__device__ __forceinline__ void pv_tile(const bf16_t* Vt  , int ldv, const f32x16 (&Pm)[2], f32x16 (&O)[2], int r, int h) {
#pragma unroll
    for (int kb = 0; kb < 2; ++kb)
#pragma unroll
        for (int s2 = 0; s2 < 2; ++s2) {
            const bf16x8 pf = pack8(Pm[kb], s2);
#pragma unroll
            for (int db = 0; db < 2; ++db) {
                const bf16_t* vp = Vt + (size_t)(32 * db + r) * ldv + 32 * kb + 16 * s2 + 4 * h;
                const s16x4 lo = *(const s16x4*)vp, hi = *(const s16x4*)(vp + 8);
                const bf16x8 vf = __builtin_shufflevector(lo, hi, 0, 1, 2, 3, 4, 5, 6, 7);
                O[db] = MFMA32(vf, pf, O[db]);
            }
        }
}
constexpr int KB_BYTES = 64 * 144, VB_BYTES = 64 * 136, STG_BYTES = KB_BYTES + VB_BYTES;
constexpr int ATT_STAGE_OFF = 65536 + 512;
__device__ __forceinline__ float ex2(float x) { return __builtin_amdgcn_exp2f(x); }
__device__ __forceinline__ float xor8_add(float x) { const int y = __builtin_amdgcn_update_dpp(0, __float_as_int(x), 0x128, 0xf, 0xf, false); return x + __int_as_float(y); }
__device__ __forceinline__ float xor16_add(float x) { auto rr = __builtin_amdgcn_permlane16_swap(__float_as_uint(x), __float_as_uint(x), false, false); return __uint_as_float(rr[0]) + __uint_as_float(rr[1]); }
__device__ __forceinline__ float max3f(float a, float b, float c) { float r; asm("v_max3_f32 %0, %1, %2, %3" : "=v"(r) : "v"(a), "v"(b), "v"(c)); return r; }

__device__ __forceinline__ void qk_lds(const LAS unsigned char* kb_, unsigned kr_off, const bf16x8 (&Qf)[4], f32x16 (&ST)[2]) {
#pragma unroll
    for (int kb = 0; kb < 2; ++kb) {
        f32x16 a = zero16();
#pragma unroll
        for (int s = 0; s < 4; ++s) { const bf16x8 kf = *(const LAS bf16x8*)(kb_ + kr_off + kb * 32 * 144 + s * 32); a = MFMA32(kf, Qf[s], a); }
        ST[kb] = a;
    }
}
__device__ __forceinline__ void pv_lds(const LAS unsigned char* vb_, unsigned vr_off, const f32x16 (&Pm)[2], f32x16 (&O)[2]) {
#pragma unroll
    for (int kb = 0; kb < 2; ++kb)
#pragma unroll
        for (int s2 = 0; s2 < 2; ++s2) {
            const bf16x8 pf = pack8(Pm[kb], s2);
#pragma unroll
            for (int db = 0; db < 2; ++db) {
                const LAS unsigned char* vp = vb_ + vr_off + db * 32 * 136 + kb * 64 + s2 * 32;
                const s16x4 lo = *(const LAS s16x4*)vp, hi = *(const LAS s16x4*)(vp + 16);
                const bf16x8 vf = __builtin_shufflevector(lo, hi, 0, 1, 2, 3, 4, 5, 6, 7);
                O[db] = MFMA32(vf, pf, O[db]);
            }
        }
}
template <bool MASKED> __device__ __forceinline__ void softmax2(f32x16 (&ST)[2], unsigned vm, bool rowon, float& m_run, float& l_run, f32x16 (&O)[2]) {
    float mx = -1e30f;
    if (MASKED) {
#pragma unroll
        for (int kb = 0; kb < 2; ++kb)
#pragma unroll
            for (int i = 0; i < 16; ++i) { const bool v = (vm >> (16 * kb + i)) & 1u; mx = fmaxf(mx, v ? ST[kb][i] : -1e30f); }
    } else {
#pragma unroll
        for (int kb = 0; kb < 2; ++kb)
#pragma unroll
            for (int i = 0; i < 16; i += 2) mx = max3f(mx, ST[kb][i], ST[kb][i + 1]);
        mx = rowon ? mx : -1e30f;
    }
    if (__any(mx > m_run + 8.0f)) {
        const float mo = fmaxf(mx, __shfl_xor(mx, 32));
        const float m_new = fmaxf(m_run, mo);
        const float alpha = ex2(m_run - m_new);
        l_run *= alpha; m_run = m_new;
#pragma unroll
        for (int db = 0; db < 2; ++db) O[db] = O[db] * alpha;
    }
    float rs0 = 0.f, rs1 = 0.f;
    if (MASKED) {
#pragma unroll
        for (int kb = 0; kb < 2; ++kb)
#pragma unroll
            for (int i = 0; i < 16; ++i) { const bool v = (vm >> (16 * kb + i)) & 1u; const float p = v ? ex2(ST[kb][i] - m_run) : 0.f; ST[kb][i] = p; rs0 += p; }
    } else {
        const float m_use = rowon ? m_run : __builtin_inff();
#pragma unroll
        for (int kb = 0; kb < 2; ++kb)
#pragma unroll
            for (int i = 0; i < 16; i += 2) { const float p0 = ex2(ST[kb][i] - m_use), p1 = ex2(ST[kb][i + 1] - m_use); ST[kb][i] = p0; ST[kb][i + 1] = p1; rs0 += p0; rs1 += p1; }
    }
    l_run += rs0 + rs1;
}

template <int MODE> __device__ __forceinline__ void attn_branch(const bf16_t* Kg, const bf16_t* Vg, int ldv, int kt0, int kt1, const bf16x8 (&Qf)[4], int t, int qb, unsigned long long mysel,
                                                                float& m_run, float& l_run, float inv_l, f32x16 (&O)[2], LAS float* psw, LAS unsigned char* stage, int tid, int r, int h,
                                                                u32x4& kreg, u32x4& vreg, bool pre, const bf16_t* nK, const bf16_t* nV, int nldv) {
    const int srow = tid >> 3, sch = tid & 7;
    const bf16_t* kp = Kg + (size_t)kt0 * 4096 + srow * 64 + sch * 8;
    const bf16_t* vp = Vg + (size_t)srow * ldv + (size_t)kt0 * 64 + sch * 8;
    if (!pre) { kreg = *(const u32x4*)kp; if (MODE != 0) vreg = *(const u32x4*)vp; }
    const unsigned kw_off = srow * 144 + sch * 16, vw_off = srow * 136 + sch * 16;
    const unsigned kr_off = r * 144 + h * 16, vr_off = r * 136 + h * 8;
    const int nmax = (t >= 31) ? ((t - 31) >> 4) : -1;
#define ATT_NEXT_LOAD(have_more) do { if (have_more) { kp += 4096; kreg = *(const u32x4*)kp; if (MODE != 0) { vp += 64; vreg = *(const u32x4*)vp; } } \
        else if (nK) { kreg = *(const u32x4*)(nK + srow * 64 + sch * 8); if (nV) vreg = *(const u32x4*)(nV + (size_t)srow * nldv + sch * 8); } } while (0)
    __syncthreads();
    *(LAS u32x4*)(stage + kw_off) = kreg;
    if (MODE != 0) { *(LAS u32x2*)(stage + KB_BYTES + vw_off) = (u32x2){vreg.x, vreg.y}; *(LAS u32x2*)(stage + KB_BYTES + vw_off + 8) = (u32x2){vreg.z, vreg.w}; }
    ATT_NEXT_LOAD(kt0 < kt1);
    for (int kt = kt0; kt <= kt1; ++kt) {
        const int cur = (kt - kt0) & 1;
        __syncthreads();
        if (kt < kt1) {
            LAS unsigned char* nb = stage + (cur ^ 1) * STG_BYTES;
            *(LAS u32x4*)(nb + kw_off) = kreg;
            if (MODE != 0) { *(LAS u32x2*)(nb + KB_BYTES + vw_off) = (u32x2){vreg.x, vreg.y}; *(LAS u32x2*)(nb + KB_BYTES + vw_off + 8) = (u32x2){vreg.z, vreg.w}; }
            ATT_NEXT_LOAD(kt + 1 < kt1);
        }
        const LAS unsigned char* kb_ = stage + cur * STG_BYTES; const LAS unsigned char* vb_ = kb_ + KB_BYTES;
        bool selb = true, active = true;
        if (MODE == 2) { selb = (mysel >> kt) & 1ull; active = (__ballot(selb) != 0ull); }
        if (active) {
            f32x16 ST[2]; qk_lds(kb_, kr_off, Qf, ST);
            if (MODE == 0) {
                unsigned vm = 0u;
#pragma unroll
                for (int kb = 0; kb < 2; ++kb)
#pragma unroll
                    for (int i = 0; i < 16; ++i) { const int n = 64 * kt + 32 * kb + crow16(i, h); if (n <= nmax) vm |= 1u << (16 * kb + i); }
                softmax2<true>(ST, vm, true, m_run, l_run, O);
            } else if (MODE == 1) {
#pragma unroll
                for (int kb = 0; kb < 2; ++kb)
#pragma unroll
                    for (int i = 0; i < 16; ++i) {
                        const int n = 64 * kt + 32 * kb + crow16(i, h);
                        const float p = (n <= nmax) ? ex2(ST[kb][i] - m_run) * inv_l : 0.f; ST[kb][i] = p;
                        const float ps = xor16_add(xor8_add(p));
                        if (r < 8) psw[r * 256 + n] = ps;
                    }
                pv_lds(vb_, vr_off, ST, O);
            } else {
                const bool edge = (MODE == 2) ? (kt == qb) : (kt == qb || kt == qb - 8);
                if (edge) {
                    unsigned vm = 0u;
#pragma unroll
                    for (int kb = 0; kb < 2; ++kb)
#pragma unroll
                        for (int i = 0; i < 16; ++i) {
                            const int kp_ = 64 * kt + 32 * kb + crow16(i, h);
                            const bool v = (MODE == 2) ? (selb && kp_ <= t) : (kp_ <= t && kp_ + 512 > t);
                            if (v) vm |= 1u << (16 * kb + i);
                        }
                    softmax2<true>(ST, vm, true, m_run, l_run, O);
                } else {
                    softmax2<false>(ST, 0u, selb, m_run, l_run, O);
                }
                pv_lds(vb_, vr_off, ST, O);
            }
        }
    }
#undef ATT_NEXT_LOAD
}

__device__ void nsa_attn_phase(const bf16_t* Q, const bf16_t* KV, const bf16_t* KCMP, const bf16_t* VCMPT, const float* gates, bf16_t* AO, LAS unsigned char* lds) {
    const int tid = otid(), wid = tid >> 6, lane = tid & 63, r = lane & 31, h = lane >> 5;
    LAS float* psw = (LAS float*)lds + wid * 2048;
    LAS unsigned long long* selw = (LAS unsigned long long*)(lds + 65536) + wid * 8;
    LAS unsigned char* stage = lds + ATT_STAGE_OFF;
    if (wid < 4) __builtin_amdgcn_s_setprio(2);
    const int G = ogdim();
    for (int idx = obid(); idx < 2048; idx += G) {
        const int vb = idx & 255, jj = idx >> 8;
        const int xcd = vb & 7, slot = vb >> 3;
        const int bg = xcd * 4 + (slot >> 3), kq = slot & 7;
        const int qb = (jj & 1) ? (16 * (jj >> 1) + 15 - kq) : (16 * (jj >> 1) + kq);
        const int b = bg >> 2, g = bg & 3;
        const int head = g * 4 + (r >> 3);
        const int tok = wid * 8 + (r & 7);
        const int t = qb * 64 + tok;
        const size_t rowg = (size_t)b * 4096 + t;
        bf16x8 Qf[4];
        { const bf16_t* qp = Q + ((size_t)(b * 16 + head) * 4096 + t) * 64 + 8 * h;
#pragma unroll
          for (int s = 0; s < 4; ++s) Qf[s] = *(const bf16x8*)(qp + 16 * s); }
        f32x16 OUT[2];
#pragma unroll
        for (int i = 0; i < 32; ++i) psw[lane + 64 * i] = 0.f;
        {
            const bf16_t* Kc = KCMP + (size_t)bg * 256 * 64; const bf16_t* Vc = VCMPT + (size_t)bg * 64 * 256;
            int ntc = ((4 * qb + 2) >> 6) + 1; if (ntc > 4) ntc = 4;
            float m_run = -1e30f, l_run = 0.f;
            f32x16 O[2]; O[0] = zero16(); O[1] = zero16();
            u32x4 kst = {0u, 0u, 0u, 0u}, vst = {0u, 0u, 0u, 0u};
            attn_branch<0>(Kc, Vc, 256, 0, ntc - 1, Qf, t, qb, 0ull, m_run, l_run, 0.f, O, psw, stage, tid, r, h, kst, vst, false, Kc, Vc, 256);
            l_run += __shfl_xor(l_run, 32);
            const float inv_l = l_run > 0.f ? __builtin_amdgcn_rcpf(l_run) : 0.f;
            attn_branch<1>(Kc, Vc, 256, 0, ntc - 1, Qf, t, qb, 0ull, m_run, l_run, inv_l, O, psw, stage, tid, r, h, kst, vst, true, nullptr, nullptr, 0);
            const float g_c = gates[rowg * 48 + head];
#pragma unroll
            for (int db = 0; db < 2; ++db) OUT[db] = O[db] * g_c;
        }
        __syncthreads();
        for (int tk = 0; tk < 8; ++tk) {
            const int mblk = lane;
            float imp = 0.f;
#pragma unroll
            for (int j = -1; j <= 3; ++j) { const int n = 4 * mblk + j; if (n >= 0) imp += psw[tk * 256 + n]; }
            if (mblk == 0 || mblk == qb || mblk == qb - 1) imp = 1e9f;
            if (mblk > qb) imp = -1e30f;
            int rank = 0;
#pragma unroll 8
            for (int mp = 0; mp < 64; ++mp) { const float o = __int_as_float(__builtin_amdgcn_readlane(__float_as_int(imp), mp)); rank += (o > imp || (o == imp && mp < mblk)) ? 1 : 0; }
            unsigned long long msk = __ballot(rank < 16);
            msk &= (qb >= 63) ? ~0ull : ((2ull << qb) - 1ull);
            if (lane == 0) selw[tk] = msk;
        }
        __syncthreads();
        const unsigned long long mysel = selw[r & 7];
#pragma unroll
        for (int db = 0; db < 2; ++db)
#pragma unroll
            for (int i = 0; i < 16; ++i) psw[(db * 16 + i) * 64 + lane] = OUT[db][i];
        u32x4 kst2 = {0u, 0u, 0u, 0u}, vst2 = {0u, 0u, 0u, 0u};
        {
            const bf16_t* Ks = KV + 2 * KVSZ + (size_t)bg * 4096 * 64; const bf16_t* Vs = KV + 3 * KVSZ + (size_t)bg * 64 * 4096;
            float m_run = -1e30f, l_run = 0.f; f32x16 O[2]; O[0] = zero16(); O[1] = zero16();
            attn_branch<2>(Ks, Vs, 4096, 0, qb, Qf, t, qb, mysel, m_run, l_run, 0.f, O, psw, stage, tid, r, h, kst2, vst2, false,
                           KV + 4 * KVSZ + (size_t)bg * 4096 * 64 + (size_t)(qb > 8 ? qb - 8 : 0) * 4096, KV + 5 * KVSZ + (size_t)bg * 64 * 4096 + (size_t)(qb > 8 ? qb - 8 : 0) * 64, 4096);
            l_run += __shfl_xor(l_run, 32);
            const float sc = (l_run > 0.f ? __builtin_amdgcn_rcpf(l_run) : 0.f) * gates[rowg * 48 + 16 + head];
#pragma unroll
            for (int db = 0; db < 2; ++db)
#pragma unroll
                for (int i = 0; i < 16; ++i) psw[(db * 16 + i) * 64 + lane] += O[db][i] * sc;
        }
        {
            const bf16_t* Kw = KV + 4 * KVSZ + (size_t)bg * 4096 * 64; const bf16_t* Vw = KV + 5 * KVSZ + (size_t)bg * 64 * 4096;
            float m_run = -1e30f, l_run = 0.f; f32x16 O[2]; O[0] = zero16(); O[1] = zero16();
            attn_branch<3>(Kw, Vw, 4096, (qb > 8 ? qb - 8 : 0), qb, Qf, t, qb, 0ull, m_run, l_run, 0.f, O, psw, stage, tid, r, h, kst2, vst2, true, nullptr, nullptr, 0);
            l_run += __shfl_xor(l_run, 32);
            const float sc = (l_run > 0.f ? __builtin_amdgcn_rcpf(l_run) : 0.f) * gates[rowg * 48 + 32 + head];
#pragma unroll
            for (int db = 0; db < 2; ++db)
#pragma unroll
                for (int i = 0; i < 16; ++i) OUT[db][i] = psw[(db * 16 + i) * 64 + lane] + O[db][i] * sc;
        }
        {
            bf16_t* op = AO + rowg * 1024 + head * 64;
#pragma unroll
            for (int db = 0; db < 2; ++db)
#pragma unroll
                for (int q4 = 0; q4 < 4; ++q4) {
                    u32x2 w; w.x = pk_bf16(OUT[db][4 * q4 + 0], OUT[db][4 * q4 + 1]); w.y = pk_bf16(OUT[db][4 * q4 + 2], OUT[db][4 * q4 + 3]);
                    *(u32x2*)(op + 32 * db + 8 * q4 + 4 * h) = w;
                }
        }
    }
    __builtin_amdgcn_s_setprio(0);
    __syncthreads();
}


__device__ void sgu_spatial_phase(const bf16_t* UV, const float* lng, const float* lnb, const bf16_t* SWS, const float* bs, bf16_t* GATED, LAS unsigned char* lds) {
    constexpr int LDV = 136;
    LAS bf16_t* vnT = (LAS bf16_t*)lds;
    LAS float* mu = (LAS float*)(lds + 128 * LDV * 2); LAS float* rsd = mu + 128;
    const int tid = otid(), wid = tid >> 6, lane = tid & 63, r = lane & 31, h = lane >> 5;
    for (int cn = obid(); cn < 256; cn += ogdim()) {
        const size_t tok0 = (size_t)cn * 128;
        __syncthreads();
#pragma unroll 4
        for (int rr = 0; rr < 16; ++rr) {
            const int sl = wid * 16 + rr;
            const u32x4* vp = (const u32x4*)(UV + (tok0 + sl) * 2048 + 1024);
            float s1 = 0.f, s2 = 0.f;
#pragma unroll
            for (int i = 0; i < 2; ++i) { const u32x4 w = vp[lane + 64 * i];
#pragma unroll
                for (int j = 0; j < 4; ++j) { const float a = __uint_as_float(w[j] << 16), c = __uint_as_float(w[j] & 0xffff0000u); s1 += a + c; s2 += a * a + c * c; } }
#pragma unroll
            for (int o = 32; o >= 1; o >>= 1) { s1 += __shfl_xor(s1, o); s2 += __shfl_xor(s2, o); }
            const float mean = s1 * (1.0f / 1024.0f); const float var = fmaxf(s2 * (1.0f / 1024.0f) - mean * mean, 0.f);
            if (lane == 0) { mu[sl] = mean; rsd[sl] = rsqrtf(var + 1e-5f); }
        }
        __syncthreads();
        for (int g = 0; g < 8; ++g) {
            {
                const int sl = tid >> 2, cq = tid & 3;
                const float mean = mu[sl], rs = rsd[sl];
                const bf16_t* vp = UV + (tok0 + sl) * 2048 + 1024 + g * 128 + cq * 32;
#pragma unroll
                for (int i = 0; i < 4; ++i) {
                    const u32x4 w = *(const u32x4*)(vp + i * 8);
                    const int c0 = cq * 32 + i * 8;
                    const f32x4 ga = *(const f32x4*)(lng + g * 128 + c0), gb = *(const f32x4*)(lng + g * 128 + c0 + 4);
                    const f32x4 ba = *(const f32x4*)(lnb + g * 128 + c0), bb = *(const f32x4*)(lnb + g * 128 + c0 + 4);
#pragma unroll
                    for (int j = 0; j < 4; ++j) {
                        const float a = __uint_as_float(w[j] << 16), c = __uint_as_float(w[j] & 0xffff0000u);
                        const float gA = (2 * j < 4) ? ga[(2 * j) & 3] : gb[(2 * j) & 3], gB = (2 * j + 1 < 4) ? ga[(2 * j + 1) & 3] : gb[(2 * j + 1) & 3];
                        const float bA = (2 * j < 4) ? ba[(2 * j) & 3] : bb[(2 * j) & 3], bB = (2 * j + 1 < 4) ? ba[(2 * j + 1) & 3] : bb[(2 * j + 1) & 3];
                        vnT[(c0 + 2 * j) * LDV + sl] = f2bf((a - mean) * rs * gA + bA);
                        vnT[(c0 + 2 * j + 1) * LDV + sl] = f2bf((c - mean) * rs * gB + bB);
                    }
                }
            }
            __syncthreads();
            const int tb = wid & 3, ch = wid >> 2;
            f32x16 acc[2]; acc[0] = zero16(); acc[1] = zero16();
            const bf16_t* wsp = SWS + ((size_t)g * 128 + tb * 32 + r) * 128 + 8 * h;
            for (int ks = 0; ks <= 2 * tb + 1; ++ks) {
                const bf16x8 bfrag = *(const bf16x8*)(wsp + 16 * ks);
#pragma unroll
                for (int cb = 0; cb < 2; ++cb) {
                    const bf16x8 afrag = *(const LAS bf16x8*)(vnT + (ch * 64 + cb * 32 + r) * LDV + 16 * ks + 8 * h);
                    acc[cb] = MFMA32(afrag, bfrag, acc[cb]);
                }
            }
            const int tl = tb * 32 + r; const size_t token = tok0 + tl;
            const float bias = bs[g * 128 + tl];
#pragma unroll
            for (int cb = 0; cb < 2; ++cb)
#pragma unroll
                for (int q4 = 0; q4 < 4; ++q4) {
                    const int c0 = g * 128 + ch * 64 + cb * 32 + 8 * q4 + 4 * h;
                    const u32x2 uw = *(const u32x2*)(UV + token * 2048 + c0);
                    const float u0 = __uint_as_float(uw.x << 16), u1 = __uint_as_float(uw.x & 0xffff0000u), u2 = __uint_as_float(uw.y << 16), u3 = __uint_as_float(uw.y & 0xffff0000u);
                    u32x2 w; w.x = pk_bf16(u0 * (acc[cb][4 * q4 + 0] + bias), u1 * (acc[cb][4 * q4 + 1] + bias)); w.y = pk_bf16(u2 * (acc[cb][4 * q4 + 2] + bias), u3 * (acc[cb][4 * q4 + 3] + bias));
                    *(u32x2*)(GATED + token * 1024 + c0) = w;
                }
            __syncthreads();
        }
    }
    __syncthreads();
}

__device__ void pool_diff_phase(const float* __restrict__ Z, bf16_t* __restrict__ Dd) {
    const size_t gtid = (size_t)obid() * 512 + otid(), gsz = (size_t)ogdim() * 512;
    for (size_t idx = gtid; idx < (size_t)256 * 1024; idx += gsz) {
        const int c4 = (int)(idx & 255), seg = (int)(idx >> 8);
        const int t0 = seg * 32, s0 = t0 & 4095; const int w = 2 << (c4 >> 6);
        const f32x4* zp = (const f32x4*)Z + c4;
        f32x4 S = {0.f, 0.f, 0.f, 0.f};
        const int jlo = (s0 - w > 0) ? (s0 - w) : 0;
        for (int j = jlo; j < s0; ++j) S = S + zp[(size_t)(t0 - s0 + j) * 256];
#pragma unroll 8
        for (int i = 0; i < 32; ++i) {
            const int s = s0 + i; const f32x4 zt = zp[(size_t)(t0 + i) * 256];
            S = S + zt; if (s - w >= 0) S = S - zp[(size_t)(t0 + i - w) * 256];
            const float inv = 1.0f / (float)((s + 1 < w) ? (s + 1) : w);
            const f32x4 d = S * inv - zt;
            u32x2 o; o.x = pk_bf16(d[0], d[1]); o.y = pk_bf16(d[2], d[3]);
            *(u32x2*)(Dd + (size_t)(t0 + i) * 1024 + c4 * 4) = o;
        }
    }
}

#define XB_TMO      128
#define XB_XCNT(j)  (256  + 64 * (j))
#define XB_XSUB(j)  (1280 + 64 * (j))
#define XB_XGEN(j)  (2304 + 64 * (j))
#define XB_TOP      3328
#define XB_TOPGEN   3392
#define XCD_BAR_WORDS 3456
#define XB_SPIN_CAP (1u << 18)

__device__ __forceinline__ unsigned xb_ld(unsigned* p)              { return __hip_atomic_load(p, __ATOMIC_RELAXED, __HIP_MEMORY_SCOPE_AGENT); }
__device__ __forceinline__ unsigned xb_add(unsigned* p, unsigned v) { return __hip_atomic_fetch_add(p, v, __ATOMIC_RELAXED, __HIP_MEMORY_SCOPE_AGENT); }
__device__ __forceinline__ unsigned xb_xcc_id() { return (unsigned)__builtin_amdgcn_s_getreg((3 << 11) | 20) & 0xFu; }
#define XB_SPIN(cond, bar) do { unsigned _sp = 0; while (cond) { __builtin_amdgcn_s_sleep(1); \
    if ((++_sp & 255u) == 0u) { if (xb_ld(&(bar)[XB_TMO])) break; if (_sp > XB_SPIN_CAP) { atomicAdd(&(bar)[XB_TMO], 1u); break; } } } } while (0)

struct XcdBarrier {
    unsigned* bar; unsigned x;
    volatile LAS unsigned* st;
};

__device__ __forceinline__ XcdBarrier xcd_barrier_post(unsigned* bar, volatile LAS unsigned* st) {
    XcdBarrier b; b.bar = bar; b.x = xb_xcc_id(); b.st = st;
    if (threadIdx.x == 0) (void)xb_add(&bar[XB_XCNT(b.x)], 1u);
    return b;
}
__device__ __forceinline__ void xcd_barrier_complete(unsigned* bar, unsigned x, unsigned& nloc, unsigned& nx) {
    const unsigned G = gridDim.x * gridDim.y * gridDim.z;
    unsigned sum, cnt, mine, sp = 0u;
    for (;;) {
        sum = 0u; cnt = 0u; mine = 0u;
#pragma unroll
        for (unsigned j = 0; j < 16; ++j) { const unsigned c = xb_ld(&bar[XB_XCNT(j)]); sum += c; cnt += (c > 0u) ? 1u : 0u; mine = (j == x) ? c : mine; }
        if (sum == G) break;
        __builtin_amdgcn_s_sleep(1);
        if ((++sp & 255u) == 0u) { if (xb_ld(&bar[XB_TMO])) break; if (sp > XB_SPIN_CAP) { atomicAdd(&bar[XB_TMO], 1u); break; } }
    }
    nloc = mine > 0u ? mine : 1u; nx = cnt > 0u ? cnt : 1u;
}

__device__ __forceinline__ void xcd_barrier(const XcdBarrier& b) {
    asm volatile("s_waitcnt vmcnt(0)" ::: "memory");
    __syncthreads();
    if (threadIdx.x == 0) {
        unsigned* bar = b.bar;
        __builtin_amdgcn_s_waitcnt(0);
        unsigned nloc = b.st[0], nx = b.st[1];
        if (nloc == 0u) { xcd_barrier_complete(bar, b.x, nloc, nx); b.st[0] = nloc; b.st[1] = nx; }
        const unsigned old = xb_add(&bar[XB_XSUB(b.x)], 1u);
        const unsigned gen = old / nloc;
        if (old + 1u == (gen + 1u) * nloc) {
            __builtin_amdgcn_fence(__ATOMIC_RELEASE, "agent");
            asm volatile("s_waitcnt vmcnt(0)" ::: "memory");
            const unsigned og = xb_add(&bar[XB_TOP], 1u);
            const unsigned tg = og / nx;
            if (og + 1u == (tg + 1u) * nx) xb_add(&bar[XB_TOPGEN], 1u);
            else XB_SPIN(xb_ld(&bar[XB_TOPGEN]) == tg, bar);
            __builtin_amdgcn_fence(__ATOMIC_ACQUIRE, "agent");
            xb_add(&bar[XB_XGEN(b.x)], 1u);
            asm volatile("s_waitcnt vmcnt(0)" ::: "memory");
        } else {
            XB_SPIN(xb_ld(&bar[XB_XGEN(b.x)]) == gen, bar);
            __builtin_amdgcn_fence(__ATOMIC_ACQUIRE, "agent");
            asm volatile("s_waitcnt vmcnt(0)" ::: "memory");
        }
    }
    __syncthreads();
}

constexpr int NPH = 25;
__constant__ unsigned char PROG[NPH][2] = {
    {0, 0},
    {3, 0}, {4, 0}, {5, 0}, {6, 0}, {7, 0}, {13, 0}, {14, 0},
    {8, 1}, {9, 1}, {7, 1}, {13, 1}, {14, 1},
    {10, 2}, {11, 2}, {7, 2}, {13, 2}, {14, 2},
    {3, 3}, {4, 3}, {5, 3}, {6, 3}, {7, 3}, {13, 3}, {14, 3},
};
__global__ void __launch_bounds__(512, 2) fwd_megakernel(Params P) {
    extern __shared__ __attribute__((aligned(16))) unsigned char lds_raw[];
    LAS unsigned char* lds = (LAS unsigned char*)lds_raw;
    cg::grid_group grid = cg::this_grid();
    { volatile LAS unsigned* st0 = (volatile LAS unsigned*)(lds + 131072); if (threadIdx.x == 0) { st0[0] = 0u; st0[1] = 0u; } __syncthreads(); }
    (void)xcd_barrier_post((unsigned*)(P.ws + WS_BAR), (volatile LAS unsigned*)(lds + 131072));
    prologue_phase(P, lds);
    if (obid() == 0 && otid() == 0) {
        const float** tb = (const float**)(P.ws + WS_TBL);
        tb[0] = P.x; tb[1] = P.mix_norm; tb[2] = P.ffn_norm; tb[3] = P.final_norm; tb[4] = P.nsa_cmp_k_w2; tb[5] = P.nsa_cmp_v_w2;
        tb[6] = P.sgu_ln_g; tb[7] = P.sgu_ln_b; tb[8] = P.sgu_b_s; tb[9] = P.pool_scale;
    }
    grid.sync();
    unsigned char* const ws_k = P.ws; float* const out_k = P.out;
#pragma unroll 1
    for (int ph = 1; ph <= NPH; ++ph) {
        const int type = (ph < NPH) ? (int)PROG[ph][0] : 15, layer = (ph < NPH) ? (int)PROG[ph][1] : 0;
        unsigned char* ws = ws_k; asm volatile("" : "+s"(ws));
        const float* const* tb = (const float* const*)(ws + WS_TBL);
        bf16_t* H = (bf16_t*)(ws + WS_H);
        bf16_t* BIG = (bf16_t*)(ws + WS_BIG);
        bf16_t* H2 = (bf16_t*)(ws + WS_H2);
        float* RSS = (float*)(ws + WS_RSS);
        const float* rss_in = RSS + (size_t)((layer == 0) ? 7 : (2 * layer - 1)) * MTOK * 16;
        bf16_t* XB = H2;
        float* X = out_k; asm volatile("" : "+s"(X));
        const int kind = layer % 3, j = layer / 3;
        switch (type) {
        case 15: final_norm_phase(XB, tb[3], X); break;
        case 3: { if (obid() == 0) cbias_reduce(ws, j);
                  EpiNsaIn E; E.Q = BIG; E.KV = BIG + (size_t)MTOK * 1024; E.gates = (float*)(ws + WS_GATES); E.cs = (const float*)(ws + WS_CS); E.rss = rss_in;
                  run_gemm(lds, XB, 1024, (const bf16_t*)(ws + WS_NWIN) + (size_t)j * NSA_NP * 1024, MTOK, 2560, 1024, E); } break;
        case 4: if (obid() >= 64) {
                  EpiGates E; E.gates = (float*)(ws + WS_GATES); E.rss = rss_in;
                  pg8::Gemm g; g.A = XB; g.Bt = (const bf16_t*)(ws + WS_NWIN) + (size_t)j * NSA_NP * 1024; g.M = MTOK; g.N = NSA_NP; g.K = 1024; g.lda = 1024; g.acs = 0;
                  GateOrder S; S.G = ogdim() - 64; S.c = obid() - 64;
                  pg8::gemm_phase<EpiGates, GateOrder, false>(lds, g, S, E, nullptr);
                } else { EpiBf16<2> E; E.O = (bf16_t*)(ws + WS_CH); E.ldc = 256; E.aux = (const float*)(ws + WS_CBIAS) + j * 512; E.rss = nullptr;
                  pg8::Gemm g; g.A = BIG + (size_t)MTOK * 1024; g.Bt = (const bf16_t*)(ws + WS_CW1) + (size_t)j * 512 * 2048; g.M = 16384; g.N = 512; g.K = 2048; g.lda = 1024; g.acs = 0;
                  CmpOrder S; S.G = ogdim(); S.c = obid();
                  pg8::gemm_phase<EpiBf16<2>, CmpOrder, false>(lds, g, S, E, nullptr); } break;
        case 5: if (obid() < 64) cmp2_local((const bf16_t*)(ws + WS_CH), (const bf16_t*)(ws + WS_W2T) + (size_t)j * 2 * 64 * 256, (bf16_t*)(ws + WS_KCMP), (bf16_t*)(ws + WS_VCMPT), obid()); break;
        case 6: nsa_attn_phase(BIG, BIG + (size_t)MTOK * 1024, (const bf16_t*)(ws + WS_KCMP), (const bf16_t*)(ws + WS_VCMPT), (const float*)(ws + WS_GATES), H, lds); break;
        case 7: case 14: {
                  EpiResid E; E.XB = XB;
                  if (type == 7) E.rss = RSS + (size_t)(2 * layer) * MTOK * 16; else E.rss = (layer < 3) ? RSS + (size_t)(2 * layer + 1) * MTOK * 16 : nullptr;
                  const bf16_t* A = H; int K = 1024; const bf16_t* Bt;
                  if (type == 14) { A = BIG; K = FH; Bt = (const bf16_t*)(ws + WS_WDN) + (size_t)layer * 1024 * FH; }
                  else if (kind == 0) Bt = (const bf16_t*)(ws + WS_NWOUT) + (size_t)j * 1024 * 1024;
                  else if (kind == 1) Bt = (const bf16_t*)(ws + WS_SWOUT);
                  else Bt = (const bf16_t*)(ws + WS_PWOUT);
                  run_gemm(lds, A, K, Bt, MTOK, 1024, K, E); } break;
        case 8: { EpiBf16<0> E; E.O = BIG; E.ldc = 2048; E.aux = nullptr; E.rss = rss_in;
                  run_gemm(lds, XB, 1024, (const bf16_t*)(ws + WS_SWIN), MTOK, 2048, 1024, E); } break;
        case 9: sgu_spatial_phase(BIG, tb[6], tb[7], (const bf16_t*)(ws + WS_SWS), tb[8], H, lds); break;
        case 10: { EpiF32 E; E.C = (float*)BIG; E.rss = rss_in;
                  run_gemm(lds, XB, 1024, (const bf16_t*)(ws + WS_PWIN), MTOK, 1024, 1024, E); } break;
        case 11: pool_diff_phase((const float*)BIG, H); break;
        case 12: { EpiBf16<1> E; E.O = BIG; E.ldc = 1024; E.aux = tb[9]; E.rss = nullptr;
                  int kk = 256; asm volatile("" : "+s"(kk));
                  run_gemm(lds, H, 1024, (const bf16_t*)(ws + WS_PGRP), MTOK, 1024, kk, E, 512); } break;
        case 13: { EpiGU E; E.HID = BIG; E.rss = RSS + (size_t)(2 * layer) * MTOK * 16;
                  run_gemm(lds, XB, 1024, (const bf16_t*)(ws + WS_WGU) + (size_t)layer * 5632 * 1024, MTOK, 5632, 1024, E); } break;
        default: break;
        }
        if (ph < NPH && type != 4) { XcdBarrier xb; xb.bar = (unsigned*)(ws + WS_BAR); xb.x = xb_xcc_id(); xb.st = (volatile LAS unsigned*)(lds + 131072); xcd_barrier(xb); }
    }
}

extern "C" void kernel_launch(void* const* d_in, const int* in_sizes, int n_in, void* d_out, int out_size, void* d_ws, size_t ws_size, hipStream_t stream) {
    static int grid_blocks = 0;
    if (grid_blocks == 0) {
        if (n_in != 25 || out_size != MTOK * DM || ws_size < WS_END) { fprintf(stderr, "kernel_launch: unexpected shapes (n_in %d, out %d, ws %zu need %zu)\n", n_in, out_size, ws_size, (size_t)WS_END); grid_blocks = -1; return; }
        int dev = 0, cus = 0, per_cu = 0;
        hipGetDevice(&dev);
        hipDeviceGetAttribute(&cus, hipDeviceAttributeMultiprocessorCount, dev);
        if (hipFuncSetAttribute((const void*)fwd_megakernel, hipFuncAttributeMaxDynamicSharedMemorySize, LDS_BYTES) != hipSuccess) { fprintf(stderr, "kernel_launch: hipFuncSetAttribute failed\n"); grid_blocks = -1; return; }
        if (hipOccupancyMaxActiveBlocksPerMultiprocessor(&per_cu, (const void*)fwd_megakernel, 512, LDS_BYTES) != hipSuccess || per_cu < 1) { fprintf(stderr, "kernel_launch: occupancy query gave %d\n", per_cu); per_cu = 1; }
        (void)hipGetLastError();
        grid_blocks = cus * 1;
    }
    if (grid_blocks < 0) return;
    Params p{};
    p.x = (const float*)d_in[0]; p.positions = (const int*)d_in[1]; p.mix_norm = (const float*)d_in[2]; p.ffn_norm = (const float*)d_in[3]; p.final_norm = (const float*)d_in[4];
    p.nsa_w_in = (const float*)d_in[5]; p.nsa_cmp_pos_k = (const float*)d_in[6]; p.nsa_cmp_k_w1 = (const float*)d_in[7]; p.nsa_cmp_k_w2 = (const float*)d_in[8];
    p.nsa_cmp_pos_v = (const float*)d_in[9]; p.nsa_cmp_v_w1 = (const float*)d_in[10]; p.nsa_cmp_v_w2 = (const float*)d_in[11]; p.nsa_w_out = (const float*)d_in[12];
    p.sgu_w_in = (const float*)d_in[13]; p.sgu_ln_g = (const float*)d_in[14]; p.sgu_ln_b = (const float*)d_in[15]; p.sgu_w_s = (const float*)d_in[16]; p.sgu_b_s = (const float*)d_in[17]; p.sgu_w_out = (const float*)d_in[18];
    p.pool_w_in = (const float*)d_in[19]; p.pool_w_grp = (const float*)d_in[20]; p.pool_scale = (const float*)d_in[21]; p.pool_w_out = (const float*)d_in[22];
    p.ffn_w_gate_up = (const float*)d_in[23]; p.ffn_w_down = (const float*)d_in[24];
    p.out = (float*)d_out; p.ws = (unsigned char*)d_ws;
    if (hipMemsetAsync((unsigned char*)d_ws + WS_BAR, 0, 16384, stream) != hipSuccess) { fprintf(stderr, "kernel_launch: memset of barrier words failed\n"); return; }
    void* args[] = {&p};
    hipError_t e = hipLaunchCooperativeKernel((const void*)fwd_megakernel, dim3(grid_blocks), dim3(512), args, LDS_BYTES, stream);
    if (e != hipSuccess) fprintf(stderr, "cooperative launch failed: %s (grid %d)\n", hipGetErrorString(e), grid_blocks);
}
```

```cpp
#include <hip/hip_runtime.h>
#include <hip/hip_cooperative_groups.h>
#include <cstdio>
namespace cg = cooperative_groups;
namespace pg8 {
#define PG8_LAS __attribute__((address_space(3)))
typedef unsigned short bf16_t;
typedef short bf16x8 __attribute__((ext_vector_type(8)));
typedef float f32x4 __attribute__((ext_vector_type(4)));
typedef unsigned u32x4 __attribute__((ext_vector_type(4)));
constexpr int BM = 256, BK = 64, HALF = 128, HTB = HALF * BK * 2  , STAGE_BYTES = 8 * HTB, NXCD = 8, WGM = 8;

__host__ __device__ __forceinline__ int lds_byte(int r, int c) { const int st = (r >> 4) * 2 + (c >> 5), rr = r & 15, cc = c & 31, ob = rr * 64 + cc * 2; return st * 1024 + (ob ^ (((ob >> 9) & 1) << 5)); }
__host__ __device__ __forceinline__ void stage_rc(int b, int& R, int& C) { const int st = b / 1024, sb = b % 1024, swz = sb ^ (((sb >> 9) & 1) << 5); R = (st >> 1) * 16 + swz / 64; C = (st & 1) * 32 + (swz % 64) / 2; }
__host__ __device__ __forceinline__ int perm32(int rho) { const int n = rho >> 4, i = rho & 15; return 8 * (i >> 2) + 4 * n + (i & 3); }

struct Unit { int pm, pn; };
struct Gemm { const bf16_t* A; const bf16_t* Bt; int M, N, K, lda, acs; };

struct StaticOrder {
    int nM, nN, nwg, G, c;
    __host__ __device__ void init(int M, int N, int G_, int c_) { nM = M / BM; nN = N / BM; nwg = nM * nN; G = G_; c = c_; }
    __host__ __device__ bool next(int i, Unit& u) const {
        const long L = (long)i * G + c; if (L >= nwg) return false;
        int wgid = (int)L; { const int q = nwg / NXCD, r = nwg % NXCD, xcd = wgid % NXCD, off = wgid / NXCD; wgid = (xcd < r ? xcd * (q + 1) : r * (q + 1) + (xcd - r) * q) + off; }
        const int nig = WGM * nN, gid = wgid / nig, fm = gid * WGM, gsz = (nM - fm) < WGM ? (nM - fm) : WGM;
        u.pm = fm + ((wgid % nig) % gsz); u.pn = (wgid % nig) / gsz; return true;
    }
    __device__ __forceinline__ void a_ready(const Unit&) const {}
    __device__ __forceinline__ void done(const Unit&) const {}
};
template <class Epi, class Sched, bool STAMP = false>
__device__ __forceinline__ void gemm_phase(PG8_LAS unsigned char* lds, const Gemm g, const Sched& S, const Epi& E, unsigned long long* stamps) {
    int tid_ = threadIdx.x; asm volatile("" : "+v"(tid_)); const int tid = tid_, wid = __builtin_amdgcn_readfirstlane(tid >> 6), lane = tid & 63, wr = wid >> 2, wc = wid & 3, fr = lane & 15, fq = lane >> 4;
    const int K = g.K, nt = K / BK;
    int ts_lo = 0, ts_hi = 0, nts = 0; const unsigned long long rt_entry = STAMP ? (unsigned long long)wall_clock64() : 0ull;
#define PG8_STAMP() do { if (STAMP && wid == 0 && nts < 64) { const unsigned long long _c = (unsigned long long)clock64(); \
        ts_lo = (lane == nts) ? (int)(unsigned)_c : ts_lo; ts_hi = (lane == nts) ? (int)(unsigned)(_c >> 32) : ts_hi; ++nts; } } while (0)
    PG8_STAMP();
    unsigned voffA[2], voffB[2];
#pragma unroll
    for (int i = 0; i < 2; ++i) { int R, C; stage_rc(tid * 16 + i * 8192, R, C); const int Rb = Epi::PERM ? ((R & ~31) + perm32(R & 31)) : R;
        voffA[i] = (unsigned)(R * g.lda + C) * 2u; voffB[i] = (unsigned)(Rb * K + C) * 2u; }
    const size_t kstep = (size_t)(BK * 2);
    const size_t hstep = (size_t)HALF * K * 2;
    const size_t tstep = 2 * hstep; const size_t hstepA = (size_t)HALF * g.lda * 2; const size_t tstepA = 2 * hstepA;
    const unsigned ldsw = (unsigned)wid * 1024u;
    const int aoff = lds_byte(wr * 64 + fr, fq * 8), boff = lds_byte(wc * 32 + fr, fq * 8);
#define PG8_SA(b, h) (((b) * 2 + (h)) * HTB)
#define PG8_SB(b, h) ((4 + (b) * 2 + (h)) * HTB)
#define PG8_STAGE(bufoff, gbase, voff) do { _Pragma("unroll") for (int _i = 0; _i < 2; ++_i) \
        __builtin_amdgcn_global_load_lds((const unsigned*)((const char*)(gbase) + (voff)[_i]), (PG8_LAS unsigned*)(lds + (bufoff) + ldsw + _i * 8192), 16, 0, 0); } while (0)
#define PG8_LDA(dst, b, h) do { _Pragma("unroll") for (int m = 0; m < 4; ++m) _Pragma("unroll") for (int k = 0; k < 2; ++k) dst[m][k] = *(const PG8_LAS bf16x8*)(lds + PG8_SA(b, h) + aoff + m * 2048 + k * 1024); } while (0)
#define PG8_LDB(dst, b, h) do { _Pragma("unroll") for (int n = 0; n < 2; ++n) _Pragma("unroll") for (int k = 0; k < 2; ++k) dst[n][k] = *(const PG8_LAS bf16x8*)(lds + PG8_SB(b, h) + boff + n * 2048 + k * 1024); } while (0)
#define PG8_MMA(ai, bj, At, Bt) do { __builtin_amdgcn_s_setprio(1); _Pragma("unroll") for (int m = 0; m < 4; ++m) _Pragma("unroll") for (int n = 0; n < 2; ++n) _Pragma("unroll") for (int k = 0; k < 2; ++k) \
        acc[ai][bj][m][n] = __builtin_amdgcn_mfma_f32_16x16x32_bf16(Bt[n][k], At[m][k], acc[ai][bj][m][n], 0, 0, 0); __builtin_amdgcn_s_setprio(0); } while (0)
#define PG8_WAIT_V(n) asm volatile("s_waitcnt vmcnt(" #n ")" ::: "memory")
#define PG8_WAIT_L(n) asm volatile("s_waitcnt lgkmcnt(" #n ")" ::: "memory")
#define PG8_BAR __builtin_amdgcn_s_barrier()
#define PG8_SCHED __builtin_amdgcn_sched_barrier(0)
    Unit cur, nxt; int ui = 0;
    if (!S.next(0, cur)) return;
    f32x4 acc[2][2][4][2];
#pragma unroll
    for (int a = 0; a < 2; ++a)
#pragma unroll
        for (int b = 0; b < 2; ++b)
#pragma unroll
            for (int m = 0; m < 4; ++m)
#pragma unroll
                for (int n = 0; n < 2; ++n) acc[a][b][m][n] = (f32x4){0.f, 0.f, 0.f, 0.f};
    bf16x8 At[4][2], B0[2][2], B1[2][2];
    const char* cA = (const char*)g.A + (size_t)cur.pm * tstepA + (size_t)cur.pn * g.acs; const char* cB = (const char*)g.Bt + (size_t)cur.pn * tstep;
    S.a_ready(cur);
    PG8_STAGE(PG8_SB(0, 0), cB, voffB); PG8_STAGE(PG8_SB(0, 1), cB + hstep, voffB); PG8_STAGE(PG8_SA(0, 0), cA, voffA); PG8_STAGE(PG8_SA(0, 1), cA + hstepA, voffA);
    if (wr == 1) PG8_BAR;
    PG8_WAIT_V(2); PG8_BAR;
    PG8_STAGE(PG8_SB(1, 0), cB + kstep, voffB); PG8_STAGE(PG8_SA(1, 0), cA + kstep, voffA); PG8_STAGE(PG8_SB(1, 1), cB + hstep + kstep, voffB);
    PG8_WAIT_V(6); PG8_BAR;
    PG8_STAMP();
    for (;;) {
        const bool has_next = S.next(ui + 1, nxt);
        const char* nA = has_next ? (const char*)g.A + (size_t)nxt.pm * tstepA + (size_t)nxt.pn * g.acs : cA; const char* nB = has_next ? (const char*)g.Bt + (size_t)nxt.pn * tstep : cB;
        for (int t = 0; t < nt; t += 2) {
            const bool last = (t == nt - 2);
            const char* a1 = cA + (size_t)(t + 1) * kstep;
            const char* a2 = last ? nA : cA + (size_t)(t + 2) * kstep; const char* b2 = last ? nB : cB + (size_t)(t + 2) * kstep;
            const char* a3 = a2 + kstep; const char* b3 = b2 + kstep;
            if (last && has_next) S.a_ready(nxt);
            PG8_LDB(B0, 0, 0); PG8_LDB(B1, 0, 1); PG8_SCHED; PG8_LDA(At, 0, 0); PG8_STAGE(PG8_SA(1, 1), a1 + hstepA, voffA);
            PG8_WAIT_V(8); PG8_WAIT_L(0); PG8_BAR; PG8_MMA(0, 0, At, B0); PG8_MMA(0, 1, At, B1); PG8_BAR; PG8_SCHED;
            PG8_LDA(At, 0, 1); PG8_STAGE(PG8_SB(0, 0), b2, voffB); PG8_STAGE(PG8_SB(0, 1), b2 + hstep, voffB); PG8_STAGE(PG8_SA(0, 0), a2, voffA);
            PG8_WAIT_V(8); PG8_WAIT_L(0); PG8_BAR; PG8_MMA(1, 0, At, B0); PG8_MMA(1, 1, At, B1); PG8_BAR; PG8_SCHED;
            PG8_LDB(B0, 1, 0); PG8_LDB(B1, 1, 1); PG8_SCHED; PG8_LDA(At, 1, 0); PG8_STAGE(PG8_SA(0, 1), a2 + hstepA, voffA);
            PG8_WAIT_V(8); PG8_WAIT_L(0); PG8_BAR; PG8_MMA(0, 0, At, B0); PG8_MMA(0, 1, At, B1); PG8_BAR; PG8_SCHED;
            PG8_LDA(At, 1, 1); PG8_STAGE(PG8_SB(1, 0), b3, voffB); PG8_STAGE(PG8_SB(1, 1), b3 + hstep, voffB); PG8_STAGE(PG8_SA(1, 0), a3, voffA);
            PG8_WAIT_V(8); PG8_WAIT_L(0); PG8_BAR; PG8_MMA(1, 0, At, B0); PG8_MMA(1, 1, At, B1); PG8_BAR; PG8_SCHED;
        }
        PG8_STAMP();
        if (wr == 0) PG8_BAR;
        if constexpr (!Epi::AFTER_DRAIN) { E(acc, cur, wr, wc, fr, fq); S.done(cur); }
        PG8_STAMP();
        if (!has_next) break;
#pragma unroll
        for (int a = 0; a < 2; ++a)
#pragma unroll
            for (int b = 0; b < 2; ++b)
#pragma unroll
                for (int m = 0; m < 4; ++m)
#pragma unroll
                    for (int n = 0; n < 2; ++n) acc[a][b][m][n] = (f32x4){0.f, 0.f, 0.f, 0.f};
        cur = nxt; cA = nA; cB = nB; ++ui;
        if (wr == 1) PG8_BAR;
    }
    PG8_WAIT_V(0);
    PG8_BAR;
    if constexpr (Epi::AFTER_DRAIN) { E.fused(acc, cur, wr, wc, fr, fq, lds, wid, lane); S.done(cur); }
    PG8_STAMP();
    if (STAMP && wid == 0) { stamps[lane] = lane < nts ? (((unsigned long long)(unsigned)ts_hi << 32) | (unsigned)ts_lo) : 0ull;
        if (lane == 62) stamps[62] = rt_entry; if (lane == 63) stamps[63] = (unsigned long long)wall_clock64(); }
#undef PG8_STAMP
#undef PG8_SA
#undef PG8_SB
#undef PG8_STAGE
#undef PG8_LDA
#undef PG8_LDB
#undef PG8_MMA
#undef PG8_WAIT_V
#undef PG8_WAIT_L
#undef PG8_BAR
#undef PG8_SCHED
}
}

#define LAS __attribute__((address_space(3)))
typedef unsigned short bf16_t;
typedef short bf16x8 __attribute__((ext_vector_type(8)));
typedef short s16x4 __attribute__((ext_vector_type(4)));
typedef float f32x4 __attribute__((ext_vector_type(4)));
typedef float f32x16 __attribute__((ext_vector_type(16)));
typedef unsigned u32x4 __attribute__((ext_vector_type(4)));
typedef unsigned u32x2 __attribute__((ext_vector_type(2)));
typedef __bf16 bf16x2_t __attribute__((ext_vector_type(2)));
typedef float f32x2_t __attribute__((ext_vector_type(2)));

__device__ __forceinline__ int otid() { int t = threadIdx.x; asm volatile("" : "+v"(t)); return t; }
__device__ __forceinline__ int obid() { int t = blockIdx.x; asm volatile("" : "+s"(t)); return t; }
__device__ __forceinline__ int ogdim() { int t = gridDim.x; asm volatile("" : "+s"(t)); return t; }
constexpr int NB = 8, SEQ = 4096, DM = 1024, MTOK = NB * SEQ;
constexpr int FH = 2816;
constexpr int NSA_IN = 2608, NSA_NP = 2816;
constexpr size_t KVSZ = (size_t)32 * 4096 * 64;
constexpr int LDS_BYTES = 131072 + 16;

__device__ __forceinline__ unsigned pk_bf16(float a, float b) { f32x2_t v = {a, b}; bf16x2_t r = __builtin_convertvector(v, bf16x2_t); return __builtin_bit_cast(unsigned, r); }
__device__ __forceinline__ bf16_t f2bf(float a) { return (bf16_t)(pk_bf16(a, 0.f) & 0xffffu); }
__device__ __forceinline__ float bf2f(unsigned short x) { return __uint_as_float(((unsigned)x) << 16); }
__device__ __forceinline__ float gelu_tanh(float x) { const float y = 0.7978845608f * (x + 0.044715f * x * x * x); return x * __builtin_amdgcn_rcpf(1.0f + __builtin_amdgcn_exp2f(-2.885390082f * y)); }
__device__ __forceinline__ float silu_f(float x) { return x * __builtin_amdgcn_rcpf(1.0f + __builtin_amdgcn_exp2f(-1.442695041f * x)); }
__device__ __forceinline__ float sigmoid_f(float x) { return __builtin_amdgcn_rcpf(1.0f + __builtin_amdgcn_exp2f(-1.442695041f * x)); }

constexpr size_t al256(size_t x) { return (x + 255) & ~(size_t)255; }
constexpr size_t WS_WGU = 0;
constexpr size_t WS_WDN = WS_WGU + (size_t)4 * 5632 * 1024 * 2;
constexpr size_t WS_NWIN = WS_WDN + (size_t)4 * 1024 * 2816 * 2;
constexpr size_t WS_NWOUT = WS_NWIN + (size_t)2 * NSA_NP * 1024 * 2;
constexpr size_t WS_CW1 = WS_NWOUT + (size_t)2 * 1024 * 1024 * 2;
constexpr size_t WS_SWIN = WS_CW1 + (size_t)2 * 512 * 2048 * 2;
constexpr size_t WS_SWOUT = WS_SWIN + (size_t)2048 * 1024 * 2;
constexpr size_t WS_SWS = WS_SWOUT + (size_t)1024 * 1024 * 2;
constexpr size_t WS_PWIN = WS_SWS + (size_t)8 * 128 * 128 * 2;
constexpr size_t WS_PGRP = WS_PWIN + (size_t)1024 * 1024 * 2;
constexpr size_t WS_PWOUT = WS_PGRP + (size_t)1024 * 1024 * 2;
constexpr size_t WS_CBIAS = WS_PWOUT + (size_t)1024 * 1024 * 2;
constexpr size_t WS_CS = WS_CBIAS + 4096;
constexpr size_t WS_GATES = WS_CS + (size_t)MTOK * 16 * 4;
constexpr size_t WS_CH = WS_GATES + (size_t)MTOK * 48 * 4;
constexpr size_t WS_KCMP = WS_CH + (size_t)16384 * 256 * 2;
constexpr size_t WS_VCMPT = WS_KCMP + (size_t)32 * 256 * 64 * 2;
constexpr size_t WS_H = WS_VCMPT + (size_t)32 * 64 * 256 * 2;
constexpr size_t WS_BIG = WS_H + (size_t)MTOK * 1024 * 2;
constexpr size_t WS_TBL = WS_BIG + (size_t)MTOK * 2816 * 2 + 65536;
constexpr size_t WS_CBPART = WS_TBL + 4096;
constexpr size_t WS_W2T = WS_CBPART + (size_t)256 * 256 * 4;
constexpr size_t WS_H2 = WS_W2T + (size_t)4 * 64 * 256 * 2;
constexpr size_t WS_RSS = WS_H2 + (size_t)MTOK * 1024 * 2;
constexpr size_t WS_BAR = WS_RSS + (size_t)8 * MTOK * 16 * 4;
constexpr size_t WS_END = WS_BAR + 16384;

struct Params {
    const float* x; const int* positions; const float* mix_norm; const float* ffn_norm; const float* final_norm;
    const float* nsa_w_in; const float* nsa_cmp_pos_k; const float* nsa_cmp_k_w1; const float* nsa_cmp_k_w2;
    const float* nsa_cmp_pos_v; const float* nsa_cmp_v_w1; const float* nsa_cmp_v_w2; const float* nsa_w_out;
    const float* sgu_w_in; const float* sgu_ln_g; const float* sgu_ln_b; const float* sgu_w_s; const float* sgu_b_s; const float* sgu_w_out;
    const float* pool_w_in; const float* pool_w_grp; const float* pool_scale; const float* pool_w_out;
    const float* ffn_w_gate_up; const float* ffn_w_down;
    float* out; unsigned char* ws;
};


__device__ __forceinline__ float row_rstd(const float* rss, int row) {
    const f32x4* q = (const f32x4*)(rss + (size_t)row * 16);
    const f32x4 s = (q[0] + q[1]) + (q[2] + q[3]);
    return rsqrtf(((s[0] + s[1]) + (s[2] + s[3])) * (1.0f / 1024.0f) + 1e-6f);
}
__device__ __forceinline__ void load_rstd(const float* rss, int row0, float (&rs)[2][4]) {
#pragma unroll
    for (int ai = 0; ai < 2; ++ai)
#pragma unroll
        for (int m = 0; m < 4; ++m) rs[ai][m] = rss ? row_rstd(rss, row0 + ai * 128 + m * 16) : 1.0f;
}
struct EpiResid {
    static constexpr bool PERM = true, AFTER_DRAIN = false;
    bf16_t* XB; float* rss;
    __device__ __forceinline__ void operator()(const f32x4 (&acc)[2][2][4][2], const pg8::Unit& u, int wr, int wc, int fr, int fq) const {
        const int row0 = u.pm * 256 + wr * 64 + fr, col0 = u.pn * 256 + wc * 32 + 8 * fq;
#pragma unroll
        for (int ai = 0; ai < 2; ++ai)
#pragma unroll
            for (int m = 0; m < 4; ++m) {
                const int row = row0 + ai * 128 + m * 16;
                bf16_t* rp = XB + (size_t)row * 1024 + col0;
                float ss = 0.f;
#pragma unroll
                for (int bj = 0; bj < 2; ++bj) {
                    const u32x4 bw = *(const u32x4*)(rp + bj * 128);
                    const f32x4 a0 = acc[ai][bj][m][0], a1 = acc[ai][bj][m][1];
                    float x[8];
                    x[0] = __uint_as_float(bw.x << 16) + a0[0]; x[1] = __uint_as_float(bw.x & 0xffff0000u) + a0[1];
                    x[2] = __uint_as_float(bw.y << 16) + a0[2]; x[3] = __uint_as_float(bw.y & 0xffff0000u) + a0[3];
                    x[4] = __uint_as_float(bw.z << 16) + a1[0]; x[5] = __uint_as_float(bw.z & 0xffff0000u) + a1[1];
                    x[6] = __uint_as_float(bw.w << 16) + a1[2]; x[7] = __uint_as_float(bw.w & 0xffff0000u) + a1[3];
#pragma unroll
                    for (int e = 0; e < 8; ++e) ss += x[e] * x[e];
                    u32x4 w; w.x = pk_bf16(x[0], x[1]); w.y = pk_bf16(x[2], x[3]); w.z = pk_bf16(x[4], x[5]); w.w = pk_bf16(x[6], x[7]);
                    *(u32x4*)(rp + bj * 128) = w;
                }
                if (rss) {
                    ss += __shfl_xor(ss, 16); ss += __shfl_xor(ss, 32);
                    if (fq == 0) rss[(size_t)row * 16 + u.pn * 4 + wc] = ss;
                }
            }
    }
};
struct EpiF32 {
    static constexpr bool PERM = false, AFTER_DRAIN = false;
    float* C; const float* rss;
    __device__ __forceinline__ void operator()(const f32x4 (&acc)[2][2][4][2], const pg8::Unit& u, int wr, int wc, int fr, int fq) const {
        const int row0 = u.pm * 256 + wr * 64 + fr, col0 = u.pn * 256 + wc * 32 + 4 * fq;
        float rs[2][4]; load_rstd(rss, row0, rs);
#pragma unroll
        for (int ai = 0; ai < 2; ++ai)
#pragma unroll
            for (int m = 0; m < 4; ++m) {
                const size_t off = (size_t)(row0 + ai * 128 + m * 16) * 1024 + col0;
#pragma unroll
                for (int bj = 0; bj < 2; ++bj)
#pragma unroll
                    for (int n = 0; n < 2; ++n) *(f32x4*)(C + off + bj * 128 + n * 16) = acc[ai][bj][m][n] * rs[ai][m];
            }
    }
};
struct EpiGU {
    static constexpr bool PERM = true, AFTER_DRAIN = false;
    bf16_t* HID; const float* rss;
    __device__ __forceinline__ void operator()(const f32x4 (&acc)[2][2][4][2], const pg8::Unit& u, int wr, int wc, int fr, int fq) const {
        const int row0 = u.pm * 256 + wr * 64 + fr, col0 = u.pn * 128 + wc * 32 + 8 * fq;
        float rs[2][4]; load_rstd(rss, row0, rs);
#pragma unroll
        for (int ai = 0; ai < 2; ++ai)
#pragma unroll
            for (int m = 0; m < 4; ++m) {
                const float rr = rs[ai][m];
                const f32x4 g0 = acc[ai][0][m][0] * rr, g1 = acc[ai][0][m][1] * rr, u0 = acc[ai][1][m][0] * rr, u1 = acc[ai][1][m][1] * rr;
                u32x4 w;
                w.x = pk_bf16(silu_f(g0[0]) * u0[0], silu_f(g0[1]) * u0[1]); w.y = pk_bf16(silu_f(g0[2]) * u0[2], silu_f(g0[3]) * u0[3]);
                w.z = pk_bf16(silu_f(g1[0]) * u1[0], silu_f(g1[1]) * u1[1]); w.w = pk_bf16(silu_f(g1[2]) * u1[2], silu_f(g1[3]) * u1[3]);
                *(u32x4*)(HID + (size_t)(row0 + ai * 128 + m * 16) * FH + col0) = w;
            }
    }
};
template <int MODE> struct EpiBf16 {
    static constexpr bool PERM = true, AFTER_DRAIN = false;
    bf16_t* O; int ldc; const float* aux; const float* rss;
    __device__ __forceinline__ void operator()(const f32x4 (&acc)[2][2][4][2], const pg8::Unit& u, int wr, int wc, int fr, int fq) const {
        const int row0 = u.pm * 256 + wr * 64 + fr; const int ct = wc * 32 + 8 * fq;
        const int colbase = (MODE == 2) ? 0 : u.pn * 256;
        float rs[2][4]; if (MODE == 0) load_rstd(rss, row0, rs);
        f32x4 av[2][2];
#pragma unroll
        for (int bj = 0; bj < 2; ++bj)
#pragma unroll
            for (int n = 0; n < 2; ++n) av[bj][n] = (MODE == 0) ? (f32x4){0.f, 0.f, 0.f, 0.f} : *(const f32x4*)(aux + u.pn * 256 + ct + bj * 128 + 4 * n);
#pragma unroll
        for (int ai = 0; ai < 2; ++ai)
#pragma unroll
            for (int m = 0; m < 4; ++m) {
                bf16_t* rowp = O + (size_t)(row0 + ai * 128 + m * 16) * ldc + colbase + ct;
#pragma unroll
                for (int bj = 0; bj < 2; ++bj) {
                    f32x4 v0 = acc[ai][bj][m][0], v1 = acc[ai][bj][m][1];
                    if (MODE == 0) { v0 = v0 * rs[ai][m]; v1 = v1 * rs[ai][m]; }
                    if (MODE == 1) { v0 = v0 * av[bj][0]; v1 = v1 * av[bj][1]; }
                    if (MODE == 2) { v0 = v0 + av[bj][0]; v1 = v1 + av[bj][1]; }
                    if (MODE != 1) {
#pragma unroll
                        for (int j = 0; j < 4; ++j) { v0[j] = gelu_tanh(v0[j]); v1[j] = gelu_tanh(v1[j]); }
                    }
                    u32x4 w; w.x = pk_bf16(v0[0], v0[1]); w.y = pk_bf16(v0[2], v0[3]); w.z = pk_bf16(v1[0], v1[1]); w.w = pk_bf16(v1[2], v1[3]);
                    *(u32x4*)(rowp + bj * 128) = w;
                }
            }
    }
};
struct EpiNsaIn {
    static constexpr bool PERM = true, AFTER_DRAIN = false;
    bf16_t* Q; bf16_t* KV; float* gates; const float* cs; const float* rss;
    template <int VAR> __device__ __forceinline__ void variant(const f32x4 (&acc)[2][2][4][2], const pg8::Unit& u, int wr, int wc, int fr, int fq) const {
        const int pn = u.pn; const int jkv = pn - 4;
        const int row0 = u.pm * 256 + wr * 64 + fr;
        const bool rope_w = (VAR <= 1) && ((wc & 1) == 0);
#pragma unroll
        for (int ai = 0; ai < 2; ++ai)
#pragma unroll
            for (int m = 0; m < 4; ++m) {
                const int row = row0 + ai * 128 + m * 16; const int b = row >> 12, s = row & 4095;
                const float rr = rss ? row_rstd(rss, row) : 1.0f;
#pragma unroll
                for (int bj = 0; bj < 2; ++bj) {
                    const int cb = bj * 128 + wc * 32 + fq * 8;
                    f32x4 v0 = acc[ai][bj][m][0] * rr, v1 = acc[ai][bj][m][1] * rr;
                    if (rope_w) {
                        f32x4 p0, p1;
#pragma unroll
                        for (int j = 0; j < 4; ++j) { p0[j] = __shfl_xor(v0[j], 16); p1[j] = __shfl_xor(v1[j], 16); }
                        if (fq < 2) {
                            const f32x4* c4 = (const f32x4*)(cs + (size_t)row * 16);
                            const f32x4 cA = c4[0], cB = c4[1], sA = c4[2], sB = c4[3];
                            if (fq == 0) { v0 = v0 * cA - p0 * sA; v1 = v1 * cB - p1 * sB; }
                            else { v0 = v0 * cA + p0 * sA; v1 = v1 * cB + p1 * sB; }
                        }
                    }
                    const int hh = cb >> 6, d0 = cb & 63;
                    if (VAR == 0) {
                        v0 = v0 * 0.18033688f; v1 = v1 * 0.18033688f;
                        u32x4 w; w.x = pk_bf16(v0[0], v0[1]); w.y = pk_bf16(v0[2], v0[3]); w.z = pk_bf16(v1[0], v1[1]); w.w = pk_bf16(v1[2], v1[3]);
                        *(u32x4*)(Q + ((size_t)(b * 16 + pn * 4 + hh) * 4096 + s) * 64 + d0) = w;
                    } else if (VAR == 1 || VAR == 2) {
                        u32x4 w; w.x = pk_bf16(v0[0], v0[1]); w.y = pk_bf16(v0[2], v0[3]); w.z = pk_bf16(v1[0], v1[1]); w.w = pk_bf16(v1[2], v1[3]);
                        *(u32x4*)(KV + (size_t)jkv * KVSZ + ((size_t)(b * 4 + hh) * 4096 + s) * 64 + d0) = w;
                    } else if (VAR == 3) {
                        bf16_t* tp = KV + (size_t)jkv * KVSZ + ((size_t)(b * 4 + hh) * 64 + d0) * 4096 + s;
#pragma unroll
                        for (int j = 0; j < 4; ++j) { tp[(size_t)j * 4096] = f2bf(v0[j]); tp[(size_t)(j + 4) * 4096] = f2bf(v1[j]); }
                    } else if (cb < 48) {
                        f32x4 g0, g1;
#pragma unroll
                        for (int j = 0; j < 4; ++j) { g0[j] = sigmoid_f(v0[j]); g1[j] = sigmoid_f(v1[j]); }
                        float* gp = gates + (size_t)row * 48 + cb;
                        *(f32x4*)gp = g0; *(f32x4*)(gp + 4) = g1;
                    }
                }
            }
    }
    __device__ __forceinline__ void operator()(const f32x4 (&acc)[2][2][4][2], const pg8::Unit& u, int wr_, int wc_, int fr_, int fq_) const {
        const int pn = u.pn;
        const int t_ = otid(); const int wid_ = __builtin_amdgcn_readfirstlane(t_ >> 6); const int wr = wid_ >> 2, wc = wid_ & 3, fr = t_ & 15, fq = (t_ & 63) >> 4;
        (void)wr_; (void)wc_; (void)fr_; (void)fq_;
        if (pn < 4) variant<0>(acc, u, wr, wc, fr, fq);
        else if (pn == 4 || pn == 6 || pn == 8) variant<1>(acc, u, wr, wc, fr, fq);
        else if (pn == 5) variant<2>(acc, u, wr, wc, fr, fq);
        else if (pn == 7 || pn == 9) variant<3>(acc, u, wr, wc, fr, fq);
        else variant<4>(acc, u, wr, wc, fr, fq);
    }
};
struct EpiGates {
    static constexpr bool PERM = false, AFTER_DRAIN = false;
    float* gates; const float* rss;
    __device__ __forceinline__ void operator()(const f32x4 (&acc)[2][2][4][2], const pg8::Unit& u, int wr, int wc, int fr, int fq) const {
        if (wc > 1) return;
        const int row0 = u.pm * 256 + wr * 64 + fr;
#pragma unroll
        for (int ai = 0; ai < 2; ++ai)
#pragma unroll
            for (int m = 0; m < 4; ++m) {
                const int row = row0 + ai * 128 + m * 16;
                const float rr = rss ? row_rstd(rss, row) : 1.0f;
#pragma unroll
                for (int n = 0; n < 2; ++n) {
                    const int cb = wc * 32 + 16 * n + 4 * fq;
                    if (cb < 48) {
                        const f32x4 v = acc[ai][0][m][n] * rr; f32x4 gsig;
#pragma unroll
                        for (int e = 0; e < 4; ++e) gsig[e] = sigmoid_f(v[e]);
                        *(f32x4*)(gates + (size_t)row * 48 + cb) = gsig;
                    }
                }
            }
    }
};
struct GateOrder {
    int G, c;
    __device__ bool next(int i, pg8::Unit& u) const { const int L = i * G + c; if (L >= 128 || G <= 0) return false; u.pm = L; u.pn = 10; return true; }
    __device__ __forceinline__ void a_ready(const pg8::Unit&) const {}
    __device__ __forceinline__ void done(const pg8::Unit&) const {}
};
struct CmpOrder {
    int G, c;
    __device__ bool next(int i, pg8::Unit& u) const { const int L = i * G + c; if (L >= 64) return false; u.pm = L; u.pn = L >> 5; return true; }
    __device__ __forceinline__ void a_ready(const pg8::Unit&) const {}
    __device__ __forceinline__ void done(const pg8::Unit&) const {}
};

template <class Epi> __device__ __forceinline__ void run_gemm(LAS unsigned char* lds, const bf16_t* A, int lda, const bf16_t* Bt, int M, int N, int K, const Epi& E, int acs = 0) {
    pg8::Gemm g; g.A = A; g.Bt = Bt; g.M = M; g.N = N; g.K = K; g.lda = lda; g.acs = acs;
    pg8::StaticOrder S; S.init(M, N, ogdim(), obid());
    pg8::gemm_phase<Epi, pg8::StaticOrder, false>(lds, g, S, E, nullptr);
}

struct TJob { const float* src; bf16_t* dst; const float* gk; int K, Nsrc, Ndst, mode, tiles; };
__device__ __forceinline__ int job_colmap(int mode, int n) {
    if (mode == 0) return n;
    if (mode == 1) { const int t = n >> 8, r = n & 255; return (r < 128) ? (t * 128 + r) : (FH + t * 128 + (r - 128)); }
    return (n < NSA_IN) ? n : -1;
}
__device__ void transpose_tile(LAS float* tile, const TJob& J, int t) {
    const int tid = otid(), tx = tid & 63, ty = tid >> 6;
    const int nkt = J.K >> 6; const int tn = t / nkt, tk = t - tn * nkt; const int n0 = tn * 64, k0 = tk * 64;
    const int sc = job_colmap(J.mode, n0 + tx);
#pragma unroll
    for (int i = 0; i < 8; ++i) { const int k = k0 + ty + 8 * i; const float gs = J.gk ? J.gk[k] : 1.0f; tile[(ty + 8 * i) * 65 + tx] = (sc >= 0) ? J.src[(size_t)k * J.Nsrc + sc] * gs : 0.f; }
    __syncthreads();
    {
        const int nn = tid >> 3, kg = tid & 7;
        float v[8];
#pragma unroll
        for (int e = 0; e < 8; ++e) v[e] = tile[(kg * 8 + e) * 65 + nn];
        u32x4 w; w.x = pk_bf16(v[0], v[1]); w.y = pk_bf16(v[2], v[3]); w.z = pk_bf16(v[4], v[5]); w.w = pk_bf16(v[6], v[7]);
        *(u32x4*)(J.dst + (size_t)(n0 + nn) * J.K + k0 + kg * 8) = w;
    }
    __syncthreads();
}
__device__ __forceinline__ void get_job(const Params& P, unsigned char* ws, int j, TJob& J) {
        J.gk = nullptr;
        if (j < 4) { J.gk = P.ffn_norm + j * 1024; J.src = P.ffn_w_gate_up + (size_t)j * 1024 * 5632; J.dst = (bf16_t*)(ws + WS_WGU) + (size_t)j * 5632 * 1024; J.K = 1024; J.Nsrc = 5632; J.Ndst = 5632; J.mode = 1; }
        else if (j < 8) { const int l = j - 4; J.src = P.ffn_w_down + (size_t)l * 2816 * 1024; J.dst = (bf16_t*)(ws + WS_WDN) + (size_t)l * 1024 * 2816; J.K = 2816; J.Nsrc = 1024; J.Ndst = 1024; J.mode = 0; }
        else if (j < 10) { const int l = j - 8; J.gk = P.mix_norm + (3 * l) * 1024; J.src = P.nsa_w_in + (size_t)l * 1024 * NSA_IN; J.dst = (bf16_t*)(ws + WS_NWIN) + (size_t)l * NSA_NP * 1024; J.K = 1024; J.Nsrc = NSA_IN; J.Ndst = NSA_NP; J.mode = 2; }
        else if (j < 12) { const int l = j - 10; J.src = P.nsa_w_out + (size_t)l * 1024 * 1024; J.dst = (bf16_t*)(ws + WS_NWOUT) + (size_t)l * 1024 * 1024; J.K = 1024; J.Nsrc = 1024; J.Ndst = 1024; J.mode = 0; }
        else if (j < 14) { const int l = j - 12; J.src = P.nsa_cmp_k_w1 + (size_t)l * 2048 * 256; J.dst = (bf16_t*)(ws + WS_CW1) + (size_t)l * 512 * 2048; J.K = 2048; J.Nsrc = 256; J.Ndst = 256; J.mode = 0; }
        else if (j < 16) { const int l = j - 14; J.src = P.nsa_cmp_v_w1 + (size_t)l * 2048 * 256; J.dst = (bf16_t*)(ws + WS_CW1) + (size_t)l * 512 * 2048 + (size_t)256 * 2048; J.K = 2048; J.Nsrc = 256; J.Ndst = 256; J.mode = 0; }
        else if (j == 16) { J.gk = P.mix_norm + 1024; J.src = P.sgu_w_in; J.dst = (bf16_t*)(ws + WS_SWIN); J.K = 1024; J.Nsrc = 2048; J.Ndst = 2048; J.mode = 0; }
        else if (j == 17) { J.src = P.sgu_w_out; J.dst = (bf16_t*)(ws + WS_SWOUT); J.K = 1024; J.Nsrc = 1024; J.Ndst = 1024; J.mode = 0; }
        else if (j == 18) { J.gk = P.mix_norm + 2048; J.src = P.pool_w_in; J.dst = (bf16_t*)(ws + WS_PWIN); J.K = 1024; J.Nsrc = 1024; J.Ndst = 1024; J.mode = 0; }
        else { J.src = P.pool_w_out; J.dst = (bf16_t*)(ws + WS_PWOUT); J.K = 1024; J.Nsrc = 1024; J.Ndst = 1024; J.mode = 0; }
        J.tiles = (J.Ndst >> 6) * (J.K >> 6);
    }
__device__ void prologue_phase(const Params& P, LAS unsigned char* lds) {
    unsigned char* ws = P.ws;
    const int tid = otid();
    constexpr int NJ = 22;
    int total = 0;
    (void)NJ; (void)total;
    {
        int base = 0;
        for (int j = 0; j < 19; ++j) {
            TJob J; get_job(P, ws, j, J);
            int first = (obid() - base % ogdim() + ogdim()) % ogdim();
            for (int t = first; t < J.tiles; t += ogdim()) transpose_tile((LAS float*)lds, J, t);
            base += J.tiles;
        }
    }
    const size_t gtid = (size_t)obid() * 512 + tid, gsz = (size_t)ogdim() * 512;
    {
        bf16_t* dst = (bf16_t*)(ws + WS_PWOUT);
        for (size_t i = gtid; i < (size_t)256 * 256; i += gsz) {
            const int e0 = (int)(i & 255) * 4, c0 = (int)(i >> 8) * 4; const int g = c0 >> 8;
            const f32x4* wg = (const f32x4*)(P.pool_w_grp + ((size_t)g * 256 + (c0 & 255)) * 256);
            const f32x4* sc = (const f32x4*)(P.pool_scale + g * 256);
            const float* wo = P.pool_w_out + (size_t)g * 256 * 1024 + e0;
            f32x4 acc[4];
#pragma unroll
            for (int j = 0; j < 4; ++j) acc[j] = (f32x4){0.f, 0.f, 0.f, 0.f};
#pragma unroll 2
            for (int m4 = 0; m4 < 64; ++m4) {
                const f32x4 s4 = sc[m4];
                f32x4 wv[4];
#pragma unroll
                for (int j = 0; j < 4; ++j) wv[j] = wg[j * 64 + m4] * s4;
#pragma unroll
                for (int mm = 0; mm < 4; ++mm) {
                    const f32x4 o4 = *(const f32x4*)(wo + (size_t)(m4 * 4 + mm) * 1024);
#pragma unroll
                    for (int j = 0; j < 4; ++j) acc[j] = acc[j] + o4 * wv[j][mm];
                }
            }
#pragma unroll
            for (int ii = 0; ii < 4; ++ii) {
                u32x2 w; w.x = pk_bf16(acc[0][ii], acc[1][ii]); w.y = pk_bf16(acc[2][ii], acc[3][ii]);
                *(u32x2*)(dst + (size_t)(e0 + ii) * 1024 + c0) = w;
            }
        }
    }
    {
        bf16_t* dst = (bf16_t*)(ws + WS_W2T);
        for (size_t i = gtid; i < (size_t)4 * 64 * 256; i += gsz) {
            const int c = (int)(i & 255), d = (int)((i >> 8) & 63), kv = (int)((i >> 14) & 1), l = (int)(i >> 15);
            const float* w2 = (kv ? P.nsa_cmp_v_w2 : P.nsa_cmp_k_w2) + (size_t)l * 256 * 64;
            dst[i] = f2bf(w2[c * 64 + d]);
        }
    }
    {
        bf16_t* dst = (bf16_t*)(ws + WS_SWS);
        for (size_t i = gtid; i < (size_t)8 * 128 * 128; i += gsz) { const int t = (int)((i >> 7) & 127), s = (int)(i & 127); dst[i] = f2bf(s <= t ? P.sgu_w_s[i] : 0.f); }
    }
    {
        float* cs = (float*)(ws + WS_CS);
        for (size_t i = gtid; i < (size_t)MTOK * 8; i += gsz) {
            const int row = (int)(i >> 3), f = (int)(i & 7);
            const float inv = (float)pow(500000.0, -(double)(2 * f) / 16.0);
            const float ang = (float)P.positions[row] * inv;
            float sv, cv; sincosf(ang, &sv, &cv);
            cs[(size_t)row * 16 + f] = cv; cs[(size_t)row * 16 + 8 + f] = sv;
        }
    }
    {
        const int lane = tid & 63; const int gw = obid() * 8 + (tid >> 6), nw = ogdim() * 8;
        bf16_t* __restrict__ XBp = (bf16_t*)(ws + WS_H2); float* __restrict__ rss7 = (float*)(ws + WS_RSS) + (size_t)7 * MTOK * 16;
        const float* __restrict__ xin_ = P.x;
#pragma unroll 4
        for (int row = gw; row < MTOK; row += nw) {
            const f32x4* xr = (const f32x4*)(xin_ + (size_t)row * 1024); float ss = 0.f;
#pragma unroll
            for (int i = 0; i < 4; ++i) { const f32x4 v = xr[lane + 64 * i]; ss += v[0] * v[0] + v[1] * v[1] + v[2] * v[2] + v[3] * v[3];
                u32x2 w; w.x = pk_bf16(v[0], v[1]); w.y = pk_bf16(v[2], v[3]); ((u32x2*)(XBp + (size_t)row * 1024))[lane + 64 * i] = w; }
#pragma unroll
            for (int o = 32; o >= 1; o >>= 1) ss += __shfl_xor(ss, o);
            if (lane < 16) rss7[(size_t)row * 16 + lane] = (lane == 0) ? ss : 0.f;
        }
    }
    for (int item = obid(); item < 256; item += ogdim()) {
        const int job = item >> 6, chunk = item & 63; const int l = job >> 1, kv = job & 1;
        const float* pos = (kv ? P.nsa_cmp_pos_v : P.nsa_cmp_pos_k) + (size_t)l * 2048;
        const float* w1 = (kv ? P.nsa_cmp_v_w1 : P.nsa_cmp_k_w1) + (size_t)l * 2048 * 256;
        const int c = tid & 255, hf = tid >> 8;
        float a = 0.f;
        const int r0 = chunk * 32 + hf * 16;
#pragma unroll
        for (int r = 0; r < 16; ++r) a += pos[r0 + r] * w1[(size_t)(r0 + r) * 256 + c];
        LAS float* red = (LAS float*)lds;
        __syncthreads();
        if (hf == 1) red[c] = a;
        __syncthreads();
        if (hf == 0) ((float*)(ws + WS_CBPART))[(size_t)item * 256 + c] = a + red[c];
        __syncthreads();
    }
}
__device__ void cbias_reduce(unsigned char* ws, int l) {
    const int tid = otid(); const int kv = tid >> 8, c = tid & 255;
    const float* part = (const float*)(ws + WS_CBPART) + (size_t)(l * 2 + kv) * 64 * 256 + c;
    float a = 0.f;
#pragma unroll 16
    for (int ch = 0; ch < 64; ++ch) a += part[(size_t)ch * 256];
    ((float*)(ws + WS_CBIAS))[l * 512 + tid] = a;
}

__device__ void rmsnorm_phase(const float* X, const float* g, bf16_t* H, float* outf) {
    const int lane = otid() & 63; const int gw = obid() * 8 + (otid() >> 6), nw = ogdim() * 8;
    f32x4 gv[4];
#pragma unroll
    for (int i = 0; i < 4; ++i) gv[i] = ((const f32x4*)g)[lane + 64 * i];
    for (int row = gw; row < MTOK; row += nw) {
        const f32x4* xr = (const f32x4*)(X + (size_t)row * 1024);
        f32x4 v[4]; float ss = 0.f;
#pragma unroll
        for (int i = 0; i < 4; ++i) { v[i] = xr[lane + 64 * i]; ss += v[i][0] * v[i][0] + v[i][1] * v[i][1] + v[i][2] * v[i][2] + v[i][3] * v[i][3]; }
#pragma unroll
        for (int o = 32; o >= 1; o >>= 1) ss += __shfl_xor(ss, o);
        const float rstd = rsqrtf(ss * (1.0f / 1024.0f) + 1e-6f);
        if (outf) {
#pragma unroll
            for (int i = 0; i < 4; ++i) ((f32x4*)(outf + (size_t)row * 1024))[lane + 64 * i] = v[i] * rstd * gv[i];
        } else {
#pragma unroll
            for (int i = 0; i < 4; ++i) { const f32x4 y = v[i] * rstd * gv[i]; u32x2 w; w.x = pk_bf16(y[0], y[1]); w.y = pk_bf16(y[2], y[3]); ((u32x2*)(H + (size_t)row * 1024))[lane + 64 * i] = w; }
        }
    }
}

__device__ void final_norm_phase(const bf16_t* __restrict__ XB, const float* __restrict__ g, float* __restrict__ out) {
    const int lane = otid() & 63; const int gw = obid() * 8 + (otid() >> 6), nw = ogdim() * 8;
#pragma unroll 4
    for (int row = gw; row < MTOK; row += nw) {
        const u32x4* xr = (const u32x4*)(XB + (size_t)row * 1024);
        float v[2][8]; float ss = 0.f;
#pragma unroll
        for (int i = 0; i < 2; ++i) { const u32x4 w = xr[lane + 64 * i];
            v[i][0] = __uint_as_float(w.x << 16); v[i][1] = __uint_as_float(w.x & 0xffff0000u); v[i][2] = __uint_as_float(w.y << 16); v[i][3] = __uint_as_float(w.y & 0xffff0000u);
            v[i][4] = __uint_as_float(w.z << 16); v[i][5] = __uint_as_float(w.z & 0xffff0000u); v[i][6] = __uint_as_float(w.w << 16); v[i][7] = __uint_as_float(w.w & 0xffff0000u);
#pragma unroll
            for (int e = 0; e < 8; ++e) ss += v[i][e] * v[i][e]; }
#pragma unroll
        for (int o = 32; o >= 1; o >>= 1) ss += __shfl_xor(ss, o);
        const float rstd = rsqrtf(ss * (1.0f / 1024.0f) + 1e-6f);
#pragma unroll
        for (int i = 0; i < 2; ++i) { const int c0 = (lane + 64 * i) * 8;
            const f32x4 g0 = *(const f32x4*)(g + c0), g1 = *(const f32x4*)(g + c0 + 4);
            f32x4 o0, o1;
#pragma unroll
            for (int e = 0; e < 4; ++e) { o0[e] = v[i][e] * rstd * g0[e]; o1[e] = v[i][4 + e] * rstd * g1[e]; }
            *(f32x4*)(out + (size_t)row * 1024 + c0) = o0; *(f32x4*)(out + (size_t)row * 1024 + c0 + 4) = o1; }
    }
}

#define MFMA32(a, b, c) __builtin_amdgcn_mfma_f32_32x32x16_bf16((a), (b), (c), 0, 0, 0)
__device__ __forceinline__ int crow16(int i, int h) { return (i & 3) + 8 * (i >> 2) + 4 * h; }
__device__ __forceinline__ f32x16 zero16() { f32x16 z; for (int i = 0; i < 16; ++i) z[i] = 0.f; return z; }
__device__ void cmp2_local(const bf16_t* CH, const bf16_t* w2T, bf16_t* KCMP, bf16_t* VCMPT, int L) {
    const int tid = otid(), w = tid >> 6, lane = tid & 63, r = lane & 31, h = lane >> 5;
    const int type = L >> 5;
    const bf16_t* wp = w2T + (size_t)type * 64 * 256 + 8 * h;
    const bf16_t* chp = CH + ((size_t)L * 256 + w * 32 + r) * 256 + 8 * h;
    f32x16 acc[2]; acc[0] = zero16(); acc[1] = zero16();
#pragma unroll 4
    for (int s = 0; s < 16; ++s) {
        const bf16x8 cf = *(const bf16x8*)(chp + 16 * s);
#pragma unroll
        for (int db = 0; db < 2; ++db) {
            const bf16x8 wf = *(const bf16x8*)(wp + (size_t)(32 * db + r) * 256 + 16 * s);
            acc[db] = (type == 0) ? MFMA32(wf, cf, acc[db]) : MFMA32(cf, wf, acc[db]);
        }
    }
    const int Rl0 = (L & 31) * 256 + w * 32;
#pragma unroll
    for (int db = 0; db < 2; ++db)
#pragma unroll
        for (int q4 = 0; q4 < 4; ++q4) {
            u32x2 o; o.x = pk_bf16(acc[db][4 * q4 + 0], acc[db][4 * q4 + 1]); o.y = pk_bf16(acc[db][4 * q4 + 2], acc[db][4 * q4 + 3]);
            if (type == 0) *(u32x2*)(KCMP + (size_t)(Rl0 + r) * 64 + 32 * db + 8 * q4 + 4 * h) = o;
            else *(u32x2*)(VCMPT + ((size_t)(Rl0 >> 8) * 64 + 32 * db + r) * 256 + (Rl0 & 255) + 8 * q4 + 4 * h) = o;
        }
}


__device__ __forceinline__ void qk_tile(const bf16_t* Kt  , const bf16x8 (&Qf)[4], f32x16 (&ST)[2], int r, int h) {
#pragma unroll
    for (int kb = 0; kb < 2; ++kb) {
        f32x16 a = zero16();
#pragma unroll
        for (int s = 0; s < 4; ++s) { const bf16x8 kf = *(const bf16x8*)(Kt + (size_t)(32 * kb + r) * 64 + 16 * s + 8 * h); a = MFMA32(kf, Qf[s], a); }
        ST[kb] = a;
    }
}
__device__ __forceinline__ bf16x8 pack8(const f32x16& x, int s2) {
    u32x4 p; p.x = pk_bf16(x[8 * s2 + 0], x[8 * s2 + 1]); p.y = pk_bf16(x[8 * s2 + 2], x[8 * s2 + 3]); p.z = pk_bf16(x[8 * s2 + 4], x[8 * s2 + 5]); p.w = pk_bf16(x[8 * s2 + 6], x[8 * s2 + 7]);
    return __builtin_bit_cast(bf16x8, p);
}
__device__ __forceinline__ void pv_tile(const bf16_t* Vt  , int ldv, const f32x16 (&Pm)[2], f32x16 (&O)[2], int r, int h) {
#pragma unroll
    for (int kb = 0; kb < 2; ++kb)
#pragma unroll
        for (int s2 = 0; s2 < 2; ++s2) {
            const bf16x8 pf = pack8(Pm[kb], s2);
#pragma unroll
            for (int db = 0; db < 2; ++db) {
                const bf16_t* vp = Vt + (size_t)(32 * db + r) * ldv + 32 * kb + 16 * s2 + 4 * h;
                const s16x4 lo = *(const s16x4*)vp, hi = *(const s16x4*)(vp + 8);
                const bf16x8 vf = __builtin_shufflevector(lo, hi, 0, 1, 2, 3, 4, 5, 6, 7);
                O[db] = MFMA32(vf, pf, O[db]);
            }
        }
}
constexpr int KB_BYTES = 64 * 144, VB_BYTES = 64 * 136, STG_BYTES = KB_BYTES + VB_BYTES;
constexpr int ATT_STAGE_OFF = 65536 + 512;
__device__ __forceinline__ float ex2(float x) { return __builtin_amdgcn_exp2f(x); }
__device__ __forceinline__ float xor8_add(float x) { const int y = __builtin_amdgcn_update_dpp(0, __float_as_int(x), 0x128, 0xf, 0xf, false); return x + __int_as_float(y); }
__device__ __forceinline__ float xor16_add(float x) { auto rr = __builtin_amdgcn_permlane16_swap(__float_as_uint(x), __float_as_uint(x), false, false); return __uint_as_float(rr[0]) + __uint_as_float(rr[1]); }
__device__ __forceinline__ float max3f(float a, float b, float c) { float r; asm("v_max3_f32 %0, %1, %2, %3" : "=v"(r) : "v"(a), "v"(b), "v"(c)); return r; }

__device__ __forceinline__ void qk_lds(const LAS unsigned char* kb_, unsigned kr_off, const bf16x8 (&Qf)[4], f32x16 (&ST)[2]) {
#pragma unroll
    for (int kb = 0; kb < 2; ++kb) {
        f32x16 a = zero16();
#pragma unroll
        for (int s = 0; s < 4; ++s) { const bf16x8 kf = *(const LAS bf16x8*)(kb_ + kr_off + kb * 32 * 144 + s * 32); a = MFMA32(kf, Qf[s], a); }
        ST[kb] = a;
    }
}
__device__ __forceinline__ void pv_lds(const LAS unsigned char* vb_, unsigned vr_off, const f32x16 (&Pm)[2], f32x16 (&O)[2]) {
#pragma unroll
    for (int kb = 0; kb < 2; ++kb)
#pragma unroll
        for (int s2 = 0; s2 < 2; ++s2) {
            const bf16x8 pf = pack8(Pm[kb], s2);
#pragma unroll
            for (int db = 0; db < 2; ++db) {
                const LAS unsigned char* vp = vb_ + vr_off + db * 32 * 136 + kb * 64 + s2 * 32;
                const s16x4 lo = *(const LAS s16x4*)vp, hi = *(const LAS s16x4*)(vp + 16);
                const bf16x8 vf = __builtin_shufflevector(lo, hi, 0, 1, 2, 3, 4, 5, 6, 7);
                O[db] = MFMA32(vf, pf, O[db]);
            }
        }
}
template <bool MASKED> __device__ __forceinline__ void softmax2(f32x16 (&ST)[2], unsigned vm, bool rowon, float& m_run, float& l_run, f32x16 (&O)[2]) {
    float mx = -1e30f;
    if (MASKED) {
#pragma unroll
        for (int kb = 0; kb < 2; ++kb)
#pragma unroll
            for (int i = 0; i < 16; ++i) { const bool v = (vm >> (16 * kb + i)) & 1u; mx = fmaxf(mx, v ? ST[kb][i] : -1e30f); }
    } else {
#pragma unroll
        for (int kb = 0; kb < 2; ++kb)
#pragma unroll
            for (int i = 0; i < 16; i += 2) mx = max3f(mx, ST[kb][i], ST[kb][i + 1]);
        mx = rowon ? mx : -1e30f;
    }
    if (__any(mx > m_run + 8.0f)) {
        const float mo = fmaxf(mx, __shfl_xor(mx, 32));
        const float m_new = fmaxf(m_run, mo);
        const float alpha = ex2(m_run - m_new);
        l_run *= alpha; m_run = m_new;
#pragma unroll
        for (int db = 0; db < 2; ++db) O[db] = O[db] * alpha;
    }
    float rs0 = 0.f, rs1 = 0.f;
    if (MASKED) {
#pragma unroll
        for (int kb = 0; kb < 2; ++kb)
#pragma unroll
            for (int i = 0; i < 16; ++i) { const bool v = (vm >> (16 * kb + i)) & 1u; const float p = v ? ex2(ST[kb][i] - m_run) : 0.f; ST[kb][i] = p; rs0 += p; }
    } else {
        const float m_use = rowon ? m_run : __builtin_inff();
#pragma unroll
        for (int kb = 0; kb < 2; ++kb)
#pragma unroll
            for (int i = 0; i < 16; i += 2) { const float p0 = ex2(ST[kb][i] - m_use), p1 = ex2(ST[kb][i + 1] - m_use); ST[kb][i] = p0; ST[kb][i + 1] = p1; rs0 += p0; rs1 += p1; }
    }
    l_run += rs0 + rs1;
}

template <int MODE> __device__ __forceinline__ void attn_branch(const bf16_t* Kg, const bf16_t* Vg, int ldv, int kt0, int kt1, const bf16x8 (&Qf)[4], int t, int qb, unsigned long long mysel,
                                                                float& m_run, float& l_run, float inv_l, f32x16 (&O)[2], LAS float* psw, LAS unsigned char* stage, int tid, int r, int h,
                                                                u32x4& kreg, u32x4& vreg, bool pre, const bf16_t* nK, const bf16_t* nV, int nldv) {
    const int srow = tid >> 3, sch = tid & 7;
    const bf16_t* kp = Kg + (size_t)kt0 * 4096 + srow * 64 + sch * 8;
    const bf16_t* vp = Vg + (size_t)srow * ldv + (size_t)kt0 * 64 + sch * 8;
    if (!pre) { kreg = *(const u32x4*)kp; if (MODE != 0) vreg = *(const u32x4*)vp; }
    const unsigned kw_off = srow * 144 + sch * 16, vw_off = srow * 136 + sch * 16;
    const unsigned kr_off = r * 144 + h * 16, vr_off = r * 136 + h * 8;
    const int nmax = (t >= 31) ? ((t - 31) >> 4) : -1;
    __syncthreads();
    *(LAS u32x4*)(stage + kw_off) = kreg;
    if (MODE != 0) { *(LAS u32x2*)(stage + KB_BYTES + vw_off) = (u32x2){vreg.x, vreg.y}; *(LAS u32x2*)(stage + KB_BYTES + vw_off + 8) = (u32x2){vreg.z, vreg.w}; }
    __syncthreads();
    for (int kt = kt0; kt <= kt1; ++kt) {
        const int cur = (kt - kt0) & 1;
        if (kt < kt1) { kp += 4096; kreg = *(const u32x4*)kp; if (MODE != 0) { vp += 64; vreg = *(const u32x4*)vp; } }
        else if (nK) { kreg = *(const u32x4*)(nK + srow * 64 + sch * 8); if (nV) vreg = *(const u32x4*)(nV + (size_t)srow * nldv + sch * 8); }
        const LAS unsigned char* kb_ = stage + cur * STG_BYTES; const LAS unsigned char* vb_ = kb_ + KB_BYTES;
        bool selb = true, active = true;
        if (MODE == 2) { selb = (mysel >> kt) & 1ull; active = (__ballot(selb) != 0ull); }
        if (active) {
            f32x16 ST[2]; qk_lds(kb_, kr_off, Qf, ST);
            if (MODE == 0) {
                unsigned vm = 0u;
#pragma unroll
                for (int kb = 0; kb < 2; ++kb)
#pragma unroll
                    for (int i = 0; i < 16; ++i) { const int n = 64 * kt + 32 * kb + crow16(i, h); if (n <= nmax) vm |= 1u << (16 * kb + i); }
                softmax2<true>(ST, vm, true, m_run, l_run, O);
            } else if (MODE == 1) {
#pragma unroll
                for (int kb = 0; kb < 2; ++kb)
#pragma unroll
                    for (int i = 0; i < 16; ++i) {
                        const int n = 64 * kt + 32 * kb + crow16(i, h);
                        const float p = (n <= nmax) ? ex2(ST[kb][i] - m_run) * inv_l : 0.f; ST[kb][i] = p;
                        const float ps = xor16_add(xor8_add(p));
                        if (r < 8) psw[r * 256 + n] = ps;
                    }
                pv_lds(vb_, vr_off, ST, O);
            } else {
                const bool edge = (MODE == 2) ? (kt == qb) : (kt == qb || kt == qb - 8);
                if (edge) {
                    unsigned vm = 0u;
#pragma unroll
                    for (int kb = 0; kb < 2; ++kb)
#pragma unroll
                        for (int i = 0; i < 16; ++i) {
                            const int kp_ = 64 * kt + 32 * kb + crow16(i, h);
                            const bool v = (MODE == 2) ? (selb && kp_ <= t) : (kp_ <= t && kp_ + 512 > t);
                            if (v) vm |= 1u << (16 * kb + i);
                        }
                    softmax2<true>(ST, vm, true, m_run, l_run, O);
                } else {
                    softmax2<false>(ST, 0u, selb, m_run, l_run, O);
                }
                pv_lds(vb_, vr_off, ST, O);
            }
        }
        if (kt < kt1) {
            LAS unsigned char* nb = stage + (cur ^ 1) * STG_BYTES;
            *(LAS u32x4*)(nb + kw_off) = kreg;
            if (MODE != 0) { *(LAS u32x2*)(nb + KB_BYTES + vw_off) = (u32x2){vreg.x, vreg.y}; *(LAS u32x2*)(nb + KB_BYTES + vw_off + 8) = (u32x2){vreg.z, vreg.w}; }
        }
        __syncthreads();
    }
}

__device__ void nsa_attn_phase(const bf16_t* Q, const bf16_t* KV, const bf16_t* KCMP, const bf16_t* VCMPT, const float* gates, bf16_t* AO, LAS unsigned char* lds) {
    const int tid = otid(), wid = tid >> 6, lane = tid & 63, r = lane & 31, h = lane >> 5;
    LAS float* psw = (LAS float*)lds + wid * 2048;
    LAS unsigned long long* selw = (LAS unsigned long long*)(lds + 65536) + wid * 8;
    LAS unsigned char* stage = lds + ATT_STAGE_OFF;
    if (wid < 4) __builtin_amdgcn_s_setprio(2);
    const int G = ogdim();
    for (int idx = obid(); idx < 2048; idx += G) {
        const int vb = idx & 255, jj = idx >> 8;
        const int xcd = vb & 7, slot = vb >> 3;
        const int bg = xcd * 4 + (slot >> 3), kq = slot & 7;
        const int qb = (jj & 1) ? (16 * (jj >> 1) + 15 - kq) : (16 * (jj >> 1) + kq);
        const int b = bg >> 2, g = bg & 3;
        const int head = g * 4 + (r >> 3);
        const int tok = wid * 8 + (r & 7);
        const int t = qb * 64 + tok;
        const size_t rowg = (size_t)b * 4096 + t;
        bf16x8 Qf[4];
        { const bf16_t* qp = Q + ((size_t)(b * 16 + head) * 4096 + t) * 64 + 8 * h;
#pragma unroll
          for (int s = 0; s < 4; ++s) Qf[s] = *(const bf16x8*)(qp + 16 * s); }
        f32x16 OUT[2];
#pragma unroll
        for (int i = 0; i < 32; ++i) psw[lane + 64 * i] = 0.f;
        {
            const bf16_t* Kc = KCMP + (size_t)bg * 256 * 64; const bf16_t* Vc = VCMPT + (size_t)bg * 64 * 256;
            int ntc = ((4 * qb + 2) >> 6) + 1; if (ntc > 4) ntc = 4;
            float m_run = -1e30f, l_run = 0.f;
            f32x16 O[2]; O[0] = zero16(); O[1] = zero16();
            u32x4 kst = {0u, 0u, 0u, 0u}, vst = {0u, 0u, 0u, 0u};
            attn_branch<0>(Kc, Vc, 256, 0, ntc - 1, Qf, t, qb, 0ull, m_run, l_run, 0.f, O, psw, stage, tid, r, h, kst, vst, false, Kc, Vc, 256);
            l_run += __shfl_xor(l_run, 32);
            const float inv_l = l_run > 0.f ? __builtin_amdgcn_rcpf(l_run) : 0.f;
            attn_branch<1>(Kc, Vc, 256, 0, ntc - 1, Qf, t, qb, 0ull, m_run, l_run, inv_l, O, psw, stage, tid, r, h, kst, vst, true, nullptr, nullptr, 0);
            const float g_c = gates[rowg * 48 + head];
#pragma unroll
            for (int db = 0; db < 2; ++db) OUT[db] = O[db] * g_c;
        }
        __syncthreads();
        for (int tk = 0; tk < 8; ++tk) {
            const int mblk = lane;
            float imp = 0.f;
#pragma unroll
            for (int j = -1; j <= 3; ++j) { const int n = 4 * mblk + j; if (n >= 0) imp += psw[tk * 256 + n]; }
            if (mblk == 0 || mblk == qb || mblk == qb - 1) imp = 1e9f;
            if (mblk > qb) imp = -1e30f;
            int rank = 0;
#pragma unroll 8
            for (int mp = 0; mp < 64; ++mp) { const float o = __int_as_float(__builtin_amdgcn_readlane(__float_as_int(imp), mp)); rank += (o > imp || (o == imp && mp < mblk)) ? 1 : 0; }
            unsigned long long msk = __ballot(rank < 16);
            msk &= (qb >= 63) ? ~0ull : ((2ull << qb) - 1ull);
            if (lane == 0) selw[tk] = msk;
        }
        __syncthreads();
        const unsigned long long mysel = selw[r & 7];
#pragma unroll
        for (int db = 0; db < 2; ++db)
#pragma unroll
            for (int i = 0; i < 16; ++i) psw[(db * 16 + i) * 64 + lane] = OUT[db][i];
        u32x4 kst2 = {0u, 0u, 0u, 0u}, vst2 = {0u, 0u, 0u, 0u};
        {
            const bf16_t* Ks = KV + 2 * KVSZ + (size_t)bg * 4096 * 64; const bf16_t* Vs = KV + 3 * KVSZ + (size_t)bg * 64 * 4096;
            float m_run = -1e30f, l_run = 0.f; f32x16 O[2]; O[0] = zero16(); O[1] = zero16();
            attn_branch<2>(Ks, Vs, 4096, 0, qb, Qf, t, qb, mysel, m_run, l_run, 0.f, O, psw, stage, tid, r, h, kst2, vst2, false,
                           KV + 4 * KVSZ + (size_t)bg * 4096 * 64 + (size_t)(qb > 8 ? qb - 8 : 0) * 4096, KV + 5 * KVSZ + (size_t)bg * 64 * 4096 + (size_t)(qb > 8 ? qb - 8 : 0) * 64, 4096);
            l_run += __shfl_xor(l_run, 32);
            const float sc = (l_run > 0.f ? __builtin_amdgcn_rcpf(l_run) : 0.f) * gates[rowg * 48 + 16 + head];
#pragma unroll
            for (int db = 0; db < 2; ++db)
#pragma unroll
                for (int i = 0; i < 16; ++i) psw[(db * 16 + i) * 64 + lane] += O[db][i] * sc;
        }
        {
            const bf16_t* Kw = KV + 4 * KVSZ + (size_t)bg * 4096 * 64; const bf16_t* Vw = KV + 5 * KVSZ + (size_t)bg * 64 * 4096;
            float m_run = -1e30f, l_run = 0.f; f32x16 O[2]; O[0] = zero16(); O[1] = zero16();
            attn_branch<3>(Kw, Vw, 4096, (qb > 8 ? qb - 8 : 0), qb, Qf, t, qb, 0ull, m_run, l_run, 0.f, O, psw, stage, tid, r, h, kst2, vst2, true, nullptr, nullptr, 0);
            l_run += __shfl_xor(l_run, 32);
            const float sc = (l_run > 0.f ? __builtin_amdgcn_rcpf(l_run) : 0.f) * gates[rowg * 48 + 32 + head];
#pragma unroll
            for (int db = 0; db < 2; ++db)
#pragma unroll
                for (int i = 0; i < 16; ++i) OUT[db][i] = psw[(db * 16 + i) * 64 + lane] + O[db][i] * sc;
        }
        {
            bf16_t* op = AO + rowg * 1024 + head * 64;
#pragma unroll
            for (int db = 0; db < 2; ++db)
#pragma unroll
                for (int q4 = 0; q4 < 4; ++q4) {
                    u32x2 w; w.x = pk_bf16(OUT[db][4 * q4 + 0], OUT[db][4 * q4 + 1]); w.y = pk_bf16(OUT[db][4 * q4 + 2], OUT[db][4 * q4 + 3]);
                    *(u32x2*)(op + 32 * db + 8 * q4 + 4 * h) = w;
                }
        }
    }
    __builtin_amdgcn_s_setprio(0);
    __syncthreads();
}


__device__ void sgu_spatial_phase(const bf16_t* UV, const float* lng, const float* lnb, const bf16_t* SWS, const float* bs, bf16_t* GATED, LAS unsigned char* lds) {
    constexpr int LDV = 136;
    LAS bf16_t* vnT = (LAS bf16_t*)lds;
    LAS float* mu = (LAS float*)(lds + 128 * LDV * 2); LAS float* rsd = mu + 128;
    const int tid = otid(), wid = tid >> 6, lane = tid & 63, r = lane & 31, h = lane >> 5;
    for (int cn = obid(); cn < 256; cn += ogdim()) {
        const size_t tok0 = (size_t)cn * 128;
        __syncthreads();
#pragma unroll 4
        for (int rr = 0; rr < 16; ++rr) {
            const int sl = wid * 16 + rr;
            const u32x4* vp = (const u32x4*)(UV + (tok0 + sl) * 2048 + 1024);
            float s1 = 0.f, s2 = 0.f;
#pragma unroll
            for (int i = 0; i < 2; ++i) { const u32x4 w = vp[lane + 64 * i];
#pragma unroll
                for (int j = 0; j < 4; ++j) { const float a = __uint_as_float(w[j] << 16), c = __uint_as_float(w[j] & 0xffff0000u); s1 += a + c; s2 += a * a + c * c; } }
#pragma unroll
            for (int o = 32; o >= 1; o >>= 1) { s1 += __shfl_xor(s1, o); s2 += __shfl_xor(s2, o); }
            const float mean = s1 * (1.0f / 1024.0f); const float var = fmaxf(s2 * (1.0f / 1024.0f) - mean * mean, 0.f);
            if (lane == 0) { mu[sl] = mean; rsd[sl] = rsqrtf(var + 1e-5f); }
        }
        __syncthreads();
        for (int g = 0; g < 8; ++g) {
            {
                const int sl = tid >> 2, cq = tid & 3;
                const float mean = mu[sl], rs = rsd[sl];
                const bf16_t* vp = UV + (tok0 + sl) * 2048 + 1024 + g * 128 + cq * 32;
#pragma unroll
                for (int i = 0; i < 4; ++i) {
                    const u32x4 w = *(const u32x4*)(vp + i * 8);
                    const int c0 = cq * 32 + i * 8;
                    const f32x4 ga = *(const f32x4*)(lng + g * 128 + c0), gb = *(const f32x4*)(lng + g * 128 + c0 + 4);
                    const f32x4 ba = *(const f32x4*)(lnb + g * 128 + c0), bb = *(const f32x4*)(lnb + g * 128 + c0 + 4);
#pragma unroll
                    for (int j = 0; j < 4; ++j) {
                        const float a = __uint_as_float(w[j] << 16), c = __uint_as_float(w[j] & 0xffff0000u);
                        const float gA = (2 * j < 4) ? ga[(2 * j) & 3] : gb[(2 * j) & 3], gB = (2 * j + 1 < 4) ? ga[(2 * j + 1) & 3] : gb[(2 * j + 1) & 3];
                        const float bA = (2 * j < 4) ? ba[(2 * j) & 3] : bb[(2 * j) & 3], bB = (2 * j + 1 < 4) ? ba[(2 * j + 1) & 3] : bb[(2 * j + 1) & 3];
                        vnT[(c0 + 2 * j) * LDV + sl] = f2bf((a - mean) * rs * gA + bA);
                        vnT[(c0 + 2 * j + 1) * LDV + sl] = f2bf((c - mean) * rs * gB + bB);
                    }
                }
            }
            __syncthreads();
            const int tb = wid & 3, ch = wid >> 2;
            f32x16 acc[2]; acc[0] = zero16(); acc[1] = zero16();
            const bf16_t* wsp = SWS + ((size_t)g * 128 + tb * 32 + r) * 128 + 8 * h;
            for (int ks = 0; ks <= 2 * tb + 1; ++ks) {
                const bf16x8 bfrag = *(const bf16x8*)(wsp + 16 * ks);
#pragma unroll
                for (int cb = 0; cb < 2; ++cb) {
                    const bf16x8 afrag = *(const LAS bf16x8*)(vnT + (ch * 64 + cb * 32 + r) * LDV + 16 * ks + 8 * h);
                    acc[cb] = MFMA32(afrag, bfrag, acc[cb]);
                }
            }
            const int tl = tb * 32 + r; const size_t token = tok0 + tl;
            const float bias = bs[g * 128 + tl];
#pragma unroll
            for (int cb = 0; cb < 2; ++cb)
#pragma unroll
                for (int q4 = 0; q4 < 4; ++q4) {
                    const int c0 = g * 128 + ch * 64 + cb * 32 + 8 * q4 + 4 * h;
                    const u32x2 uw = *(const u32x2*)(UV + token * 2048 + c0);
                    const float u0 = __uint_as_float(uw.x << 16), u1 = __uint_as_float(uw.x & 0xffff0000u), u2 = __uint_as_float(uw.y << 16), u3 = __uint_as_float(uw.y & 0xffff0000u);
                    u32x2 w; w.x = pk_bf16(u0 * (acc[cb][4 * q4 + 0] + bias), u1 * (acc[cb][4 * q4 + 1] + bias)); w.y = pk_bf16(u2 * (acc[cb][4 * q4 + 2] + bias), u3 * (acc[cb][4 * q4 + 3] + bias));
                    *(u32x2*)(GATED + token * 1024 + c0) = w;
                }
            __syncthreads();
        }
    }
    __syncthreads();
}

__device__ void pool_diff_phase(const float* __restrict__ Z, bf16_t* __restrict__ Dd) {
    const size_t gtid = (size_t)obid() * 512 + otid(), gsz = (size_t)ogdim() * 512;
    for (size_t idx = gtid; idx < (size_t)256 * 1024; idx += gsz) {
        const int c4 = (int)(idx & 255), seg = (int)(idx >> 8);
        const int t0 = seg * 32, s0 = t0 & 4095; const int w = 2 << (c4 >> 6);
        const f32x4* zp = (const f32x4*)Z + c4;
        f32x4 S = {0.f, 0.f, 0.f, 0.f};
        const int jlo = (s0 - w > 0) ? (s0 - w) : 0;
        for (int j = jlo; j < s0; ++j) S = S + zp[(size_t)(t0 - s0 + j) * 256];
#pragma unroll 8
        for (int i = 0; i < 32; ++i) {
            const int s = s0 + i; const f32x4 zt = zp[(size_t)(t0 + i) * 256];
            S = S + zt; if (s - w >= 0) S = S - zp[(size_t)(t0 + i - w) * 256];
            const float inv = 1.0f / (float)((s + 1 < w) ? (s + 1) : w);
            const f32x4 d = S * inv - zt;
            u32x2 o; o.x = pk_bf16(d[0], d[1]); o.y = pk_bf16(d[2], d[3]);
            *(u32x2*)(Dd + (size_t)(t0 + i) * 1024 + c4 * 4) = o;
        }
    }
}

#define XB_TMO      128
#define XB_XCNT(j)  (256  + 64 * (j))
#define XB_XSUB(j)  (1280 + 64 * (j))
#define XB_XGEN(j)  (2304 + 64 * (j))
#define XB_TOP      3328
#define XB_TOPGEN   3392
#define XCD_BAR_WORDS 3456
#define XB_SPIN_CAP (1u << 18)

__device__ __forceinline__ unsigned xb_ld(unsigned* p)              { return __hip_atomic_load(p, __ATOMIC_RELAXED, __HIP_MEMORY_SCOPE_AGENT); }
__device__ __forceinline__ unsigned xb_add(unsigned* p, unsigned v) { return __hip_atomic_fetch_add(p, v, __ATOMIC_RELAXED, __HIP_MEMORY_SCOPE_AGENT); }
__device__ __forceinline__ unsigned xb_xcc_id() { return (unsigned)__builtin_amdgcn_s_getreg((3 << 11) | 20) & 0xFu; }
#define XB_SPIN(cond, bar) do { unsigned _sp = 0; while (cond) { __builtin_amdgcn_s_sleep(1); \
    if ((++_sp & 255u) == 0u) { if (xb_ld(&(bar)[XB_TMO])) break; if (_sp > XB_SPIN_CAP) { atomicAdd(&(bar)[XB_TMO], 1u); break; } } } } while (0)

struct XcdBarrier {
    unsigned* bar; unsigned x;
    volatile LAS unsigned* st;
};

__device__ __forceinline__ XcdBarrier xcd_barrier_post(unsigned* bar, volatile LAS unsigned* st) {
    XcdBarrier b; b.bar = bar; b.x = xb_xcc_id(); b.st = st;
    if (threadIdx.x == 0) (void)xb_add(&bar[XB_XCNT(b.x)], 1u);
    return b;
}
__device__ __forceinline__ void xcd_barrier_complete(unsigned* bar, unsigned x, unsigned& nloc, unsigned& nx) {
    const unsigned G = gridDim.x * gridDim.y * gridDim.z;
    unsigned sum, cnt, mine, sp = 0u;
    for (;;) {
        sum = 0u; cnt = 0u; mine = 0u;
#pragma unroll
        for (unsigned j = 0; j < 16; ++j) { const unsigned c = xb_ld(&bar[XB_XCNT(j)]); sum += c; cnt += (c > 0u) ? 1u : 0u; mine = (j == x) ? c : mine; }
        if (sum == G) break;
        __builtin_amdgcn_s_sleep(1);
        if ((++sp & 255u) == 0u) { if (xb_ld(&bar[XB_TMO])) break; if (sp > XB_SPIN_CAP) { atomicAdd(&bar[XB_TMO], 1u); break; } }
    }
    nloc = mine > 0u ? mine : 1u; nx = cnt > 0u ? cnt : 1u;
}

__device__ __forceinline__ void xcd_barrier(const XcdBarrier& b) {
    asm volatile("s_waitcnt vmcnt(0)" ::: "memory");
    __syncthreads();
    if (threadIdx.x == 0) {
        unsigned* bar = b.bar;
        __builtin_amdgcn_s_waitcnt(0);
        unsigned nloc = b.st[0], nx = b.st[1];
        if (nloc == 0u) { xcd_barrier_complete(bar, b.x, nloc, nx); b.st[0] = nloc; b.st[1] = nx; }
        const unsigned old = xb_add(&bar[XB_XSUB(b.x)], 1u);
        const unsigned gen = old / nloc;
        if (old + 1u == (gen + 1u) * nloc) {
            __builtin_amdgcn_fence(__ATOMIC_RELEASE, "agent");
            asm volatile("s_waitcnt vmcnt(0)" ::: "memory");
            const unsigned og = xb_add(&bar[XB_TOP], 1u);
            const unsigned tg = og / nx;
            if (og + 1u == (tg + 1u) * nx) xb_add(&bar[XB_TOPGEN], 1u);
            else XB_SPIN(xb_ld(&bar[XB_TOPGEN]) == tg, bar);
            __builtin_amdgcn_fence(__ATOMIC_ACQUIRE, "agent");
            xb_add(&bar[XB_XGEN(b.x)], 1u);
            asm volatile("s_waitcnt vmcnt(0)" ::: "memory");
        } else {
            XB_SPIN(xb_ld(&bar[XB_XGEN(b.x)]) == gen, bar);
            __builtin_amdgcn_fence(__ATOMIC_ACQUIRE, "agent");
            asm volatile("s_waitcnt vmcnt(0)" ::: "memory");
        }
    }
    __syncthreads();
}

constexpr int NPH = 25;
__constant__ unsigned char PROG[NPH][2] = {
    {0, 0},
    {3, 0}, {4, 0}, {5, 0}, {6, 0}, {7, 0}, {13, 0}, {14, 0},
    {8, 1}, {9, 1}, {7, 1}, {13, 1}, {14, 1},
    {10, 2}, {11, 2}, {7, 2}, {13, 2}, {14, 2},
    {3, 3}, {4, 3}, {5, 3}, {6, 3}, {7, 3}, {13, 3}, {14, 3},
};
__global__ void __launch_bounds__(512, 2) fwd_megakernel(Params P) {
    extern __shared__ __attribute__((aligned(16))) unsigned char lds_raw[];
    LAS unsigned char* lds = (LAS unsigned char*)lds_raw;
    cg::grid_group grid = cg::this_grid();
    { volatile LAS unsigned* st0 = (volatile LAS unsigned*)(lds + 131072); if (threadIdx.x == 0) { st0[0] = 0u; st0[1] = 0u; } __syncthreads(); }
    (void)xcd_barrier_post((unsigned*)(P.ws + WS_BAR), (volatile LAS unsigned*)(lds + 131072));
    prologue_phase(P, lds);
    if (obid() == 0 && otid() == 0) {
        const float** tb = (const float**)(P.ws + WS_TBL);
        tb[0] = P.x; tb[1] = P.mix_norm; tb[2] = P.ffn_norm; tb[3] = P.final_norm; tb[4] = P.nsa_cmp_k_w2; tb[5] = P.nsa_cmp_v_w2;
        tb[6] = P.sgu_ln_g; tb[7] = P.sgu_ln_b; tb[8] = P.sgu_b_s; tb[9] = P.pool_scale;
    }
    grid.sync();
    unsigned char* const ws_k = P.ws; float* const out_k = P.out;
#pragma unroll 1
    for (int ph = 1; ph <= NPH; ++ph) {
        const int type = (ph < NPH) ? (int)PROG[ph][0] : 15, layer = (ph < NPH) ? (int)PROG[ph][1] : 0;
        unsigned char* ws = ws_k; asm volatile("" : "+s"(ws));
        const float* const* tb = (const float* const*)(ws + WS_TBL);
        bf16_t* H = (bf16_t*)(ws + WS_H);
        bf16_t* BIG = (bf16_t*)(ws + WS_BIG);
        bf16_t* H2 = (bf16_t*)(ws + WS_H2);
        float* RSS = (float*)(ws + WS_RSS);
        const float* rss_in = RSS + (size_t)((layer == 0) ? 7 : (2 * layer - 1)) * MTOK * 16;
        bf16_t* XB = H2;
        float* X = out_k; asm volatile("" : "+s"(X));
        const int kind = layer % 3, j = layer / 3;
        switch (type) {
        case 15: final_norm_phase(XB, tb[3], X); break;
        case 3: { if (obid() == 0) cbias_reduce(ws, j);
                  EpiNsaIn E; E.Q = BIG; E.KV = BIG + (size_t)MTOK * 1024; E.gates = (float*)(ws + WS_GATES); E.cs = (const float*)(ws + WS_CS); E.rss = rss_in;
                  run_gemm(lds, XB, 1024, (const bf16_t*)(ws + WS_NWIN) + (size_t)j * NSA_NP * 1024, MTOK, 2560, 1024, E); } break;
        case 4: if (obid() >= 64) {
                  EpiGates E; E.gates = (float*)(ws + WS_GATES); E.rss = rss_in;
                  pg8::Gemm g; g.A = XB; g.Bt = (const bf16_t*)(ws + WS_NWIN) + (size_t)j * NSA_NP * 1024; g.M = MTOK; g.N = NSA_NP; g.K = 1024; g.lda = 1024; g.acs = 0;
                  GateOrder S; S.G = ogdim() - 64; S.c = obid() - 64;
                  pg8::gemm_phase<EpiGates, GateOrder, false>(lds, g, S, E, nullptr);
                } else { EpiBf16<2> E; E.O = (bf16_t*)(ws + WS_CH); E.ldc = 256; E.aux = (const float*)(ws + WS_CBIAS) + j * 512; E.rss = nullptr;
                  pg8::Gemm g; g.A = BIG + (size_t)MTOK * 1024; g.Bt = (const bf16_t*)(ws + WS_CW1) + (size_t)j * 512 * 2048; g.M = 16384; g.N = 512; g.K = 2048; g.lda = 1024; g.acs = 0;
                  CmpOrder S; S.G = ogdim(); S.c = obid();
                  pg8::gemm_phase<EpiBf16<2>, CmpOrder, false>(lds, g, S, E, nullptr); } break;
        case 5: if (obid() < 64) cmp2_local((const bf16_t*)(ws + WS_CH), (const bf16_t*)(ws + WS_W2T) + (size_t)j * 2 * 64 * 256, (bf16_t*)(ws + WS_KCMP), (bf16_t*)(ws + WS_VCMPT), obid()); break;
        case 6: nsa_attn_phase(BIG, BIG + (size_t)MTOK * 1024, (const bf16_t*)(ws + WS_KCMP), (const bf16_t*)(ws + WS_VCMPT), (const float*)(ws + WS_GATES), H, lds); break;
        case 7: case 14: {
                  EpiResid E; E.XB = XB;
                  if (type == 7) E.rss = RSS + (size_t)(2 * layer) * MTOK * 16; else E.rss = (layer < 3) ? RSS + (size_t)(2 * layer + 1) * MTOK * 16 : nullptr;
                  const bf16_t* A = H; int K = 1024; const bf16_t* Bt;
                  if (type == 14) { A = BIG; K = FH; Bt = (const bf16_t*)(ws + WS_WDN) + (size_t)layer * 1024 * FH; }
                  else if (kind == 0) Bt = (const bf16_t*)(ws + WS_NWOUT) + (size_t)j * 1024 * 1024;
                  else if (kind == 1) Bt = (const bf16_t*)(ws + WS_SWOUT);
                  else Bt = (const bf16_t*)(ws + WS_PWOUT);
                  run_gemm(lds, A, K, Bt, MTOK, 1024, K, E); } break;
        case 8: { EpiBf16<0> E; E.O = BIG; E.ldc = 2048; E.aux = nullptr; E.rss = rss_in;
                  run_gemm(lds, XB, 1024, (const bf16_t*)(ws + WS_SWIN), MTOK, 2048, 1024, E); } break;
        case 9: sgu_spatial_phase(BIG, tb[6], tb[7], (const bf16_t*)(ws + WS_SWS), tb[8], H, lds); break;
        case 10: { EpiF32 E; E.C = (float*)BIG; E.rss = rss_in;
                  run_gemm(lds, XB, 1024, (const bf16_t*)(ws + WS_PWIN), MTOK, 1024, 1024, E); } break;
        case 11: pool_diff_phase((const float*)BIG, H); break;
        case 12: { EpiBf16<1> E; E.O = BIG; E.ldc = 1024; E.aux = tb[9]; E.rss = nullptr;
                  int kk = 256; asm volatile("" : "+s"(kk));
                  run_gemm(lds, H, 1024, (const bf16_t*)(ws + WS_PGRP), MTOK, 1024, kk, E, 512); } break;
        case 13: { EpiGU E; E.HID = BIG; E.rss = RSS + (size_t)(2 * layer) * MTOK * 16;
                  run_gemm(lds, XB, 1024, (const bf16_t*)(ws + WS_WGU) + (size_t)layer * 5632 * 1024, MTOK, 5632, 1024, E); } break;
        default: break;
        }
        if (ph < NPH && type != 4) { XcdBarrier xb; xb.bar = (unsigned*)(ws + WS_BAR); xb.x = xb_xcc_id(); xb.st = (volatile LAS unsigned*)(lds + 131072); xcd_barrier(xb); }
    }
}

extern "C" void kernel_launch(void* const* d_in, const int* in_sizes, int n_in, void* d_out, int out_size, void* d_ws, size_t ws_size, hipStream_t stream) {
    static int grid_blocks = 0;
    if (grid_blocks == 0) {
        if (n_in != 25 || out_size != MTOK * DM || ws_size < WS_END) { fprintf(stderr, "kernel_launch: unexpected shapes (n_in %d, out %d, ws %zu need %zu)\n", n_in, out_size, ws_size, (size_t)WS_END); grid_blocks = -1; return; }
        int dev = 0, cus = 0, per_cu = 0;
        hipGetDevice(&dev);
        hipDeviceGetAttribute(&cus, hipDeviceAttributeMultiprocessorCount, dev);
        if (hipFuncSetAttribute((const void*)fwd_megakernel, hipFuncAttributeMaxDynamicSharedMemorySize, LDS_BYTES) != hipSuccess) { fprintf(stderr, "kernel_launch: hipFuncSetAttribute failed\n"); grid_blocks = -1; return; }
        if (hipOccupancyMaxActiveBlocksPerMultiprocessor(&per_cu, (const void*)fwd_megakernel, 512, LDS_BYTES) != hipSuccess || per_cu < 1) { fprintf(stderr, "kernel_launch: occupancy query gave %d\n", per_cu); per_cu = 1; }
        (void)hipGetLastError();
        grid_blocks = cus * 1;
    }
    if (grid_blocks < 0) return;
    Params p{};
    p.x = (const float*)d_in[0]; p.positions = (const int*)d_in[1]; p.mix_norm = (const float*)d_in[2]; p.ffn_norm = (const float*)d_in[3]; p.final_norm = (const float*)d_in[4];
    p.nsa_w_in = (const float*)d_in[5]; p.nsa_cmp_pos_k = (const float*)d_in[6]; p.nsa_cmp_k_w1 = (const float*)d_in[7]; p.nsa_cmp_k_w2 = (const float*)d_in[8];
    p.nsa_cmp_pos_v = (const float*)d_in[9]; p.nsa_cmp_v_w1 = (const float*)d_in[10]; p.nsa_cmp_v_w2 = (const float*)d_in[11]; p.nsa_w_out = (const float*)d_in[12];
    p.sgu_w_in = (const float*)d_in[13]; p.sgu_ln_g = (const float*)d_in[14]; p.sgu_ln_b = (const float*)d_in[15]; p.sgu_w_s = (const float*)d_in[16]; p.sgu_b_s = (const float*)d_in[17]; p.sgu_w_out = (const float*)d_in[18];
    p.pool_w_in = (const float*)d_in[19]; p.pool_w_grp = (const float*)d_in[20]; p.pool_scale = (const float*)d_in[21]; p.pool_w_out = (const float*)d_in[22];
    p.ffn_w_gate_up = (const float*)d_in[23]; p.ffn_w_down = (const float*)d_in[24];
    p.out = (float*)d_out; p.ws = (unsigned char*)d_ws;
    if (hipMemsetAsync((unsigned char*)d_ws + WS_BAR, 0, 16384, stream) != hipSuccess) { fprintf(stderr, "kernel_launch: memset of barrier words failed\n"); return; }
    void* args[] = {&p};
    hipError_t e = hipLaunchCooperativeKernel((const void*)fwd_megakernel, dim3(grid_blocks), dim3(512), args, LDS_BYTES, stream);
    if (e != hipSuccess) fprintf(stderr, "cooperative launch failed: %s (grid %d)\n", hipGetErrorString(e), grid_blocks);
}
```

```cpp
#include <hip/hip_runtime.h>
#include <hip/hip_cooperative_groups.h>
#include <cstdio>
namespace cg = cooperative_groups;
namespace pg8 {
#define PG8_LAS __attribute__((address_space(3)))
typedef unsigned short bf16_t;
typedef short bf16x8 __attribute__((ext_vector_type(8)));
typedef float f32x4 __attribute__((ext_vector_type(4)));
typedef unsigned u32x4 __attribute__((ext_vector_type(4)));
constexpr int BM = 256, BK = 64, HALF = 128, HTB = HALF * BK * 2  , STAGE_BYTES = 8 * HTB, NXCD = 8, WGM = 8;

__host__ __device__ __forceinline__ int lds_byte(int r, int c) { const int st = (r >> 4) * 2 + (c >> 5), rr = r & 15, cc = c & 31, ob = rr * 64 + cc * 2; return st * 1024 + (ob ^ (((ob >> 9) & 1) << 5)); }
__host__ __device__ __forceinline__ void stage_rc(int b, int& R, int& C) { const int st = b / 1024, sb = b % 1024, swz = sb ^ (((sb >> 9) & 1) << 5); R = (st >> 1) * 16 + swz / 64; C = (st & 1) * 32 + (swz % 64) / 2; }
__host__ __device__ __forceinline__ int perm32(int rho) { const int n = rho >> 4, i = rho & 15; return 8 * (i >> 2) + 4 * n + (i & 3); }

struct Unit { int pm, pn; };
struct Gemm { const bf16_t* A; const bf16_t* Bt; int M, N, K, lda, acs; };

struct StaticOrder {
    int nM, nN, nwg, G, c;
    __host__ __device__ void init(int M, int N, int G_, int c_) { nM = M / BM; nN = N / BM; nwg = nM * nN; G = G_; c = c_; }
    __host__ __device__ bool next(int i, Unit& u) const {
        const long L = (long)i * G + c; if (L >= nwg) return false;
        int wgid = (int)L; { const int q = nwg / NXCD, r = nwg % NXCD, xcd = wgid % NXCD, off = wgid / NXCD; wgid = (xcd < r ? xcd * (q + 1) : r * (q + 1) + (xcd - r) * q) + off; }
        const int nig = WGM * nN, gid = wgid / nig, fm = gid * WGM, gsz = (nM - fm) < WGM ? (nM - fm) : WGM;
        u.pm = fm + ((wgid % nig) % gsz); u.pn = (wgid % nig) / gsz; return true;
    }
    __device__ __forceinline__ void a_ready(const Unit&) const {}
    __device__ __forceinline__ void done(const Unit&) const {}
};
template <class Epi, class Sched, bool STAMP = false>
__device__ __forceinline__ void gemm_phase(PG8_LAS unsigned char* lds, const Gemm g, const Sched& S, const Epi& E, unsigned long long* stamps) {
    int tid_ = threadIdx.x; asm volatile("" : "+v"(tid_)); const int tid = tid_, wid = __builtin_amdgcn_readfirstlane(tid >> 6), lane = tid & 63, wr = wid >> 2, wc = wid & 3, fr = lane & 15, fq = lane >> 4;
    const int K = g.K, nt = K / BK;
    int ts_lo = 0, ts_hi = 0, nts = 0; const unsigned long long rt_entry = STAMP ? (unsigned long long)wall_clock64() : 0ull;
#define PG8_STAMP() do { if (STAMP && wid == 0 && nts < 64) { const unsigned long long _c = (unsigned long long)clock64(); \
        ts_lo = (lane == nts) ? (int)(unsigned)_c : ts_lo; ts_hi = (lane == nts) ? (int)(unsigned)(_c >> 32) : ts_hi; ++nts; } } while (0)
    PG8_STAMP();
    unsigned voffA[2], voffB[2];
#pragma unroll
    for (int i = 0; i < 2; ++i) { int R, C; stage_rc(tid * 16 + i * 8192, R, C); const int Rb = Epi::PERM ? ((R & ~31) + perm32(R & 31)) : R;
        voffA[i] = (unsigned)(R * g.lda + C) * 2u; voffB[i] = (unsigned)(Rb * K + C) * 2u; }
    const size_t kstep = (size_t)(BK * 2);
    const size_t hstep = (size_t)HALF * K * 2;
    const size_t tstep = 2 * hstep; const size_t hstepA = (size_t)HALF * g.lda * 2; const size_t tstepA = 2 * hstepA;
    const unsigned ldsw = (unsigned)wid * 1024u;
    const int aoff = lds_byte(wr * 64 + fr, fq * 8), boff = lds_byte(wc * 32 + fr, fq * 8);
#define PG8_SA(b, h) (((b) * 2 + (h)) * HTB)
#define PG8_SB(b, h) ((4 + (b) * 2 + (h)) * HTB)
#define PG8_STAGE(bufoff, gbase, voff) do { _Pragma("unroll") for (int _i = 0; _i < 2; ++_i) \
        __builtin_amdgcn_global_load_lds((const unsigned*)((const char*)(gbase) + (voff)[_i]), (PG8_LAS unsigned*)(lds + (bufoff) + ldsw + _i * 8192), 16, 0, 0); } while (0)
#define PG8_LDA(dst, b, h) do { _Pragma("unroll") for (int m = 0; m < 4; ++m) _Pragma("unroll") for (int k = 0; k < 2; ++k) dst[m][k] = *(const PG8_LAS bf16x8*)(lds + PG8_SA(b, h) + aoff + m * 2048 + k * 1024); } while (0)
#define PG8_LDB(dst, b, h) do { _Pragma("unroll") for (int n = 0; n < 2; ++n) _Pragma("unroll") for (int k = 0; k < 2; ++k) dst[n][k] = *(const PG8_LAS bf16x8*)(lds + PG8_SB(b, h) + boff + n * 2048 + k * 1024); } while (0)
#define PG8_MMA(ai, bj, At, Bt) do { __builtin_amdgcn_s_setprio(1); _Pragma("unroll") for (int m = 0; m < 4; ++m) _Pragma("unroll") for (int n = 0; n < 2; ++n) _Pragma("unroll") for (int k = 0; k < 2; ++k) \
        acc[ai][bj][m][n] = __builtin_amdgcn_mfma_f32_16x16x32_bf16(Bt[n][k], At[m][k], acc[ai][bj][m][n], 0, 0, 0); __builtin_amdgcn_s_setprio(0); } while (0)
#define PG8_WAIT_V(n) asm volatile("s_waitcnt vmcnt(" #n ")" ::: "memory")
#define PG8_WAIT_L(n) asm volatile("s_waitcnt lgkmcnt(" #n ")" ::: "memory")
#define PG8_BAR __builtin_amdgcn_s_barrier()
#define PG8_SCHED __builtin_amdgcn_sched_barrier(0)
    Unit cur, nxt; int ui = 0;
    if (!S.next(0, cur)) return;
    f32x4 acc[2][2][4][2];
#pragma unroll
    for (int a = 0; a < 2; ++a)
#pragma unroll
        for (int b = 0; b < 2; ++b)
#pragma unroll
            for (int m = 0; m < 4; ++m)
#pragma unroll
                for (int n = 0; n < 2; ++n) acc[a][b][m][n] = (f32x4){0.f, 0.f, 0.f, 0.f};
    bf16x8 At[4][2], B0[2][2], B1[2][2];
    const char* cA = (const char*)g.A + (size_t)cur.pm * tstepA + (size_t)cur.pn * g.acs; const char* cB = (const char*)g.Bt + (size_t)cur.pn * tstep;
    S.a_ready(cur);
    PG8_STAGE(PG8_SB(0, 0), cB, voffB); PG8_STAGE(PG8_SB(0, 1), cB + hstep, voffB); PG8_STAGE(PG8_SA(0, 0), cA, voffA); PG8_STAGE(PG8_SA(0, 1), cA + hstepA, voffA);
    if (wr == 1) PG8_BAR;
    PG8_WAIT_V(2); PG8_BAR;
    PG8_STAGE(PG8_SB(1, 0), cB + kstep, voffB); PG8_STAGE(PG8_SA(1, 0), cA + kstep, voffA); PG8_STAGE(PG8_SB(1, 1), cB + hstep + kstep, voffB);
    PG8_WAIT_V(6); PG8_BAR;
    PG8_STAMP();
    for (;;) {
        const bool has_next = S.next(ui + 1, nxt);
        const char* nA = has_next ? (const char*)g.A + (size_t)nxt.pm * tstepA + (size_t)nxt.pn * g.acs : cA; const char* nB = has_next ? (const char*)g.Bt + (size_t)nxt.pn * tstep : cB;
        for (int t = 0; t < nt; t += 2) {
            const bool last = (t == nt - 2);
            const char* a1 = cA + (size_t)(t + 1) * kstep;
            const char* a2 = last ? nA : cA + (size_t)(t + 2) * kstep; const char* b2 = last ? nB : cB + (size_t)(t + 2) * kstep;
            const char* a3 = a2 + kstep; const char* b3 = b2 + kstep;
            if (last && has_next) S.a_ready(nxt);
            PG8_LDB(B0, 0, 0); PG8_LDB(B1, 0, 1); PG8_SCHED; PG8_LDA(At, 0, 0); PG8_STAGE(PG8_SA(1, 1), a1 + hstepA, voffA);
            PG8_WAIT_V(8); PG8_WAIT_L(0); PG8_BAR; PG8_MMA(0, 0, At, B0); PG8_MMA(0, 1, At, B1); PG8_BAR; PG8_SCHED;
            PG8_LDA(At, 0, 1); PG8_STAGE(PG8_SB(0, 0), b2, voffB); PG8_STAGE(PG8_SB(0, 1), b2 + hstep, voffB); PG8_STAGE(PG8_SA(0, 0), a2, voffA);
            PG8_WAIT_V(8); PG8_WAIT_L(0); PG8_BAR; PG8_MMA(1, 0, At, B0); PG8_MMA(1, 1, At, B1); PG8_BAR; PG8_SCHED;
            PG8_LDB(B0, 1, 0); PG8_LDB(B1, 1, 1); PG8_SCHED; PG8_LDA(At, 1, 0); PG8_STAGE(PG8_SA(0, 1), a2 + hstepA, voffA);
            PG8_WAIT_V(8); PG8_WAIT_L(0); PG8_BAR; PG8_MMA(0, 0, At, B0); PG8_MMA(0, 1, At, B1); PG8_BAR; PG8_SCHED;
            PG8_LDA(At, 1, 1); PG8_STAGE(PG8_SB(1, 0), b3, voffB); PG8_STAGE(PG8_SB(1, 1), b3 + hstep, voffB); PG8_STAGE(PG8_SA(1, 0), a3, voffA);
            PG8_WAIT_V(8); PG8_WAIT_L(0); PG8_BAR; PG8_MMA(1, 0, At, B0); PG8_MMA(1, 1, At, B1); PG8_BAR; PG8_SCHED;
        }
        PG8_STAMP();
        if (wr == 0) PG8_BAR;
        if constexpr (!Epi::AFTER_DRAIN) { E(acc, cur, wr, wc, fr, fq); S.done(cur); }
        PG8_STAMP();
        if (!has_next) break;
#pragma unroll
        for (int a = 0; a < 2; ++a)
#pragma unroll
            for (int b = 0; b < 2; ++b)
#pragma unroll
                for (int m = 0; m < 4; ++m)
#pragma unroll
                    for (int n = 0; n < 2; ++n) acc[a][b][m][n] = (f32x4){0.f, 0.f, 0.f, 0.f};
        cur = nxt; cA = nA; cB = nB; ++ui;
        if (wr == 1) PG8_BAR;
    }
    PG8_WAIT_V(0);
    PG8_BAR;
    if constexpr (Epi::AFTER_DRAIN) { E.fused(acc, cur, wr, wc, fr, fq, lds, wid, lane); S.done(cur); }
    PG8_STAMP();
    if (STAMP && wid == 0) { stamps[lane] = lane < nts ? (((unsigned long long)(unsigned)ts_hi << 32) | (unsigned)ts_lo) : 0ull;
        if (lane == 62) stamps[62] = rt_entry; if (lane == 63) stamps[63] = (unsigned long long)wall_clock64(); }
#undef PG8_STAMP
#undef PG8_SA
#undef PG8_SB
#undef PG8_STAGE
#undef PG8_LDA
#undef PG8_LDB
#undef PG8_MMA
#undef PG8_WAIT_V
#undef PG8_WAIT_L
#undef PG8_BAR
#undef PG8_SCHED
}
}

#define LAS __attribute__((address_space(3)))
typedef unsigned short bf16_t;
typedef short bf16x8 __attribute__((ext_vector_type(8)));
typedef short s16x4 __attribute__((ext_vector_type(4)));
typedef float f32x4 __attribute__((ext_vector_type(4)));
typedef float f32x16 __attribute__((ext_vector_type(16)));
typedef unsigned u32x4 __attribute__((ext_vector_type(4)));
typedef unsigned u32x2 __attribute__((ext_vector_type(2)));
typedef __bf16 bf16x2_t __attribute__((ext_vector_type(2)));
typedef float f32x2_t __attribute__((ext_vector_type(2)));

__device__ __forceinline__ int otid() { int t = threadIdx.x; asm volatile("" : "+v"(t)); return t; }
__device__ __forceinline__ int obid() { int t = blockIdx.x; asm volatile("" : "+s"(t)); return t; }
__device__ __forceinline__ int ogdim() { int t = gridDim.x; asm volatile("" : "+s"(t)); return t; }
constexpr int NB = 8, SEQ = 4096, DM = 1024, MTOK = NB * SEQ;
constexpr int FH = 2816;
constexpr int NSA_IN = 2608, NSA_NP = 2816;
constexpr size_t KVSZ = (size_t)32 * 4096 * 64;
constexpr int LDS_BYTES = 131072 + 16;

__device__ __forceinline__ unsigned pk_bf16(float a, float b) { f32x2_t v = {a, b}; bf16x2_t r = __builtin_convertvector(v, bf16x2_t); return __builtin_bit_cast(unsigned, r); }
__device__ __forceinline__ bf16_t f2bf(float a) { return (bf16_t)(pk_bf16(a, 0.f) & 0xffffu); }
__device__ __forceinline__ float bf2f(unsigned short x) { return __uint_as_float(((unsigned)x) << 16); }
__device__ __forceinline__ float gelu_tanh(float x) { const float y = 0.7978845608f * (x + 0.044715f * x * x * x); return x * __builtin_amdgcn_rcpf(1.0f + __builtin_amdgcn_exp2f(-2.885390082f * y)); }
__device__ __forceinline__ float silu_f(float x) { return x * __builtin_amdgcn_rcpf(1.0f + __builtin_amdgcn_exp2f(-1.442695041f * x)); }
__device__ __forceinline__ float sigmoid_f(float x) { return __builtin_amdgcn_rcpf(1.0f + __builtin_amdgcn_exp2f(-1.442695041f * x)); }

constexpr size_t al256(size_t x) { return (x + 255) & ~(size_t)255; }
constexpr size_t WS_WGU = 0;
constexpr size_t WS_WDN = WS_WGU + (size_t)4 * 5632 * 1024 * 2;
constexpr size_t WS_NWIN = WS_WDN + (size_t)4 * 1024 * 2816 * 2;
constexpr size_t WS_NWOUT = WS_NWIN + (size_t)2 * NSA_NP * 1024 * 2;
constexpr size_t WS_CW1 = WS_NWOUT + (size_t)2 * 1024 * 1024 * 2;
constexpr size_t WS_SWIN = WS_CW1 + (size_t)2 * 512 * 2048 * 2;
constexpr size_t WS_SWOUT = WS_SWIN + (size_t)2048 * 1024 * 2;
constexpr size_t WS_SWS = WS_SWOUT + (size_t)1024 * 1024 * 2;
constexpr size_t WS_PWIN = WS_SWS + (size_t)8 * 128 * 128 * 2;
constexpr size_t WS_PGRP = WS_PWIN + (size_t)1024 * 1024 * 2;
constexpr size_t WS_PWOUT = WS_PGRP + (size_t)1024 * 1024 * 2;
constexpr size_t WS_CBIAS = WS_PWOUT + (size_t)1024 * 1024 * 2;
constexpr size_t WS_CS = WS_CBIAS + 4096;
constexpr size_t WS_GATES = WS_CS + (size_t)MTOK * 16 * 4;
constexpr size_t WS_CH = WS_GATES + (size_t)MTOK * 48 * 4;
constexpr size_t WS_KCMP = WS_CH + (size_t)16384 * 256 * 2;
constexpr size_t WS_VCMPT = WS_KCMP + (size_t)32 * 256 * 64 * 2;
constexpr size_t WS_H = WS_VCMPT + (size_t)32 * 64 * 256 * 2;
constexpr size_t WS_BIG = WS_H + (size_t)MTOK * 1024 * 2;
constexpr size_t WS_TBL = WS_BIG + (size_t)MTOK * 2816 * 2 + 65536;
constexpr size_t WS_CBPART = WS_TBL + 4096;
constexpr size_t WS_W2T = WS_CBPART + (size_t)256 * 256 * 4;
constexpr size_t WS_H2 = WS_W2T + (size_t)4 * 64 * 256 * 2;
constexpr size_t WS_RSS = WS_H2 + (size_t)MTOK * 1024 * 2;
constexpr size_t WS_BAR = WS_RSS + (size_t)8 * MTOK * 16 * 4;
constexpr size_t WS_END = WS_BAR + 16384;

struct Params {
    const float* x; const int* positions; const float* mix_norm; const float* ffn_norm; const float* final_norm;
    const float* nsa_w_in; const float* nsa_cmp_pos_k; const float* nsa_cmp_k_w1; const float* nsa_cmp_k_w2;
    const float* nsa_cmp_pos_v; const float* nsa_cmp_v_w1; const float* nsa_cmp_v_w2; const float* nsa_w_out;
    const float* sgu_w_in; const float* sgu_ln_g; const float* sgu_ln_b; const float* sgu_w_s; const float* sgu_b_s; const float* sgu_w_out;
    const float* pool_w_in; const float* pool_w_grp; const float* pool_scale; const float* pool_w_out;
    const float* ffn_w_gate_up; const float* ffn_w_down;
    float* out; unsigned char* ws;
};


__device__ __forceinline__ float row_rstd(const float* rss, int row) {
    const f32x4* q = (const f32x4*)(rss + (size_t)row * 16);
    const f32x4 s = (q[0] + q[1]) + (q[2] + q[3]);
    return rsqrtf(((s[0] + s[1]) + (s[2] + s[3])) * (1.0f / 1024.0f) + 1e-6f);
}
__device__ __forceinline__ void load_rstd(const float* rss, int row0, float (&rs)[2][4]) {
#pragma unroll
    for (int ai = 0; ai < 2; ++ai)
#pragma unroll
        for (int m = 0; m < 4; ++m) rs[ai][m] = rss ? row_rstd(rss, row0 + ai * 128 + m * 16) : 1.0f;
}
struct EpiResid {
    static constexpr bool PERM = true, AFTER_DRAIN = false;
    bf16_t* XB; float* rss;
    __device__ __forceinline__ void operator()(const f32x4 (&acc)[2][2][4][2], const pg8::Unit& u, int wr, int wc, int fr, int fq) const {
        const int row0 = u.pm * 256 + wr * 64 + fr, col0 = u.pn * 256 + wc * 32 + 8 * fq;
#pragma unroll
        for (int ai = 0; ai < 2; ++ai)
#pragma unroll
            for (int m = 0; m < 4; ++m) {
                const int row = row0 + ai * 128 + m * 16;
                bf16_t* rp = XB + (size_t)row * 1024 + col0;
                float ss = 0.f;
#pragma unroll
                for (int bj = 0; bj < 2; ++bj) {
                    const u32x4 bw = *(const u32x4*)(rp + bj * 128);
                    const f32x4 a0 = acc[ai][bj][m][0], a1 = acc[ai][bj][m][1];
                    float x[8];
                    x[0] = __uint_as_float(bw.x << 16) + a0[0]; x[1] = __uint_as_float(bw.x & 0xffff0000u) + a0[1];
                    x[2] = __uint_as_float(bw.y << 16) + a0[2]; x[3] = __uint_as_float(bw.y & 0xffff0000u) + a0[3];
                    x[4] = __uint_as_float(bw.z << 16) + a1[0]; x[5] = __uint_as_float(bw.z & 0xffff0000u) + a1[1];
                    x[6] = __uint_as_float(bw.w << 16) + a1[2]; x[7] = __uint_as_float(bw.w & 0xffff0000u) + a1[3];
#pragma unroll
                    for (int e = 0; e < 8; ++e) ss += x[e] * x[e];
                    u32x4 w; w.x = pk_bf16(x[0], x[1]); w.y = pk_bf16(x[2], x[3]); w.z = pk_bf16(x[4], x[5]); w.w = pk_bf16(x[6], x[7]);
                    *(u32x4*)(rp + bj * 128) = w;
                }
                if (rss) {
                    ss += __shfl_xor(ss, 16); ss += __shfl_xor(ss, 32);
                    if (fq == 0) rss[(size_t)row * 16 + u.pn * 4 + wc] = ss;
                }
            }
    }
};
struct EpiF32 {
    static constexpr bool PERM = false, AFTER_DRAIN = false;
    float* C; const float* rss;
    __device__ __forceinline__ void operator()(const f32x4 (&acc)[2][2][4][2], const pg8::Unit& u, int wr, int wc, int fr, int fq) const {
        const int row0 = u.pm * 256 + wr * 64 + fr, col0 = u.pn * 256 + wc * 32 + 4 * fq;
        float rs[2][4]; load_rstd(rss, row0, rs);
#pragma unroll
        for (int ai = 0; ai < 2; ++ai)
#pragma unroll
            for (int m = 0; m < 4; ++m) {
                const size_t off = (size_t)(row0 + ai * 128 + m * 16) * 1024 + col0;
#pragma unroll
                for (int bj = 0; bj < 2; ++bj)
#pragma unroll
                    for (int n = 0; n < 2; ++n) *(f32x4*)(C + off + bj * 128 + n * 16) = acc[ai][bj][m][n] * rs[ai][m];
            }
    }
};
struct EpiGU {
    static constexpr bool PERM = true, AFTER_DRAIN = false;
    bf16_t* HID; const float* rss;
    __device__ __forceinline__ void operator()(const f32x4 (&acc)[2][2][4][2], const pg8::Unit& u, int wr, int wc, int fr, int fq) const {
        const int row0 = u.pm * 256 + wr * 64 + fr, col0 = u.pn * 128 + wc * 32 + 8 * fq;
        float rs[2][4]; load_rstd(rss, row0, rs);
#pragma unroll
        for (int ai = 0; ai < 2; ++ai)
#pragma unroll
            for (int m = 0; m < 4; ++m) {
                const float rr = rs[ai][m];
                const f32x4 g0 = acc[ai][0][m][0] * rr, g1 = acc[ai][0][m][1] * rr, u0 = acc[ai][1][m][0] * rr, u1 = acc[ai][1][m][1] * rr;
                u32x4 w;
                w.x = pk_bf16(silu_f(g0[0]) * u0[0], silu_f(g0[1]) * u0[1]); w.y = pk_bf16(silu_f(g0[2]) * u0[2], silu_f(g0[3]) * u0[3]);
                w.z = pk_bf16(silu_f(g1[0]) * u1[0], silu_f(g1[1]) * u1[1]); w.w = pk_bf16(silu_f(g1[2]) * u1[2], silu_f(g1[3]) * u1[3]);
                *(u32x4*)(HID + (size_t)(row0 + ai * 128 + m * 16) * FH + col0) = w;
            }
    }
};
template <int MODE> struct EpiBf16 {
    static constexpr bool PERM = true, AFTER_DRAIN = false;
    bf16_t* O; int ldc; const float* aux; const float* rss;
    __device__ __forceinline__ void operator()(const f32x4 (&acc)[2][2][4][2], const pg8::Unit& u, int wr, int wc, int fr, int fq) const {
        const int row0 = u.pm * 256 + wr * 64 + fr; const int ct = wc * 32 + 8 * fq;
        const int colbase = (MODE == 2) ? 0 : u.pn * 256;
        float rs[2][4]; if (MODE == 0) load_rstd(rss, row0, rs);
        f32x4 av[2][2];
#pragma unroll
        for (int bj = 0; bj < 2; ++bj)
#pragma unroll
            for (int n = 0; n < 2; ++n) av[bj][n] = (MODE == 0) ? (f32x4){0.f, 0.f, 0.f, 0.f} : *(const f32x4*)(aux + u.pn * 256 + ct + bj * 128 + 4 * n);
#pragma unroll
        for (int ai = 0; ai < 2; ++ai)
#pragma unroll
            for (int m = 0; m < 4; ++m) {
                bf16_t* rowp = O + (size_t)(row0 + ai * 128 + m * 16) * ldc + colbase + ct;
#pragma unroll
                for (int bj = 0; bj < 2; ++bj) {
                    f32x4 v0 = acc[ai][bj][m][0], v1 = acc[ai][bj][m][1];
                    if (MODE == 0) { v0 = v0 * rs[ai][m]; v1 = v1 * rs[ai][m]; }
                    if (MODE == 1) { v0 = v0 * av[bj][0]; v1 = v1 * av[bj][1]; }
                    if (MODE == 2) { v0 = v0 + av[bj][0]; v1 = v1 + av[bj][1]; }
                    if (MODE != 1) {
#pragma unroll
                        for (int j = 0; j < 4; ++j) { v0[j] = gelu_tanh(v0[j]); v1[j] = gelu_tanh(v1[j]); }
                    }
                    u32x4 w; w.x = pk_bf16(v0[0], v0[1]); w.y = pk_bf16(v0[2], v0[3]); w.z = pk_bf16(v1[0], v1[1]); w.w = pk_bf16(v1[2], v1[3]);
                    *(u32x4*)(rowp + bj * 128) = w;
                }
            }
    }
};
struct EpiNsaIn {
    static constexpr bool PERM = true, AFTER_DRAIN = false;
    bf16_t* Q; bf16_t* KV; float* gates; const float* cs; const float* rss;
    template <int VAR> __device__ __forceinline__ void variant(const f32x4 (&acc)[2][2][4][2], const pg8::Unit& u, int wr, int wc, int fr, int fq) const {
        const int pn = u.pn; const int jkv = pn - 4;
        const int row0 = u.pm * 256 + wr * 64 + fr;
        const bool rope_w = (VAR <= 1) && ((wc & 1) == 0);
#pragma unroll
        for (int ai = 0; ai < 2; ++ai)
#pragma unroll
            for (int m = 0; m < 4; ++m) {
                const int row = row0 + ai * 128 + m * 16; const int b = row >> 12, s = row & 4095;
                const float rr = rss ? row_rstd(rss, row) : 1.0f;
#pragma unroll
                for (int bj = 0; bj < 2; ++bj) {
                    const int cb = bj * 128 + wc * 32 + fq * 8;
                    f32x4 v0 = acc[ai][bj][m][0] * rr, v1 = acc[ai][bj][m][1] * rr;
                    if (rope_w) {
                        f32x4 p0, p1;
#pragma unroll
                        for (int j = 0; j < 4; ++j) { p0[j] = __shfl_xor(v0[j], 16); p1[j] = __shfl_xor(v1[j], 16); }
                        if (fq < 2) {
                            const f32x4* c4 = (const f32x4*)(cs + (size_t)row * 16);
                            const f32x4 cA = c4[0], cB = c4[1], sA = c4[2], sB = c4[3];
                            if (fq == 0) { v0 = v0 * cA - p0 * sA; v1 = v1 * cB - p1 * sB; }
                            else { v0 = v0 * cA + p0 * sA; v1 = v1 * cB + p1 * sB; }
                        }
                    }
                    const int hh = cb >> 6, d0 = cb & 63;
                    if (VAR == 0) {
                        v0 = v0 * 0.18033688f; v1 = v1 * 0.18033688f;
                        u32x4 w; w.x = pk_bf16(v0[0], v0[1]); w.y = pk_bf16(v0[2], v0[3]); w.z = pk_bf16(v1[0], v1[1]); w.w = pk_bf16(v1[2], v1[3]);
                        *(u32x4*)(Q + ((size_t)(b * 16 + pn * 4 + hh) * 4096 + s) * 64 + d0) = w;
                    } else if (VAR == 1 || VAR == 2) {
                        u32x4 w; w.x = pk_bf16(v0[0], v0[1]); w.y = pk_bf16(v0[2], v0[3]); w.z = pk_bf16(v1[0], v1[1]); w.w = pk_bf16(v1[2], v1[3]);
                        *(u32x4*)(KV + (size_t)jkv * KVSZ + ((size_t)(b * 4 + hh) * 4096 + s) * 64 + d0) = w;
                    } else if (VAR == 3) {
                        bf16_t* tp = KV + (size_t)jkv * KVSZ + ((size_t)(b * 4 + hh) * 64 + d0) * 4096 + s;
#pragma unroll
                        for (int j = 0; j < 4; ++j) { tp[(size_t)j * 4096] = f2bf(v0[j]); tp[(size_t)(j + 4) * 4096] = f2bf(v1[j]); }
                    } else if (cb < 48) {
                        f32x4 g0, g1;
#pragma unroll
                        for (int j = 0; j < 4; ++j) { g0[j] = sigmoid_f(v0[j]); g1[j] = sigmoid_f(v1[j]); }
                        float* gp = gates + (size_t)row * 48 + cb;
                        *(f32x4*)gp = g0; *(f32x4*)(gp + 4) = g1;
                    }
                }
            }
    }
    __device__ __forceinline__ void operator()(const f32x4 (&acc)[2][2][4][2], const pg8::Unit& u, int wr_, int wc_, int fr_, int fq_) const {
        const int pn = u.pn;
        const int t_ = otid(); const int wid_ = __builtin_amdgcn_readfirstlane(t_ >> 6); const int wr = wid_ >> 2, wc = wid_ & 3, fr = t_ & 15, fq = (t_ & 63) >> 4;
        (void)wr_; (void)wc_; (void)fr_; (void)fq_;
        if (pn < 4) variant<0>(acc, u, wr, wc, fr, fq);
        else if (pn == 4 || pn == 6 || pn == 8) variant<1>(acc, u, wr, wc, fr, fq);
        else if (pn == 5) variant<2>(acc, u, wr, wc, fr, fq);
        else if (pn == 7 || pn == 9) variant<3>(acc, u, wr, wc, fr, fq);
        else variant<4>(acc, u, wr, wc, fr, fq);
    }
};
struct EpiGates {
    static constexpr bool PERM = false, AFTER_DRAIN = false;
    float* gates; const float* rss;
    __device__ __forceinline__ void operator()(const f32x4 (&acc)[2][2][4][2], const pg8::Unit& u, int wr, int wc, int fr, int fq) const {
        if (wc > 1) return;
        const int row0 = u.pm * 256 + wr * 64 + fr;
#pragma unroll
        for (int ai = 0; ai < 2; ++ai)
#pragma unroll
            for (int m = 0; m < 4; ++m) {
                const int row = row0 + ai * 128 + m * 16;
                const float rr = rss ? row_rstd(rss, row) : 1.0f;
#pragma unroll
                for (int n = 0; n < 2; ++n) {
                    const int cb = wc * 32 + 16 * n + 4 * fq;
                    if (cb < 48) {
                        const f32x4 v = acc[ai][0][m][n] * rr; f32x4 gsig;
#pragma unroll
                        for (int e = 0; e < 4; ++e) gsig[e] = sigmoid_f(v[e]);
                        *(f32x4*)(gates + (size_t)row * 48 + cb) = gsig;
                    }
                }
            }
    }
};
struct GateOrder {
    int G, c;
    __device__ bool next(int i, pg8::Unit& u) const { const int L = i * G + c; if (L >= 128 || G <= 0) return false; u.pm = L; u.pn = 10; return true; }
    __device__ __forceinline__ void a_ready(const pg8::Unit&) const {}
    __device__ __forceinline__ void done(const pg8::Unit&) const {}
};
struct CmpOrder {
    int G, c;
    __device__ bool next(int i, pg8::Unit& u) const { const int L = i * G + c; if (L >= 64) return false; u.pm = L; u.pn = L >> 5; return true; }
    __device__ __forceinline__ void a_ready(const pg8::Unit&) const {}
    __device__ __forceinline__ void done(const pg8::Unit&) const {}
};

template <class Epi> __device__ __forceinline__ void run_gemm(LAS unsigned char* lds, const bf16_t* A, int lda, const bf16_t* Bt, int M, int N, int K, const Epi& E, int acs = 0) {
    pg8::Gemm g; g.A = A; g.Bt = Bt; g.M = M; g.N = N; g.K = K; g.lda = lda; g.acs = acs;
    pg8::StaticOrder S; S.init(M, N, ogdim(), obid());
    pg8::gemm_phase<Epi, pg8::StaticOrder, false>(lds, g, S, E, nullptr);
}

struct TJob { const float* src; bf16_t* dst; const float* gk; int K, Nsrc, Ndst, mode, tiles; };
__device__ __forceinline__ int job_colmap(int mode, int n) {
    if (mode == 0) return n;
    if (mode == 1) { const int t = n >> 8, r = n & 255; return (r < 128) ? (t * 128 + r) : (FH + t * 128 + (r - 128)); }
    return (n < NSA_IN) ? n : -1;
}
__device__ void transpose_tile(LAS float* tile, const TJob& J, int t) {
    const int tid = otid(), tx = tid & 63, ty = tid >> 6;
    const int nkt = J.K >> 6; const int tn = t / nkt, tk = t - tn * nkt; const int n0 = tn * 64, k0 = tk * 64;
    const int sc = job_colmap(J.mode, n0 + tx);
#pragma unroll
    for (int i = 0; i < 8; ++i) { const int k = k0 + ty + 8 * i; const float gs = J.gk ? J.gk[k] : 1.0f; tile[(ty + 8 * i) * 65 + tx] = (sc >= 0) ? J.src[(size_t)k * J.Nsrc + sc] * gs : 0.f; }
    __syncthreads();
    {
        const int nn = tid >> 3, kg = tid & 7;
        float v[8];
#pragma unroll
        for (int e = 0; e < 8; ++e) v[e] = tile[(kg * 8 + e) * 65 + nn];
        u32x4 w; w.x = pk_bf16(v[0], v[1]); w.y = pk_bf16(v[2], v[3]); w.z = pk_bf16(v[4], v[5]); w.w = pk_bf16(v[6], v[7]);
        *(u32x4*)(J.dst + (size_t)(n0 + nn) * J.K + k0 + kg * 8) = w;
    }
    __syncthreads();
}
__device__ __forceinline__ void get_job(const Params& P, unsigned char* ws, int j, TJob& J) {
        J.gk = nullptr;
        if (j < 4) { J.gk = P.ffn_norm + j * 1024; J.src = P.ffn_w_gate_up + (size_t)j * 1024 * 5632; J.dst = (bf16_t*)(ws + WS_WGU) + (size_t)j * 5632 * 1024; J.K = 1024; J.Nsrc = 5632; J.Ndst = 5632; J.mode = 1; }
        else if (j < 8) { const int l = j - 4; J.src = P.ffn_w_down + (size_t)l * 2816 * 1024; J.dst = (bf16_t*)(ws + WS_WDN) + (size_t)l * 1024 * 2816; J.K = 2816; J.Nsrc = 1024; J.Ndst = 1024; J.mode = 0; }
        else if (j < 10) { const int l = j - 8; J.gk = P.mix_norm + (3 * l) * 1024; J.src = P.nsa_w_in + (size_t)l * 1024 * NSA_IN; J.dst = (bf16_t*)(ws + WS_NWIN) + (size_t)l * NSA_NP * 1024; J.K = 1024; J.Nsrc = NSA_IN; J.Ndst = NSA_NP; J.mode = 2; }
        else if (j < 12) { const int l = j - 10; J.src = P.nsa_w_out + (size_t)l * 1024 * 1024; J.dst = (bf16_t*)(ws + WS_NWOUT) + (size_t)l * 1024 * 1024; J.K = 1024; J.Nsrc = 1024; J.Ndst = 1024; J.mode = 0; }
        else if (j < 14) { const int l = j - 12; J.src = P.nsa_cmp_k_w1 + (size_t)l * 2048 * 256; J.dst = (bf16_t*)(ws + WS_CW1) + (size_t)l * 512 * 2048; J.K = 2048; J.Nsrc = 256; J.Ndst = 256; J.mode = 0; }
        else if (j < 16) { const int l = j - 14; J.src = P.nsa_cmp_v_w1 + (size_t)l * 2048 * 256; J.dst = (bf16_t*)(ws + WS_CW1) + (size_t)l * 512 * 2048 + (size_t)256 * 2048; J.K = 2048; J.Nsrc = 256; J.Ndst = 256; J.mode = 0; }
        else if (j == 16) { J.gk = P.mix_norm + 1024; J.src = P.sgu_w_in; J.dst = (bf16_t*)(ws + WS_SWIN); J.K = 1024; J.Nsrc = 2048; J.Ndst = 2048; J.mode = 0; }
        else if (j == 17) { J.src = P.sgu_w_out; J.dst = (bf16_t*)(ws + WS_SWOUT); J.K = 1024; J.Nsrc = 1024; J.Ndst = 1024; J.mode = 0; }
        else if (j == 18) { J.gk = P.mix_norm + 2048; J.src = P.pool_w_in; J.dst = (bf16_t*)(ws + WS_PWIN); J.K = 1024; J.Nsrc = 1024; J.Ndst = 1024; J.mode = 0; }
        else { J.src = P.pool_w_out; J.dst = (bf16_t*)(ws + WS_PWOUT); J.K = 1024; J.Nsrc = 1024; J.Ndst = 1024; J.mode = 0; }
        J.tiles = (J.Ndst >> 6) * (J.K >> 6);
    }
__device__ void prologue_phase(const Params& P, LAS unsigned char* lds) {
    unsigned char* ws = P.ws;
    const int tid = otid();
    constexpr int NJ = 22;
    int total = 0;
    (void)NJ; (void)total;
    {
        int base = 0;
        for (int j = 0; j < 19; ++j) {
            TJob J; get_job(P, ws, j, J);
            int first = (obid() - base % ogdim() + ogdim()) % ogdim();
            for (int t = first; t < J.tiles; t += ogdim()) transpose_tile((LAS float*)lds, J, t);
            base += J.tiles;
        }
    }
    const size_t gtid = (size_t)obid() * 512 + tid, gsz = (size_t)ogdim() * 512;
    {
        bf16_t* dst = (bf16_t*)(ws + WS_PWOUT);
        for (size_t i = gtid; i < (size_t)256 * 256; i += gsz) {
            const int e0 = (int)(i & 255) * 4, c0 = (int)(i >> 8) * 4; const int g = c0 >> 8;
            const f32x4* wg = (const f32x4*)(P.pool_w_grp + ((size_t)g * 256 + (c0 & 255)) * 256);
            const f32x4* sc = (const f32x4*)(P.pool_scale + g * 256);
            const float* wo = P.pool_w_out + (size_t)g * 256 * 1024 + e0;
            f32x4 acc[4];
#pragma unroll
            for (int j = 0; j < 4; ++j) acc[j] = (f32x4){0.f, 0.f, 0.f, 0.f};
#pragma unroll 2
            for (int m4 = 0; m4 < 64; ++m4) {
                const f32x4 s4 = sc[m4];
                f32x4 wv[4];
#pragma unroll
                for (int j = 0; j < 4; ++j) wv[j] = wg[j * 64 + m4] * s4;
#pragma unroll
                for (int mm = 0; mm < 4; ++mm) {
                    const f32x4 o4 = *(const f32x4*)(wo + (size_t)(m4 * 4 + mm) * 1024);
#pragma unroll
                    for (int j = 0; j < 4; ++j) acc[j] = acc[j] + o4 * wv[j][mm];
                }
            }
#pragma unroll
            for (int ii = 0; ii < 4; ++ii) {
                u32x2 w; w.x = pk_bf16(acc[0][ii], acc[1][ii]); w.y = pk_bf16(acc[2][ii], acc[3][ii]);
                *(u32x2*)(dst + (size_t)(e0 + ii) * 1024 + c0) = w;
            }
        }
    }
    {
        bf16_t* dst = (bf16_t*)(ws + WS_W2T);
        for (size_t i = gtid; i < (size_t)4 * 64 * 256; i += gsz) {
            const int c = (int)(i & 255), d = (int)((i >> 8) & 63), kv = (int)((i >> 14) & 1), l = (int)(i >> 15);
            const float* w2 = (kv ? P.nsa_cmp_v_w2 : P.nsa_cmp_k_w2) + (size_t)l * 256 * 64;
            dst[i] = f2bf(w2[c * 64 + d]);
        }
    }
    {
        bf16_t* dst = (bf16_t*)(ws + WS_SWS);
        for (size_t i = gtid; i < (size_t)8 * 128 * 128; i += gsz) { const int t = (int)((i >> 7) & 127), s = (int)(i & 127); dst[i] = f2bf(s <= t ? P.sgu_w_s[i] : 0.f); }
    }
    {
        float* cs = (float*)(ws + WS_CS);
        for (size_t i = gtid; i < (size_t)MTOK * 8; i += gsz) {
            const int row = (int)(i >> 3), f = (int)(i & 7);
            const float inv = (float)pow(500000.0, -(double)(2 * f) / 16.0);
            const float ang = (float)P.positions[row] * inv;
            float sv, cv; sincosf(ang, &sv, &cv);
            cs[(size_t)row * 16 + f] = cv; cs[(size_t)row * 16 + 8 + f] = sv;
        }
    }
    {
        const int lane = tid & 63; const int gw = obid() * 8 + (tid >> 6), nw = ogdim() * 8;
        bf16_t* XBp = (bf16_t*)(ws + WS_H2); float* rss7 = (float*)(ws + WS_RSS) + (size_t)7 * MTOK * 16;
        for (int row = gw; row < MTOK; row += nw) {
            const f32x4* xr = (const f32x4*)(P.x + (size_t)row * 1024); float ss = 0.f;
#pragma unroll
            for (int i = 0; i < 4; ++i) { const f32x4 v = xr[lane + 64 * i]; ss += v[0] * v[0] + v[1] * v[1] + v[2] * v[2] + v[3] * v[3];
                u32x2 w; w.x = pk_bf16(v[0], v[1]); w.y = pk_bf16(v[2], v[3]); ((u32x2*)(XBp + (size_t)row * 1024))[lane + 64 * i] = w; }
#pragma unroll
            for (int o = 32; o >= 1; o >>= 1) ss += __shfl_xor(ss, o);
            if (lane < 16) rss7[(size_t)row * 16 + lane] = (lane == 0) ? ss : 0.f;
        }
    }
    for (int item = obid(); item < 256; item += ogdim()) {
        const int job = item >> 6, chunk = item & 63; const int l = job >> 1, kv = job & 1;
        const float* pos = (kv ? P.nsa_cmp_pos_v : P.nsa_cmp_pos_k) + (size_t)l * 2048;
        const float* w1 = (kv ? P.nsa_cmp_v_w1 : P.nsa_cmp_k_w1) + (size_t)l * 2048 * 256;
        const int c = tid & 255, hf = tid >> 8;
        float a = 0.f;
        const int r0 = chunk * 32 + hf * 16;
#pragma unroll
        for (int r = 0; r < 16; ++r) a += pos[r0 + r] * w1[(size_t)(r0 + r) * 256 + c];
        LAS float* red = (LAS float*)lds;
        __syncthreads();
        if (hf == 1) red[c] = a;
        __syncthreads();
        if (hf == 0) ((float*)(ws + WS_CBPART))[(size_t)item * 256 + c] = a + red[c];
        __syncthreads();
    }
}
__device__ void cbias_reduce(unsigned char* ws, int l) {
    const int tid = otid(); const int kv = tid >> 8, c = tid & 255;
    const float* part = (const float*)(ws + WS_CBPART) + (size_t)(l * 2 + kv) * 64 * 256 + c;
    float a = 0.f;
#pragma unroll 16
    for (int ch = 0; ch < 64; ++ch) a += part[(size_t)ch * 256];
    ((float*)(ws + WS_CBIAS))[l * 512 + tid] = a;
}

__device__ void rmsnorm_phase(const float* X, const float* g, bf16_t* H, float* outf) {
    const int lane = otid() & 63; const int gw = obid() * 8 + (otid() >> 6), nw = ogdim() * 8;
    f32x4 gv[4];
#pragma unroll
    for (int i = 0; i < 4; ++i) gv[i] = ((const f32x4*)g)[lane + 64 * i];
    for (int row = gw; row < MTOK; row += nw) {
        const f32x4* xr = (const f32x4*)(X + (size_t)row * 1024);
        f32x4 v[4]; float ss = 0.f;
#pragma unroll
        for (int i = 0; i < 4; ++i) { v[i] = xr[lane + 64 * i]; ss += v[i][0] * v[i][0] + v[i][1] * v[i][1] + v[i][2] * v[i][2] + v[i][3] * v[i][3]; }
#pragma unroll
        for (int o = 32; o >= 1; o >>= 1) ss += __shfl_xor(ss, o);
        const float rstd = rsqrtf(ss * (1.0f / 1024.0f) + 1e-6f);
        if (outf) {
#pragma unroll
            for (int i = 0; i < 4; ++i) ((f32x4*)(outf + (size_t)row * 1024))[lane + 64 * i] = v[i] * rstd * gv[i];
        } else {
#pragma unroll
            for (int i = 0; i < 4; ++i) { const f32x4 y = v[i] * rstd * gv[i]; u32x2 w; w.x = pk_bf16(y[0], y[1]); w.y = pk_bf16(y[2], y[3]); ((u32x2*)(H + (size_t)row * 1024))[lane + 64 * i] = w; }
        }
    }
}

__device__ void final_norm_phase(const bf16_t* XB, const float* g, float* out) {
    const int lane = otid() & 63; const int gw = obid() * 8 + (otid() >> 6), nw = ogdim() * 8;
    for (int row = gw; row < MTOK; row += nw) {
        const u32x4* xr = (const u32x4*)(XB + (size_t)row * 1024);
        float v[2][8]; float ss = 0.f;
#pragma unroll
        for (int i = 0; i < 2; ++i) { const u32x4 w = xr[lane + 64 * i];
            v[i][0] = __uint_as_float(w.x << 16); v[i][1] = __uint_as_float(w.x & 0xffff0000u); v[i][2] = __uint_as_float(w.y << 16); v[i][3] = __uint_as_float(w.y & 0xffff0000u);
            v[i][4] = __uint_as_float(w.z << 16); v[i][5] = __uint_as_float(w.z & 0xffff0000u); v[i][6] = __uint_as_float(w.w << 16); v[i][7] = __uint_as_float(w.w & 0xffff0000u);
#pragma unroll
            for (int e = 0; e < 8; ++e) ss += v[i][e] * v[i][e]; }
#pragma unroll
        for (int o = 32; o >= 1; o >>= 1) ss += __shfl_xor(ss, o);
        const float rstd = rsqrtf(ss * (1.0f / 1024.0f) + 1e-6f);
#pragma unroll
        for (int i = 0; i < 2; ++i) { const int c0 = (lane + 64 * i) * 8;
            const f32x4 g0 = *(const f32x4*)(g + c0), g1 = *(const f32x4*)(g + c0 + 4);
            f32x4 o0, o1;
#pragma unroll
            for (int e = 0; e < 4; ++e) { o0[e] = v[i][e] * rstd * g0[e]; o1[e] = v[i][4 + e] * rstd * g1[e]; }
            *(f32x4*)(out + (size_t)row * 1024 + c0) = o0; *(f32x4*)(out + (size_t)row * 1024 + c0 + 4) = o1; }
    }
}

#define MFMA32(a, b, c) __builtin_amdgcn_mfma_f32_32x32x16_bf16((a), (b), (c), 0, 0, 0)
__device__ __forceinline__ int crow16(int i, int h) { return (i & 3) + 8 * (i >> 2) + 4 * h; }
__device__ __forceinline__ f32x16 zero16() { f32x16 z; for (int i = 0; i < 16; ++i) z[i] = 0.f; return z; }
__device__ void cmp2_local(const bf16_t* CH, const bf16_t* w2T, bf16_t* KCMP, bf16_t* VCMPT, int L) {
    const int tid = otid(), w = tid >> 6, lane = tid & 63, r = lane & 31, h = lane >> 5;
    const int type = L >> 5;
    const bf16_t* wp = w2T + (size_t)type * 64 * 256 + 8 * h;
    const bf16_t* chp = CH + ((size_t)L * 256 + w * 32 + r) * 256 + 8 * h;
    f32x16 acc[2]; acc[0] = zero16(); acc[1] = zero16();
#pragma unroll 4
    for (int s = 0; s < 16; ++s) {
        const bf16x8 cf = *(const bf16x8*)(chp + 16 * s);
#pragma unroll
        for (int db = 0; db < 2; ++db) {
            const bf16x8 wf = *(const bf16x8*)(wp + (size_t)(32 * db + r) * 256 + 16 * s);
            acc[db] = (type == 0) ? MFMA32(wf, cf, acc[db]) : MFMA32(cf, wf, acc[db]);
        }
    }
    const int Rl0 = (L & 31) * 256 + w * 32;
#pragma unroll
    for (int db = 0; db < 2; ++db)
#pragma unroll
        for (int q4 = 0; q4 < 4; ++q4) {
            u32x2 o; o.x = pk_bf16(acc[db][4 * q4 + 0], acc[db][4 * q4 + 1]); o.y = pk_bf16(acc[db][4 * q4 + 2], acc[db][4 * q4 + 3]);
            if (type == 0) *(u32x2*)(KCMP + (size_t)(Rl0 + r) * 64 + 32 * db + 8 * q4 + 4 * h) = o;
            else *(u32x2*)(VCMPT + ((size_t)(Rl0 >> 8) * 64 + 32 * db + r) * 256 + (Rl0 & 255) + 8 * q4 + 4 * h) = o;
        }
}


__device__ __forceinline__ void qk_tile(const bf16_t* Kt  , const bf16x8 (&Qf)[4], f32x16 (&ST)[2], int r, int h) {
#pragma unroll
    for (int kb = 0; kb < 2; ++kb) {
        f32x16 a = zero16();
#pragma unroll
        for (int s = 0; s < 4; ++s) { const bf16x8 kf = *(const bf16x8*)(Kt + (size_t)(32 * kb + r) * 64 + 16 * s + 8 * h); a = MFMA32(kf, Qf[s], a); }
        ST[kb] = a;
    }
}
__device__ __forceinline__ bf16x8 pack8(const f32x16& x, int s2) {
    u32x4 p; p.x = pk_bf16(x[8 * s2 + 0], x[8 * s2 + 1]); p.y = pk_bf16(x[8 * s2 + 2], x[8 * s2 + 3]); p.z = pk_bf16(x[8 * s2 + 4], x[8 * s2 + 5]); p.w = pk_bf16(x[8 * s2 + 6], x[8 * s2 + 7]);
    return __builtin_bit_cast(bf16x8, p);
}
__device__ __forceinline__ void pv_tile(const bf16_t* Vt  , int ldv, const f32x16 (&Pm)[2], f32x16 (&O)[2], int r, int h) {
#pragma unroll
    for (int kb = 0; kb < 2; ++kb)
#pragma unroll
        for (int s2 = 0; s2 < 2; ++s2) {
            const bf16x8 pf = pack8(Pm[kb], s2);
#pragma unroll
            for (int db = 0; db < 2; ++db) {
                const bf16_t* vp = Vt + (size_t)(32 * db + r) * ldv + 32 * kb + 16 * s2 + 4 * h;
                const s16x4 lo = *(const s16x4*)vp, hi = *(const s16x4*)(vp + 8);
                const bf16x8 vf = __builtin_shufflevector(lo, hi, 0, 1, 2, 3, 4, 5, 6, 7);
                O[db] = MFMA32(vf, pf, O[db]);
            }
        }
}
constexpr int KB_BYTES = 64 * 144, VB_BYTES = 64 * 136, STG_BYTES = KB_BYTES + VB_BYTES;
constexpr int ATT_STAGE_OFF = 65536 + 512;
__device__ __forceinline__ float ex2(float x) { return __builtin_amdgcn_exp2f(x); }
__device__ __forceinline__ float xor8_add(float x) { const int y = __builtin_amdgcn_update_dpp(0, __float_as_int(x), 0x128, 0xf, 0xf, false); return x + __int_as_float(y); }
__device__ __forceinline__ float xor16_add(float x) { auto rr = __builtin_amdgcn_permlane16_swap(__float_as_uint(x), __float_as_uint(x), false, false); return __uint_as_float(rr[0]) + __uint_as_float(rr[1]); }
__device__ __forceinline__ float max3f(float a, float b, float c) { float r; asm("v_max3_f32 %0, %1, %2, %3" : "=v"(r) : "v"(a), "v"(b), "v"(c)); return r; }

__device__ __forceinline__ void qk_lds(const LAS unsigned char* kb_, unsigned kr_off, const bf16x8 (&Qf)[4], f32x16 (&ST)[2]) {
#pragma unroll
    for (int kb = 0; kb < 2; ++kb) {
        f32x16 a = zero16();
#pragma unroll
        for (int s = 0; s < 4; ++s) { const bf16x8 kf = *(const LAS bf16x8*)(kb_ + kr_off + kb * 32 * 144 + s * 32); a = MFMA32(kf, Qf[s], a); }
        ST[kb] = a;
    }
}
__device__ __forceinline__ void pv_lds(const LAS unsigned char* vb_, unsigned vr_off, const f32x16 (&Pm)[2], f32x16 (&O)[2]) {
#pragma unroll
    for (int kb = 0; kb < 2; ++kb)
#pragma unroll
        for (int s2 = 0; s2 < 2; ++s2) {
            const bf16x8 pf = pack8(Pm[kb], s2);
#pragma unroll
            for (int db = 0; db < 2; ++db) {
                const LAS unsigned char* vp = vb_ + vr_off + db * 32 * 136 + kb * 64 + s2 * 32;
                const s16x4 lo = *(const LAS s16x4*)vp, hi = *(const LAS s16x4*)(vp + 16);
                const bf16x8 vf = __builtin_shufflevector(lo, hi, 0, 1, 2, 3, 4, 5, 6, 7);
                O[db] = MFMA32(vf, pf, O[db]);
            }
        }
}
template <bool MASKED> __device__ __forceinline__ void softmax2(f32x16 (&ST)[2], unsigned vm, bool rowon, float& m_run, float& l_run, f32x16 (&O)[2]) {
    float mx = -1e30f;
    if (MASKED) {
#pragma unroll
        for (int kb = 0; kb < 2; ++kb)
#pragma unroll
            for (int i = 0; i < 16; ++i) { const bool v = (vm >> (16 * kb + i)) & 1u; mx = fmaxf(mx, v ? ST[kb][i] : -1e30f); }
    } else {
#pragma unroll
        for (int kb = 0; kb < 2; ++kb)
#pragma unroll
            for (int i = 0; i < 16; i += 2) mx = max3f(mx, ST[kb][i], ST[kb][i + 1]);
        mx = rowon ? mx : -1e30f;
    }
    if (__any(mx > m_run + 8.0f)) {
        const float mo = fmaxf(mx, __shfl_xor(mx, 32));
        const float m_new = fmaxf(m_run, mo);
        const float alpha = ex2(m_run - m_new);
        l_run *= alpha; m_run = m_new;
#pragma unroll
        for (int db = 0; db < 2; ++db) O[db] = O[db] * alpha;
    }
    float rs0 = 0.f, rs1 = 0.f;
    if (MASKED) {
#pragma unroll
        for (int kb = 0; kb < 2; ++kb)
#pragma unroll
            for (int i = 0; i < 16; ++i) { const bool v = (vm >> (16 * kb + i)) & 1u; const float p = v ? ex2(ST[kb][i] - m_run) : 0.f; ST[kb][i] = p; rs0 += p; }
    } else {
        const float m_use = rowon ? m_run : __builtin_inff();
#pragma unroll
        for (int kb = 0; kb < 2; ++kb)
#pragma unroll
            for (int i = 0; i < 16; i += 2) { const float p0 = ex2(ST[kb][i] - m_use), p1 = ex2(ST[kb][i + 1] - m_use); ST[kb][i] = p0; ST[kb][i + 1] = p1; rs0 += p0; rs1 += p1; }
    }
    l_run += rs0 + rs1;
}

template <int MODE> __device__ __forceinline__ void attn_branch(const bf16_t* Kg, const bf16_t* Vg, int ldv, int kt0, int kt1, const bf16x8 (&Qf)[4], int t, int qb, unsigned long long mysel,
                                                                float& m_run, float& l_run, float inv_l, f32x16 (&O)[2], LAS float* psw, LAS unsigned char* stage, int tid, int r, int h,
                                                                u32x4& kreg, u32x4& vreg, bool pre, const bf16_t* nK, const bf16_t* nV, int nldv) {
    const int srow = tid >> 3, sch = tid & 7;
    const bf16_t* kp = Kg + (size_t)kt0 * 4096 + srow * 64 + sch * 8;
    const bf16_t* vp = Vg + (size_t)srow * ldv + (size_t)kt0 * 64 + sch * 8;
    if (!pre) { kreg = *(const u32x4*)kp; if (MODE != 0) vreg = *(const u32x4*)vp; }
    const unsigned kw_off = srow * 144 + sch * 16, vw_off = srow * 136 + sch * 16;
    const unsigned kr_off = r * 144 + h * 16, vr_off = r * 136 + h * 8;
    const int nmax = (t >= 31) ? ((t - 31) >> 4) : -1;
    __syncthreads();
    *(LAS u32x4*)(stage + kw_off) = kreg;
    if (MODE != 0) { *(LAS u32x2*)(stage + KB_BYTES + vw_off) = (u32x2){vreg.x, vreg.y}; *(LAS u32x2*)(stage + KB_BYTES + vw_off + 8) = (u32x2){vreg.z, vreg.w}; }
    __syncthreads();
    for (int kt = kt0; kt <= kt1; ++kt) {
        const int cur = (kt - kt0) & 1;
        if (kt < kt1) { kp += 4096; kreg = *(const u32x4*)kp; if (MODE != 0) { vp += 64; vreg = *(const u32x4*)vp; } }
        else if (nK) { kreg = *(const u32x4*)(nK + srow * 64 + sch * 8); if (nV) vreg = *(const u32x4*)(nV + (size_t)srow * nldv + sch * 8); }
        const LAS unsigned char* kb_ = stage + cur * STG_BYTES; const LAS unsigned char* vb_ = kb_ + KB_BYTES;
        bool selb = true, active = true;
        if (MODE == 2) { selb = (mysel >> kt) & 1ull; active = (__ballot(selb) != 0ull); }
        if (active) {
            f32x16 ST[2]; qk_lds(kb_, kr_off, Qf, ST);
            if (MODE == 0) {
                unsigned vm = 0u;
#pragma unroll
                for (int kb = 0; kb < 2; ++kb)
#pragma unroll
                    for (int i = 0; i < 16; ++i) { const int n = 64 * kt + 32 * kb + crow16(i, h); if (n <= nmax) vm |= 1u << (16 * kb + i); }
                softmax2<true>(ST, vm, true, m_run, l_run, O);
            } else if (MODE == 1) {
#pragma unroll
                for (int kb = 0; kb < 2; ++kb)
#pragma unroll
                    for (int i = 0; i < 16; ++i) {
                        const int n = 64 * kt + 32 * kb + crow16(i, h);
                        const float p = (n <= nmax) ? ex2(ST[kb][i] - m_run) * inv_l : 0.f; ST[kb][i] = p;
                        const float ps = xor16_add(xor8_add(p));
                        if (r < 8) psw[r * 256 + n] = ps;
                    }
                pv_lds(vb_, vr_off, ST, O);
            } else {
                const bool edge = (MODE == 2) ? (kt == qb) : (kt == qb || kt == qb - 8);
                if (edge) {
                    unsigned vm = 0u;
#pragma unroll
                    for (int kb = 0; kb < 2; ++kb)
#pragma unroll
                        for (int i = 0; i < 16; ++i) {
                            const int kp_ = 64 * kt + 32 * kb + crow16(i, h);
                            const bool v = (MODE == 2) ? (selb && kp_ <= t) : (kp_ <= t && kp_ + 512 > t);
                            if (v) vm |= 1u << (16 * kb + i);
                        }
                    softmax2<true>(ST, vm, true, m_run, l_run, O);
                } else {
                    softmax2<false>(ST, 0u, selb, m_run, l_run, O);
                }
                pv_lds(vb_, vr_off, ST, O);
            }
        }
        if (kt < kt1) {
            LAS unsigned char* nb = stage + (cur ^ 1) * STG_BYTES;
            *(LAS u32x4*)(nb + kw_off) = kreg;
            if (MODE != 0) { *(LAS u32x2*)(nb + KB_BYTES + vw_off) = (u32x2){vreg.x, vreg.y}; *(LAS u32x2*)(nb + KB_BYTES + vw_off + 8) = (u32x2){vreg.z, vreg.w}; }
        }
        __syncthreads();
    }
}

__device__ void nsa_attn_phase(const bf16_t* Q, const bf16_t* KV, const bf16_t* KCMP, const bf16_t* VCMPT, const float* gates, bf16_t* AO, LAS unsigned char* lds) {
    const int tid = otid(), wid = tid >> 6, lane = tid & 63, r = lane & 31, h = lane >> 5;
    LAS float* psw = (LAS float*)lds + wid * 2048;
    LAS unsigned long long* selw = (LAS unsigned long long*)(lds + 65536) + wid * 8;
    LAS unsigned char* stage = lds + ATT_STAGE_OFF;
    if (wid < 4) __builtin_amdgcn_s_setprio(2);
    const int G = ogdim();
    for (int idx = obid(); idx < 2048; idx += G) {
        const int vb = idx & 255, jj = idx >> 8;
        const int xcd = vb & 7, slot = vb >> 3;
        const int bg = xcd * 4 + (slot >> 3), kq = slot & 7;
        const int qb = (jj & 1) ? (16 * (jj >> 1) + 15 - kq) : (16 * (jj >> 1) + kq);
        const int b = bg >> 2, g = bg & 3;
        const int head = g * 4 + (r >> 3);
        const int tok = wid * 8 + (r & 7);
        const int t = qb * 64 + tok;
        const size_t rowg = (size_t)b * 4096 + t;
        bf16x8 Qf[4];
        { const bf16_t* qp = Q + ((size_t)(b * 16 + head) * 4096 + t) * 64 + 8 * h;
#pragma unroll
          for (int s = 0; s < 4; ++s) Qf[s] = *(const bf16x8*)(qp + 16 * s); }
        f32x16 OUT[2];
#pragma unroll
        for (int i = 0; i < 32; ++i) psw[lane + 64 * i] = 0.f;
        {
            const bf16_t* Kc = KCMP + (size_t)bg * 256 * 64; const bf16_t* Vc = VCMPT + (size_t)bg * 64 * 256;
            int ntc = ((4 * qb + 2) >> 6) + 1; if (ntc > 4) ntc = 4;
            float m_run = -1e30f, l_run = 0.f;
            f32x16 O[2]; O[0] = zero16(); O[1] = zero16();
            u32x4 kst = {0u, 0u, 0u, 0u}, vst = {0u, 0u, 0u, 0u};
            attn_branch<0>(Kc, Vc, 256, 0, ntc - 1, Qf, t, qb, 0ull, m_run, l_run, 0.f, O, psw, stage, tid, r, h, kst, vst, false, Kc, Vc, 256);
            l_run += __shfl_xor(l_run, 32);
            const float inv_l = l_run > 0.f ? __builtin_amdgcn_rcpf(l_run) : 0.f;
            attn_branch<1>(Kc, Vc, 256, 0, ntc - 1, Qf, t, qb, 0ull, m_run, l_run, inv_l, O, psw, stage, tid, r, h, kst, vst, true, nullptr, nullptr, 0);
            const float g_c = gates[rowg * 48 + head];
#pragma unroll
            for (int db = 0; db < 2; ++db) OUT[db] = O[db] * g_c;
        }
        __syncthreads();
        if (qb < 16) { if (lane < 8) selw[lane] = (2ull << qb) - 1ull; }
        else
        for (int tk = 0; tk < 8; ++tk) {
            const int mblk = lane;
            float imp = 0.f;
#pragma unroll
            for (int j = -1; j <= 3; ++j) { const int n = 4 * mblk + j; if (n >= 0) imp += psw[tk * 256 + n]; }
            if (mblk == 0 || mblk == qb || mblk == qb - 1) imp = 1e9f;
            if (mblk > qb) imp = -1e30f;
            int rank = 0;
#pragma unroll 8
            for (int mp = 0; mp < 64; ++mp) { const float o = __int_as_float(__builtin_amdgcn_readlane(__float_as_int(imp), mp)); rank += (o > imp || (o == imp && mp < mblk)) ? 1 : 0; }
            unsigned long long msk = __ballot(rank < 16);
            msk &= (qb >= 63) ? ~0ull : ((2ull << qb) - 1ull);
            if (lane == 0) selw[tk] = msk;
        }
        __syncthreads();
        const unsigned long long mysel = selw[r & 7];
#pragma unroll
        for (int db = 0; db < 2; ++db)
#pragma unroll
            for (int i = 0; i < 16; ++i) psw[(db * 16 + i) * 64 + lane] = OUT[db][i];
        u32x4 kst2 = {0u, 0u, 0u, 0u}, vst2 = {0u, 0u, 0u, 0u};
        {
            const bf16_t* Ks = KV + 2 * KVSZ + (size_t)bg * 4096 * 64; const bf16_t* Vs = KV + 3 * KVSZ + (size_t)bg * 64 * 4096;
            float m_run = -1e30f, l_run = 0.f; f32x16 O[2]; O[0] = zero16(); O[1] = zero16();
            attn_branch<2>(Ks, Vs, 4096, 0, qb, Qf, t, qb, mysel, m_run, l_run, 0.f, O, psw, stage, tid, r, h, kst2, vst2, false,
                           KV + 4 * KVSZ + (size_t)bg * 4096 * 64 + (size_t)(qb > 8 ? qb - 8 : 0) * 4096, KV + 5 * KVSZ + (size_t)bg * 64 * 4096 + (size_t)(qb > 8 ? qb - 8 : 0) * 64, 4096);
            l_run += __shfl_xor(l_run, 32);
            const float sc = (l_run > 0.f ? __builtin_amdgcn_rcpf(l_run) : 0.f) * gates[rowg * 48 + 16 + head];
#pragma unroll
            for (int db = 0; db < 2; ++db)
#pragma unroll
                for (int i = 0; i < 16; ++i) psw[(db * 16 + i) * 64 + lane] += O[db][i] * sc;
        }
        {
            const bf16_t* Kw = KV + 4 * KVSZ + (size_t)bg * 4096 * 64; const bf16_t* Vw = KV + 5 * KVSZ + (size_t)bg * 64 * 4096;
            float m_run = -1e30f, l_run = 0.f; f32x16 O[2]; O[0] = zero16(); O[1] = zero16();
            attn_branch<3>(Kw, Vw, 4096, (qb > 8 ? qb - 8 : 0), qb, Qf, t, qb, 0ull, m_run, l_run, 0.f, O, psw, stage, tid, r, h, kst2, vst2, true, nullptr, nullptr, 0);
            l_run += __shfl_xor(l_run, 32);
            const float sc = (l_run > 0.f ? __builtin_amdgcn_rcpf(l_run) : 0.f) * gates[rowg * 48 + 32 + head];
#pragma unroll
            for (int db = 0; db < 2; ++db)
#pragma unroll
                for (int i = 0; i < 16; ++i) OUT[db][i] = psw[(db * 16 + i) * 64 + lane] + O[db][i] * sc;
        }
        {
            bf16_t* op = AO + rowg * 1024 + head * 64;
#pragma unroll
            for (int db = 0; db < 2; ++db)
#pragma unroll
                for (int q4 = 0; q4 < 4; ++q4) {
                    u32x2 w; w.x = pk_bf16(OUT[db][4 * q4 + 0], OUT[db][4 * q4 + 1]); w.y = pk_bf16(OUT[db][4 * q4 + 2], OUT[db][4 * q4 + 3]);
                    *(u32x2*)(op + 32 * db + 8 * q4 + 4 * h) = w;
                }
        }
    }
    __builtin_amdgcn_s_setprio(0);
    __syncthreads();
}


__device__ void sgu_spatial_phase(const bf16_t* UV, const float* lng, const float* lnb, const bf16_t* SWS, const float* bs, bf16_t* GATED, LAS unsigned char* lds) {
    constexpr int LDV = 136;
    LAS bf16_t* vnT = (LAS bf16_t*)lds;
    LAS float* mu = (LAS float*)(lds + 128 * LDV * 2); LAS float* rsd = mu + 128;
    const int tid = otid(), wid = tid >> 6, lane = tid & 63, r = lane & 31, h = lane >> 5;
    for (int cn = obid(); cn < 256; cn += ogdim()) {
        const size_t tok0 = (size_t)cn * 128;
        __syncthreads();
#pragma unroll 4
        for (int rr = 0; rr < 16; ++rr) {
            const int sl = wid * 16 + rr;
            const u32x4* vp = (const u32x4*)(UV + (tok0 + sl) * 2048 + 1024);
            float s1 = 0.f, s2 = 0.f;
#pragma unroll
            for (int i = 0; i < 2; ++i) { const u32x4 w = vp[lane + 64 * i];
#pragma unroll
                for (int j = 0; j < 4; ++j) { const float a = __uint_as_float(w[j] << 16), c = __uint_as_float(w[j] & 0xffff0000u); s1 += a + c; s2 += a * a + c * c; } }
#pragma unroll
            for (int o = 32; o >= 1; o >>= 1) { s1 += __shfl_xor(s1, o); s2 += __shfl_xor(s2, o); }
            const float mean = s1 * (1.0f / 1024.0f); const float var = fmaxf(s2 * (1.0f / 1024.0f) - mean * mean, 0.f);
            if (lane == 0) { mu[sl] = mean; rsd[sl] = rsqrtf(var + 1e-5f); }
        }
        __syncthreads();
        for (int g = 0; g < 8; ++g) {
            {
                const int sl = tid >> 2, cq = tid & 3;
                const float mean = mu[sl], rs = rsd[sl];
                const bf16_t* vp = UV + (tok0 + sl) * 2048 + 1024 + g * 128 + cq * 32;
#pragma unroll
                for (int i = 0; i < 4; ++i) {
                    const u32x4 w = *(const u32x4*)(vp + i * 8);
                    const int c0 = cq * 32 + i * 8;
                    const f32x4 ga = *(const f32x4*)(lng + g * 128 + c0), gb = *(const f32x4*)(lng + g * 128 + c0 + 4);
                    const f32x4 ba = *(const f32x4*)(lnb + g * 128 + c0), bb = *(const f32x4*)(lnb + g * 128 + c0 + 4);
#pragma unroll
                    for (int j = 0; j < 4; ++j) {
                        const float a = __uint_as_float(w[j] << 16), c = __uint_as_float(w[j] & 0xffff0000u);
                        const float gA = (2 * j < 4) ? ga[(2 * j) & 3] : gb[(2 * j) & 3], gB = (2 * j + 1 < 4) ? ga[(2 * j + 1) & 3] : gb[(2 * j + 1) & 3];
                        const float bA = (2 * j < 4) ? ba[(2 * j) & 3] : bb[(2 * j) & 3], bB = (2 * j + 1 < 4) ? ba[(2 * j + 1) & 3] : bb[(2 * j + 1) & 3];
                        vnT[(c0 + 2 * j) * LDV + sl] = f2bf((a - mean) * rs * gA + bA);
                        vnT[(c0 + 2 * j + 1) * LDV + sl] = f2bf((c - mean) * rs * gB + bB);
                    }
                }
            }
            __syncthreads();
            const int tb = wid & 3, ch = wid >> 2;
            f32x16 acc[2]; acc[0] = zero16(); acc[1] = zero16();
            const bf16_t* wsp = SWS + ((size_t)g * 128 + tb * 32 + r) * 128 + 8 * h;
            for (int ks = 0; ks <= 2 * tb + 1; ++ks) {
                const bf16x8 bfrag = *(const bf16x8*)(wsp + 16 * ks);
#pragma unroll
                for (int cb = 0; cb < 2; ++cb) {
                    const bf16x8 afrag = *(const LAS bf16x8*)(vnT + (ch * 64 + cb * 32 + r) * LDV + 16 * ks + 8 * h);
                    acc[cb] = MFMA32(afrag, bfrag, acc[cb]);
                }
            }
            const int tl = tb * 32 + r; const size_t token = tok0 + tl;
            const float bias = bs[g * 128 + tl];
#pragma unroll
            for (int cb = 0; cb < 2; ++cb)
#pragma unroll
                for (int q4 = 0; q4 < 4; ++q4) {
                    const int c0 = g * 128 + ch * 64 + cb * 32 + 8 * q4 + 4 * h;
                    const u32x2 uw = *(const u32x2*)(UV + token * 2048 + c0);
                    const float u0 = __uint_as_float(uw.x << 16), u1 = __uint_as_float(uw.x & 0xffff0000u), u2 = __uint_as_float(uw.y << 16), u3 = __uint_as_float(uw.y & 0xffff0000u);
                    u32x2 w; w.x = pk_bf16(u0 * (acc[cb][4 * q4 + 0] + bias), u1 * (acc[cb][4 * q4 + 1] + bias)); w.y = pk_bf16(u2 * (acc[cb][4 * q4 + 2] + bias), u3 * (acc[cb][4 * q4 + 3] + bias));
                    *(u32x2*)(GATED + token * 1024 + c0) = w;
                }
            __syncthreads();
        }
    }
    __syncthreads();
}

__device__ void pool_diff_phase(const float* __restrict__ Z, bf16_t* __restrict__ Dd) {
    const size_t gtid = (size_t)obid() * 512 + otid(), gsz = (size_t)ogdim() * 512;
    for (size_t idx = gtid; idx < (size_t)256 * 1024; idx += gsz) {
        const int c4 = (int)(idx & 255), seg = (int)(idx >> 8);
        const int t0 = seg * 32, s0 = t0 & 4095; const int w = 2 << (c4 >> 6);
        const f32x4* zp = (const f32x4*)Z + c4;
        f32x4 S = {0.f, 0.f, 0.f, 0.f};
        const int jlo = (s0 - w > 0) ? (s0 - w) : 0;
        for (int j = jlo; j < s0; ++j) S = S + zp[(size_t)(t0 - s0 + j) * 256];
#pragma unroll 8
        for (int i = 0; i < 32; ++i) {
            const int s = s0 + i; const f32x4 zt = zp[(size_t)(t0 + i) * 256];
            S = S + zt; if (s - w >= 0) S = S - zp[(size_t)(t0 + i - w) * 256];
            const float inv = 1.0f / (float)((s + 1 < w) ? (s + 1) : w);
            const f32x4 d = S * inv - zt;
            u32x2 o; o.x = pk_bf16(d[0], d[1]); o.y = pk_bf16(d[2], d[3]);
            *(u32x2*)(Dd + (size_t)(t0 + i) * 1024 + c4 * 4) = o;
        }
    }
}

#define XB_TMO      128
#define XB_XCNT(j)  (256  + 64 * (j))
#define XB_XSUB(j)  (1280 + 64 * (j))
#define XB_XGEN(j)  (2304 + 64 * (j))
#define XB_TOP      3328
#define XB_TOPGEN   3392
#define XCD_BAR_WORDS 3456
#define XB_SPIN_CAP (1u << 18)

__device__ __forceinline__ unsigned xb_ld(unsigned* p)              { return __hip_atomic_load(p, __ATOMIC_RELAXED, __HIP_MEMORY_SCOPE_AGENT); }
__device__ __forceinline__ unsigned xb_add(unsigned* p, unsigned v) { return __hip_atomic_fetch_add(p, v, __ATOMIC_RELAXED, __HIP_MEMORY_SCOPE_AGENT); }
__device__ __forceinline__ unsigned xb_xcc_id() { return (unsigned)__builtin_amdgcn_s_getreg((3 << 11) | 20) & 0xFu; }
#define XB_SPIN(cond, bar) do { unsigned _sp = 0; while (cond) { __builtin_amdgcn_s_sleep(1); \
    if ((++_sp & 255u) == 0u) { if (xb_ld(&(bar)[XB_TMO])) break; if (_sp > XB_SPIN_CAP) { atomicAdd(&(bar)[XB_TMO], 1u); break; } } } } while (0)

struct XcdBarrier {
    unsigned* bar; unsigned x;
    volatile LAS unsigned* st;
};

__device__ __forceinline__ XcdBarrier xcd_barrier_post(unsigned* bar, volatile LAS unsigned* st) {
    XcdBarrier b; b.bar = bar; b.x = xb_xcc_id(); b.st = st;
    if (threadIdx.x == 0) (void)xb_add(&bar[XB_XCNT(b.x)], 1u);
    return b;
}
__device__ __forceinline__ void xcd_barrier_complete(unsigned* bar, unsigned x, unsigned& nloc, unsigned& nx) {
    const unsigned G = gridDim.x * gridDim.y * gridDim.z;
    unsigned sum, cnt, mine, sp = 0u;
    for (;;) {
        sum = 0u; cnt = 0u; mine = 0u;
#pragma unroll
        for (unsigned j = 0; j < 16; ++j) { const unsigned c = xb_ld(&bar[XB_XCNT(j)]); sum += c; cnt += (c > 0u) ? 1u : 0u; mine = (j == x) ? c : mine; }
        if (sum == G) break;
        __builtin_amdgcn_s_sleep(1);
        if ((++sp & 255u) == 0u) { if (xb_ld(&bar[XB_TMO])) break; if (sp > XB_SPIN_CAP) { atomicAdd(&bar[XB_TMO], 1u); break; } }
    }
    nloc = mine > 0u ? mine : 1u; nx = cnt > 0u ? cnt : 1u;
}

__device__ __forceinline__ void xcd_barrier(const XcdBarrier& b) {
    asm volatile("s_waitcnt vmcnt(0)" ::: "memory");
    __syncthreads();
    if (threadIdx.x == 0) {
        unsigned* bar = b.bar;
        __builtin_amdgcn_s_waitcnt(0);
        unsigned nloc = b.st[0], nx = b.st[1];
        if (nloc == 0u) { xcd_barrier_complete(bar, b.x, nloc, nx); b.st[0] = nloc; b.st[1] = nx; }
        const unsigned old = xb_add(&bar[XB_XSUB(b.x)], 1u);
        const unsigned gen = old / nloc;
        if (old + 1u == (gen + 1u) * nloc) {
            __builtin_amdgcn_fence(__ATOMIC_RELEASE, "agent");
            asm volatile("s_waitcnt vmcnt(0)" ::: "memory");
            const unsigned og = xb_add(&bar[XB_TOP], 1u);
            const unsigned tg = og / nx;
            if (og + 1u == (tg + 1u) * nx) xb_add(&bar[XB_TOPGEN], 1u);
            else XB_SPIN(xb_ld(&bar[XB_TOPGEN]) == tg, bar);
            __builtin_amdgcn_fence(__ATOMIC_ACQUIRE, "agent");
            xb_add(&bar[XB_XGEN(b.x)], 1u);
            asm volatile("s_waitcnt vmcnt(0)" ::: "memory");
        } else {
            XB_SPIN(xb_ld(&bar[XB_XGEN(b.x)]) == gen, bar);
            __builtin_amdgcn_fence(__ATOMIC_ACQUIRE, "agent");
            asm volatile("s_waitcnt vmcnt(0)" ::: "memory");
        }
    }
    __syncthreads();
}

constexpr int NPH = 25;
__constant__ unsigned char PROG[NPH][2] = {
    {0, 0},
    {3, 0}, {4, 0}, {5, 0}, {6, 0}, {7, 0}, {13, 0}, {14, 0},
    {8, 1}, {9, 1}, {7, 1}, {13, 1}, {14, 1},
    {10, 2}, {11, 2}, {7, 2}, {13, 2}, {14, 2},
    {3, 3}, {4, 3}, {5, 3}, {6, 3}, {7, 3}, {13, 3}, {14, 3},
};
__global__ void __launch_bounds__(512, 2) fwd_megakernel(Params P) {
    extern __shared__ __attribute__((aligned(16))) unsigned char lds_raw[];
    LAS unsigned char* lds = (LAS unsigned char*)lds_raw;
    cg::grid_group grid = cg::this_grid();
    { volatile LAS unsigned* st0 = (volatile LAS unsigned*)(lds + 131072); if (threadIdx.x == 0) { st0[0] = 0u; st0[1] = 0u; } __syncthreads(); }
    (void)xcd_barrier_post((unsigned*)(P.ws + WS_BAR), (volatile LAS unsigned*)(lds + 131072));
    prologue_phase(P, lds);
    if (obid() == 0 && otid() == 0) {
        const float** tb = (const float**)(P.ws + WS_TBL);
        tb[0] = P.x; tb[1] = P.mix_norm; tb[2] = P.ffn_norm; tb[3] = P.final_norm; tb[4] = P.nsa_cmp_k_w2; tb[5] = P.nsa_cmp_v_w2;
        tb[6] = P.sgu_ln_g; tb[7] = P.sgu_ln_b; tb[8] = P.sgu_b_s; tb[9] = P.pool_scale;
    }
    grid.sync();
    unsigned char* const ws_k = P.ws; float* const out_k = P.out;
#pragma unroll 1
    for (int ph = 1; ph <= NPH; ++ph) {
        const int type = (ph < NPH) ? (int)PROG[ph][0] : 15, layer = (ph < NPH) ? (int)PROG[ph][1] : 0;
        unsigned char* ws = ws_k; asm volatile("" : "+s"(ws));
        const float* const* tb = (const float* const*)(ws + WS_TBL);
        bf16_t* H = (bf16_t*)(ws + WS_H);
        bf16_t* BIG = (bf16_t*)(ws + WS_BIG);
        bf16_t* H2 = (bf16_t*)(ws + WS_H2);
        float* RSS = (float*)(ws + WS_RSS);
        const float* rss_in = RSS + (size_t)((layer == 0) ? 7 : (2 * layer - 1)) * MTOK * 16;
        bf16_t* XB = H2;
        float* X = out_k; asm volatile("" : "+s"(X));
        const int kind = layer % 3, j = layer / 3;
        switch (type) {
        case 15: final_norm_phase(XB, tb[3], X); break;
        case 3: { if (obid() == 0) cbias_reduce(ws, j);
                  EpiNsaIn E; E.Q = BIG; E.KV = BIG + (size_t)MTOK * 1024; E.gates = (float*)(ws + WS_GATES); E.cs = (const float*)(ws + WS_CS); E.rss = rss_in;
                  run_gemm(lds, XB, 1024, (const bf16_t*)(ws + WS_NWIN) + (size_t)j * NSA_NP * 1024, MTOK, 2560, 1024, E); } break;
        case 4: if (obid() >= 64) {
                  EpiGates E; E.gates = (float*)(ws + WS_GATES); E.rss = rss_in;
                  pg8::Gemm g; g.A = XB; g.Bt = (const bf16_t*)(ws + WS_NWIN) + (size_t)j * NSA_NP * 1024; g.M = MTOK; g.N = NSA_NP; g.K = 1024; g.lda = 1024; g.acs = 0;
                  GateOrder S; S.G = ogdim() - 64; S.c = obid() - 64;
                  pg8::gemm_phase<EpiGates, GateOrder, false>(lds, g, S, E, nullptr);
                } else { EpiBf16<2> E; E.O = (bf16_t*)(ws + WS_CH); E.ldc = 256; E.aux = (const float*)(ws + WS_CBIAS) + j * 512; E.rss = nullptr;
                  pg8::Gemm g; g.A = BIG + (size_t)MTOK * 1024; g.Bt = (const bf16_t*)(ws + WS_CW1) + (size_t)j * 512 * 2048; g.M = 16384; g.N = 512; g.K = 2048; g.lda = 1024; g.acs = 0;
                  CmpOrder S; S.G = ogdim(); S.c = obid();
                  pg8::gemm_phase<EpiBf16<2>, CmpOrder, false>(lds, g, S, E, nullptr); } break;
        case 5: if (obid() < 64) cmp2_local((const bf16_t*)(ws + WS_CH), (const bf16_t*)(ws + WS_W2T) + (size_t)j * 2 * 64 * 256, (bf16_t*)(ws + WS_KCMP), (bf16_t*)(ws + WS_VCMPT), obid()); break;
        case 6: nsa_attn_phase(BIG, BIG + (size_t)MTOK * 1024, (const bf16_t*)(ws + WS_KCMP), (const bf16_t*)(ws + WS_VCMPT), (const float*)(ws + WS_GATES), H, lds); break;
        case 7: case 14: {
                  EpiResid E; E.XB = XB;
                  if (type == 7) E.rss = RSS + (size_t)(2 * layer) * MTOK * 16; else E.rss = (layer < 3) ? RSS + (size_t)(2 * layer + 1) * MTOK * 16 : nullptr;
                  const bf16_t* A = H; int K = 1024; const bf16_t* Bt;
                  if (type == 14) { A = BIG; K = FH; Bt = (const bf16_t*)(ws + WS_WDN) + (size_t)layer * 1024 * FH; }
                  else if (kind == 0) Bt = (const bf16_t*)(ws + WS_NWOUT) + (size_t)j * 1024 * 1024;
                  else if (kind == 1) Bt = (const bf16_t*)(ws + WS_SWOUT);
                  else Bt = (const bf16_t*)(ws + WS_PWOUT);
                  run_gemm(lds, A, K, Bt, MTOK, 1024, K, E); } break;
        case 8: { EpiBf16<0> E; E.O = BIG; E.ldc = 2048; E.aux = nullptr; E.rss = rss_in;
                  run_gemm(lds, XB, 1024, (const bf16_t*)(ws + WS_SWIN), MTOK, 2048, 1024, E); } break;
        case 9: sgu_spatial_phase(BIG, tb[6], tb[7], (const bf16_t*)(ws + WS_SWS), tb[8], H, lds); break;
        case 10: { EpiF32 E; E.C = (float*)BIG; E.rss = rss_in;
                  run_gemm(lds, XB, 1024, (const bf16_t*)(ws + WS_PWIN), MTOK, 1024, 1024, E); } break;
        case 11: pool_diff_phase((const float*)BIG, H); break;
        case 12: { EpiBf16<1> E; E.O = BIG; E.ldc = 1024; E.aux = tb[9]; E.rss = nullptr;
                  int kk = 256; asm volatile("" : "+s"(kk));
                  run_gemm(lds, H, 1024, (const bf16_t*)(ws + WS_PGRP), MTOK, 1024, kk, E, 512); } break;
        case 13: { EpiGU E; E.HID = BIG; E.rss = RSS + (size_t)(2 * layer) * MTOK * 16;
                  run_gemm(lds, XB, 1024, (const bf16_t*)(ws + WS_WGU) + (size_t)layer * 5632 * 1024, MTOK, 5632, 1024, E); } break;
        default: break;
        }
        if (ph < NPH && type != 4) { XcdBarrier xb; xb.bar = (unsigned*)(ws + WS_BAR); xb.x = xb_xcc_id(); xb.st = (volatile LAS unsigned*)(lds + 131072); xcd_barrier(xb); }
    }
}

extern "C" void kernel_launch(void* const* d_in, const int* in_sizes, int n_in, void* d_out, int out_size, void* d_ws, size_t ws_size, hipStream_t stream) {
    static int grid_blocks = 0;
    if (grid_blocks == 0) {
        if (n_in != 25 || out_size != MTOK * DM || ws_size < WS_END) { fprintf(stderr, "kernel_launch: unexpected shapes (n_in %d, out %d, ws %zu need %zu)\n", n_in, out_size, ws_size, (size_t)WS_END); grid_blocks = -1; return; }
        int dev = 0, cus = 0, per_cu = 0;
        hipGetDevice(&dev);
        hipDeviceGetAttribute(&cus, hipDeviceAttributeMultiprocessorCount, dev);
        if (hipFuncSetAttribute((const void*)fwd_megakernel, hipFuncAttributeMaxDynamicSharedMemorySize, LDS_BYTES) != hipSuccess) { fprintf(stderr, "kernel_launch: hipFuncSetAttribute failed\n"); grid_blocks = -1; return; }
        if (hipOccupancyMaxActiveBlocksPerMultiprocessor(&per_cu, (const void*)fwd_megakernel, 512, LDS_BYTES) != hipSuccess || per_cu < 1) { fprintf(stderr, "kernel_launch: occupancy query gave %d\n", per_cu); per_cu = 1; }
        (void)hipGetLastError();
        grid_blocks = cus * 1;
    }
    if (grid_blocks < 0) return;
    Params p{};
    p.x = (const float*)d_in[0]; p.positions = (const int*)d_in[1]; p.mix_norm = (const float*)d_in[2]; p.ffn_norm = (const float*)d_in[3]; p.final_norm = (const float*)d_in[4];
    p.nsa_w_in = (const float*)d_in[5]; p.nsa_cmp_pos_k = (const float*)d_in[6]; p.nsa_cmp_k_w1 = (const float*)d_in[7]; p.nsa_cmp_k_w2 = (const float*)d_in[8];
    p.nsa_cmp_pos_v = (const float*)d_in[9]; p.nsa_cmp_v_w1 = (const float*)d_in[10]; p.nsa_cmp_v_w2 = (const float*)d_in[11]; p.nsa_w_out = (const float*)d_in[12];
    p.sgu_w_in = (const float*)d_in[13]; p.sgu_ln_g = (const float*)d_in[14]; p.sgu_ln_b = (const float*)d_in[15]; p.sgu_w_s = (const float*)d_in[16]; p.sgu_b_s = (const float*)d_in[17]; p.sgu_w_out = (const float*)d_in[18];
    p.pool_w_in = (const float*)d_in[19]; p.pool_w_grp = (const float*)d_in[20]; p.pool_scale = (const float*)d_in[21]; p.pool_w_out = (const float*)d_in[22];
    p.ffn_w_gate_up = (const float*)d_in[23]; p.ffn_w_down = (const float*)d_in[24];
    p.out = (float*)d_out; p.ws = (unsigned char*)d_ws;
    if (hipMemsetAsync((unsigned char*)d_ws + WS_BAR, 0, 16384, stream) != hipSuccess) { fprintf(stderr, "kernel_launch: memset of barrier words failed\n"); return; }
    void* args[] = {&p};
    hipError_t e = hipLaunchCooperativeKernel((const void*)fwd_megakernel, dim3(grid_blocks), dim3(512), args, LDS_BYTES, stream);
    if (e != hipSuccess) fprintf(stderr, "cooperative launch failed: %s (grid %d)\n", hipGetErrorString(e), grid_blocks);
}
```

```cpp
#include <hip/hip_runtime.h>
#include <hip/hip_cooperative_groups.h>
#include <cstdio>
namespace cg = cooperative_groups;
namespace pg8 {
#define PG8_LAS __attribute__((address_space(3)))
typedef unsigned short bf16_t;
typedef short bf16x8 __attribute__((ext_vector_type(8)));
typedef float f32x4 __attribute__((ext_vector_type(4)));
typedef unsigned u32x4 __attribute__((ext_vector_type(4)));
constexpr int BM = 256, BK = 64, HALF = 128, HTB = HALF * BK * 2  , STAGE_BYTES = 8 * HTB, NXCD = 8, WGM = 8;

__host__ __device__ __forceinline__ int lds_byte(int r, int c) { const int st = (r >> 4) * 2 + (c >> 5), rr = r & 15, cc = c & 31, ob = rr * 64 + cc * 2; return st * 1024 + (ob ^ (((ob >> 9) & 1) << 5)); }
__host__ __device__ __forceinline__ void stage_rc(int b, int& R, int& C) { const int st = b / 1024, sb = b % 1024, swz = sb ^ (((sb >> 9) & 1) << 5); R = (st >> 1) * 16 + swz / 64; C = (st & 1) * 32 + (swz % 64) / 2; }
__host__ __device__ __forceinline__ int perm32(int rho) { const int n = rho >> 4, i = rho & 15; return 8 * (i >> 2) + 4 * n + (i & 3); }

struct Unit { int pm, pn; };
struct Gemm { const bf16_t* A; const bf16_t* Bt; int M, N, K, lda, acs; };

struct StaticOrder {
    int nM, nN, nwg, G, c;
    __host__ __device__ void init(int M, int N, int G_, int c_) { nM = M / BM; nN = N / BM; nwg = nM * nN; G = G_; c = c_; }
    __host__ __device__ bool next(int i, Unit& u) const {
        const long L = (long)i * G + c; if (L >= nwg) return false;
        int wgid = (int)L; { const int q = nwg / NXCD, r = nwg % NXCD, xcd = wgid % NXCD, off = wgid / NXCD; wgid = (xcd < r ? xcd * (q + 1) : r * (q + 1) + (xcd - r) * q) + off; }
        const int nig = WGM * nN, gid = wgid / nig, fm = gid * WGM, gsz = (nM - fm) < WGM ? (nM - fm) : WGM;
        u.pm = fm + ((wgid % nig) % gsz); u.pn = (wgid % nig) / gsz; return true;
    }
    __device__ __forceinline__ void a_ready(const Unit&) const {}
    __device__ __forceinline__ void done(const Unit&) const {}
};
template <class Epi, class Sched, bool STAMP = false>
__device__ __forceinline__ void gemm_phase(PG8_LAS unsigned char* lds, const Gemm g, const Sched& S, const Epi& E, unsigned long long* stamps) {
    int tid_ = threadIdx.x; asm volatile("" : "+v"(tid_)); const int tid = tid_, wid = __builtin_amdgcn_readfirstlane(tid >> 6), lane = tid & 63, wr = wid >> 2, wc = wid & 3, fr = lane & 15, fq = lane >> 4;
    const int K = g.K, nt = K / BK;
    int ts_lo = 0, ts_hi = 0, nts = 0; const unsigned long long rt_entry = STAMP ? (unsigned long long)wall_clock64() : 0ull;
#define PG8_STAMP() do { if (STAMP && wid == 0 && nts < 64) { const unsigned long long _c = (unsigned long long)clock64(); \
        ts_lo = (lane == nts) ? (int)(unsigned)_c : ts_lo; ts_hi = (lane == nts) ? (int)(unsigned)(_c >> 32) : ts_hi; ++nts; } } while (0)
    PG8_STAMP();
    unsigned voffA[2], voffB[2];
#pragma unroll
    for (int i = 0; i < 2; ++i) { int R, C; stage_rc(tid * 16 + i * 8192, R, C); const int Rb = Epi::PERM ? ((R & ~31) + perm32(R & 31)) : R;
        voffA[i] = (unsigned)(R * g.lda + C) * 2u; voffB[i] = (unsigned)(Rb * K + C) * 2u; }
    const size_t kstep = (size_t)(BK * 2);
    const size_t hstep = (size_t)HALF * K * 2;
    const size_t tstep = 2 * hstep; const size_t hstepA = (size_t)HALF * g.lda * 2; const size_t tstepA = 2 * hstepA;
    const unsigned ldsw = (unsigned)wid * 1024u;
    const int aoff = lds_byte(wr * 64 + fr, fq * 8), boff = lds_byte(wc * 32 + fr, fq * 8);
#define PG8_SA(b, h) (((b) * 2 + (h)) * HTB)
#define PG8_SB(b, h) ((4 + (b) * 2 + (h)) * HTB)
#define PG8_STAGE(bufoff, gbase, voff) do { _Pragma("unroll") for (int _i = 0; _i < 2; ++_i) \
        __builtin_amdgcn_global_load_lds((const unsigned*)((const char*)(gbase) + (voff)[_i]), (PG8_LAS unsigned*)(lds + (bufoff) + ldsw + _i * 8192), 16, 0, 0); } while (0)
#define PG8_LDA(dst, b, h) do { _Pragma("unroll") for (int m = 0; m < 4; ++m) _Pragma("unroll") for (int k = 0; k < 2; ++k) dst[m][k] = *(const PG8_LAS bf16x8*)(lds + PG8_SA(b, h) + aoff + m * 2048 + k * 1024); } while (0)
#define PG8_LDB(dst, b, h) do { _Pragma("unroll") for (int n = 0; n < 2; ++n) _Pragma("unroll") for (int k = 0; k < 2; ++k) dst[n][k] = *(const PG8_LAS bf16x8*)(lds + PG8_SB(b, h) + boff + n * 2048 + k * 1024); } while (0)
#define PG8_MMA(ai, bj, At, Bt) do { __builtin_amdgcn_s_setprio(1); _Pragma("unroll") for (int m = 0; m < 4; ++m) _Pragma("unroll") for (int n = 0; n < 2; ++n) _Pragma("unroll") for (int k = 0; k < 2; ++k) \
        acc[ai][bj][m][n] = __builtin_amdgcn_mfma_f32_16x16x32_bf16(Bt[n][k], At[m][k], acc[ai][bj][m][n], 0, 0, 0); __builtin_amdgcn_s_setprio(0); } while (0)
#define PG8_WAIT_V(n) asm volatile("s_waitcnt vmcnt(" #n ")" ::: "memory")
#define PG8_WAIT_L(n) asm volatile("s_waitcnt lgkmcnt(" #n ")" ::: "memory")
#define PG8_BAR __builtin_amdgcn_s_barrier()
#define PG8_SCHED __builtin_amdgcn_sched_barrier(0)
    Unit cur, nxt; int ui = 0;
    if (!S.next(0, cur)) return;
    f32x4 acc[2][2][4][2];
#pragma unroll
    for (int a = 0; a < 2; ++a)
#pragma unroll
        for (int b = 0; b < 2; ++b)
#pragma unroll
            for (int m = 0; m < 4; ++m)
#pragma unroll
                for (int n = 0; n < 2; ++n) acc[a][b][m][n] = (f32x4){0.f, 0.f, 0.f, 0.f};
    bf16x8 At[4][2], B0[2][2], B1[2][2];
    const char* cA = (const char*)g.A + (size_t)cur.pm * tstepA + (size_t)cur.pn * g.acs; const char* cB = (const char*)g.Bt + (size_t)cur.pn * tstep;
    S.a_ready(cur);
    PG8_STAGE(PG8_SB(0, 0), cB, voffB); PG8_STAGE(PG8_SB(0, 1), cB + hstep, voffB); PG8_STAGE(PG8_SA(0, 0), cA, voffA); PG8_STAGE(PG8_SA(0, 1), cA + hstepA, voffA);
    if (wr == 1) PG8_BAR;
    PG8_WAIT_V(2); PG8_BAR;
    PG8_STAGE(PG8_SB(1, 0), cB + kstep, voffB); PG8_STAGE(PG8_SA(1, 0), cA + kstep, voffA); PG8_STAGE(PG8_SB(1, 1), cB + hstep + kstep, voffB);
    PG8_WAIT_V(6); PG8_BAR;
    PG8_STAMP();
    for (;;) {
        const bool has_next = S.next(ui + 1, nxt);
        const char* nA = has_next ? (const char*)g.A + (size_t)nxt.pm * tstepA + (size_t)nxt.pn * g.acs : cA; const char* nB = has_next ? (const char*)g.Bt + (size_t)nxt.pn * tstep : cB;
        for (int t = 0; t < nt; t += 2) {
            const bool last = (t == nt - 2);
            const char* a1 = cA + (size_t)(t + 1) * kstep;
            const char* a2 = last ? nA : cA + (size_t)(t + 2) * kstep; const char* b2 = last ? nB : cB + (size_t)(t + 2) * kstep;
            const char* a3 = a2 + kstep; const char* b3 = b2 + kstep;
            if (last && has_next) S.a_ready(nxt);
            PG8_LDB(B0, 0, 0); PG8_LDB(B1, 0, 1); PG8_SCHED; PG8_LDA(At, 0, 0); PG8_STAGE(PG8_SA(1, 1), a1 + hstepA, voffA);
            PG8_WAIT_V(8); PG8_WAIT_L(0); PG8_BAR; PG8_MMA(0, 0, At, B0); PG8_MMA(0, 1, At, B1); PG8_BAR; PG8_SCHED;
            PG8_LDA(At, 0, 1); PG8_STAGE(PG8_SB(0, 0), b2, voffB); PG8_STAGE(PG8_SB(0, 1), b2 + hstep, voffB); PG8_STAGE(PG8_SA(0, 0), a2, voffA);
            PG8_WAIT_V(8); PG8_WAIT_L(0); PG8_BAR; PG8_MMA(1, 0, At, B0); PG8_MMA(1, 1, At, B1); PG8_BAR; PG8_SCHED;
            PG8_LDB(B0, 1, 0); PG8_LDB(B1, 1, 1); PG8_SCHED; PG8_LDA(At, 1, 0); PG8_STAGE(PG8_SA(0, 1), a2 + hstepA, voffA);
            PG8_WAIT_V(8); PG8_WAIT_L(0); PG8_BAR; PG8_MMA(0, 0, At, B0); PG8_MMA(0, 1, At, B1); PG8_BAR; PG8_SCHED;
            PG8_LDA(At, 1, 1); PG8_STAGE(PG8_SB(1, 0), b3, voffB); PG8_STAGE(PG8_SB(1, 1), b3 + hstep, voffB); PG8_STAGE(PG8_SA(1, 0), a3, voffA);
            PG8_WAIT_V(8); PG8_WAIT_L(0); PG8_BAR; PG8_MMA(1, 0, At, B0); PG8_MMA(1, 1, At, B1); PG8_BAR; PG8_SCHED;
        }
        PG8_STAMP();
        if (wr == 0) PG8_BAR;
        if constexpr (!Epi::AFTER_DRAIN) { E(acc, cur, wr, wc, fr, fq); S.done(cur); }
        PG8_STAMP();
        if (!has_next) break;
#pragma unroll
        for (int a = 0; a < 2; ++a)
#pragma unroll
            for (int b = 0; b < 2; ++b)
#pragma unroll
                for (int m = 0; m < 4; ++m)
#pragma unroll
                    for (int n = 0; n < 2; ++n) acc[a][b][m][n] = (f32x4){0.f, 0.f, 0.f, 0.f};
        cur = nxt; cA = nA; cB = nB; ++ui;
        if (wr == 1) PG8_BAR;
    }
    PG8_WAIT_V(0);
    PG8_BAR;
    if constexpr (Epi::AFTER_DRAIN) { E.fused(acc, cur, wr, wc, fr, fq, lds, wid, lane); S.done(cur); }
    PG8_STAMP();
    if (STAMP && wid == 0) { stamps[lane] = lane < nts ? (((unsigned long long)(unsigned)ts_hi << 32) | (unsigned)ts_lo) : 0ull;
        if (lane == 62) stamps[62] = rt_entry; if (lane == 63) stamps[63] = (unsigned long long)wall_clock64(); }
#undef PG8_STAMP
#undef PG8_SA
#undef PG8_SB
#undef PG8_STAGE
#undef PG8_LDA
#undef PG8_LDB
#undef PG8_MMA
#undef PG8_WAIT_V
#undef PG8_WAIT_L
#undef PG8_BAR
#undef PG8_SCHED
}
}

#define LAS __attribute__((address_space(3)))
typedef unsigned short bf16_t;
typedef short bf16x8 __attribute__((ext_vector_type(8)));
typedef short s16x4 __attribute__((ext_vector_type(4)));
typedef float f32x4 __attribute__((ext_vector_type(4)));
typedef float f32x16 __attribute__((ext_vector_type(16)));
typedef unsigned u32x4 __attribute__((ext_vector_type(4)));
typedef unsigned u32x2 __attribute__((ext_vector_type(2)));
typedef __bf16 bf16x2_t __attribute__((ext_vector_type(2)));
typedef float f32x2_t __attribute__((ext_vector_type(2)));

__device__ __forceinline__ int otid() { int t = threadIdx.x; asm volatile("" : "+v"(t)); return t; }
__device__ __forceinline__ int obid() { int t = blockIdx.x; asm volatile("" : "+s"(t)); return t; }
__device__ __forceinline__ int ogdim() { int t = gridDim.x; asm volatile("" : "+s"(t)); return t; }
constexpr int NB = 8, SEQ = 4096, DM = 1024, MTOK = NB * SEQ;
constexpr int FH = 2816;
constexpr int NSA_IN = 2608, NSA_NP = 2816;
constexpr size_t KVSZ = (size_t)32 * 4096 * 64;
constexpr int LDS_BYTES = 131072 + 16;

__device__ __forceinline__ unsigned pk_bf16(float a, float b) { f32x2_t v = {a, b}; bf16x2_t r = __builtin_convertvector(v, bf16x2_t); return __builtin_bit_cast(unsigned, r); }
__device__ __forceinline__ bf16_t f2bf(float a) { return (bf16_t)(pk_bf16(a, 0.f) & 0xffffu); }
__device__ __forceinline__ float bf2f(unsigned short x) { return __uint_as_float(((unsigned)x) << 16); }
__device__ __forceinline__ float gelu_tanh(float x) { const float y = 0.7978845608f * (x + 0.044715f * x * x * x); return x * __builtin_amdgcn_rcpf(1.0f + __builtin_amdgcn_exp2f(-2.885390082f * y)); }
__device__ __forceinline__ float silu_f(float x) { return x * __builtin_amdgcn_rcpf(1.0f + __builtin_amdgcn_exp2f(-1.442695041f * x)); }
__device__ __forceinline__ float sigmoid_f(float x) { return __builtin_amdgcn_rcpf(1.0f + __builtin_amdgcn_exp2f(-1.442695041f * x)); }

constexpr size_t al256(size_t x) { return (x + 255) & ~(size_t)255; }
constexpr size_t WS_WGU = 0;
constexpr size_t WS_WDN = WS_WGU + (size_t)4 * 5632 * 1024 * 2;
constexpr size_t WS_NWIN = WS_WDN + (size_t)4 * 1024 * 2816 * 2;
constexpr size_t WS_NWOUT = WS_NWIN + (size_t)2 * NSA_NP * 1024 * 2;
constexpr size_t WS_CW1 = WS_NWOUT + (size_t)2 * 1024 * 1024 * 2;
constexpr size_t WS_SWIN = WS_CW1 + (size_t)2 * 512 * 2048 * 2;
constexpr size_t WS_SWOUT = WS_SWIN + (size_t)2048 * 1024 * 2;
constexpr size_t WS_SWS = WS_SWOUT + (size_t)1024 * 1024 * 2;
constexpr size_t WS_PWIN = WS_SWS + (size_t)8 * 128 * 128 * 2;
constexpr size_t WS_PGRP = WS_PWIN + (size_t)1024 * 1024 * 2;
constexpr size_t WS_PWOUT = WS_PGRP + (size_t)1024 * 1024 * 2;
constexpr size_t WS_CBIAS = WS_PWOUT + (size_t)1024 * 1024 * 2;
constexpr size_t WS_CS = WS_CBIAS + 4096;
constexpr size_t WS_GATES = WS_CS + (size_t)MTOK * 16 * 4;
constexpr size_t WS_CH = WS_GATES + (size_t)MTOK * 48 * 4;
constexpr size_t WS_KCMP = WS_CH + (size_t)16384 * 256 * 2;
constexpr size_t WS_VCMPT = WS_KCMP + (size_t)32 * 256 * 64 * 2;
constexpr size_t WS_H = WS_VCMPT + (size_t)32 * 64 * 256 * 2;
constexpr size_t WS_BIG = WS_H + (size_t)MTOK * 1024 * 2;
constexpr size_t WS_TBL = WS_BIG + (size_t)MTOK * 2816 * 2 + 65536;
constexpr size_t WS_CBPART = WS_TBL + 4096;
constexpr size_t WS_W2T = WS_CBPART + (size_t)256 * 256 * 4;
constexpr size_t WS_H2 = WS_W2T + (size_t)4 * 64 * 256 * 2;
constexpr size_t WS_RSS = WS_H2 + (size_t)MTOK * 1024 * 2;
constexpr size_t WS_BAR = WS_RSS + (size_t)8 * MTOK * 16 * 4;
constexpr size_t WS_END = WS_BAR + 16384;

struct Params {
    const float* x; const int* positions; const float* mix_norm; const float* ffn_norm; const float* final_norm;
    const float* nsa_w_in; const float* nsa_cmp_pos_k; const float* nsa_cmp_k_w1; const float* nsa_cmp_k_w2;
    const float* nsa_cmp_pos_v; const float* nsa_cmp_v_w1; const float* nsa_cmp_v_w2; const float* nsa_w_out;
    const float* sgu_w_in; const float* sgu_ln_g; const float* sgu_ln_b; const float* sgu_w_s; const float* sgu_b_s; const float* sgu_w_out;
    const float* pool_w_in; const float* pool_w_grp; const float* pool_scale; const float* pool_w_out;
    const float* ffn_w_gate_up; const float* ffn_w_down;
    float* out; unsigned char* ws;
};


__device__ __forceinline__ float row_rstd(const float* rss, int row) {
    const f32x4* q = (const f32x4*)(rss + (size_t)row * 16);
    const f32x4 s = (q[0] + q[1]) + (q[2] + q[3]);
    return rsqrtf(((s[0] + s[1]) + (s[2] + s[3])) * (1.0f / 1024.0f) + 1e-6f);
}
__device__ __forceinline__ void load_rstd(const float* rss, int row0, float (&rs)[2][4]) {
#pragma unroll
    for (int ai = 0; ai < 2; ++ai)
#pragma unroll
        for (int m = 0; m < 4; ++m) rs[ai][m] = rss ? row_rstd(rss, row0 + ai * 128 + m * 16) : 1.0f;
}
struct EpiResid {
    static constexpr bool PERM = true, AFTER_DRAIN = false;
    bf16_t* XB; float* rss;
    __device__ __forceinline__ void operator()(const f32x4 (&acc)[2][2][4][2], const pg8::Unit& u, int wr, int wc, int fr, int fq) const {
        const int row0 = u.pm * 256 + wr * 64 + fr, col0 = u.pn * 256 + wc * 32 + 8 * fq;
#pragma unroll
        for (int ai = 0; ai < 2; ++ai)
#pragma unroll
            for (int m = 0; m < 4; ++m) {
                const int row = row0 + ai * 128 + m * 16;
                bf16_t* rp = XB + (size_t)row * 1024 + col0;
                float ss = 0.f;
#pragma unroll
                for (int bj = 0; bj < 2; ++bj) {
                    const u32x4 bw = *(const u32x4*)(rp + bj * 128);
                    const f32x4 a0 = acc[ai][bj][m][0], a1 = acc[ai][bj][m][1];
                    float x[8];
                    x[0] = __uint_as_float(bw.x << 16) + a0[0]; x[1] = __uint_as_float(bw.x & 0xffff0000u) + a0[1];
                    x[2] = __uint_as_float(bw.y << 16) + a0[2]; x[3] = __uint_as_float(bw.y & 0xffff0000u) + a0[3];
                    x[4] = __uint_as_float(bw.z << 16) + a1[0]; x[5] = __uint_as_float(bw.z & 0xffff0000u) + a1[1];
                    x[6] = __uint_as_float(bw.w << 16) + a1[2]; x[7] = __uint_as_float(bw.w & 0xffff0000u) + a1[3];
#pragma unroll
                    for (int e = 0; e < 8; ++e) ss += x[e] * x[e];
                    u32x4 w; w.x = pk_bf16(x[0], x[1]); w.y = pk_bf16(x[2], x[3]); w.z = pk_bf16(x[4], x[5]); w.w = pk_bf16(x[6], x[7]);
                    *(u32x4*)(rp + bj * 128) = w;
                }
                if (rss) {
                    ss += __shfl_xor(ss, 16); ss += __shfl_xor(ss, 32);
                    if (fq == 0) rss[(size_t)row * 16 + u.pn * 4 + wc] = ss;
                }
            }
    }
};
struct EpiF32 {
    static constexpr bool PERM = false, AFTER_DRAIN = false;
    float* C; const float* rss;
    __device__ __forceinline__ void operator()(const f32x4 (&acc)[2][2][4][2], const pg8::Unit& u, int wr, int wc, int fr, int fq) const {
        const int row0 = u.pm * 256 + wr * 64 + fr, col0 = u.pn * 256 + wc * 32 + 4 * fq;
        float rs[2][4]; load_rstd(rss, row0, rs);
#pragma unroll
        for (int ai = 0; ai < 2; ++ai)
#pragma unroll
            for (int m = 0; m < 4; ++m) {
                const size_t off = (size_t)(row0 + ai * 128 + m * 16) * 1024 + col0;
#pragma unroll
                for (int bj = 0; bj < 2; ++bj)
#pragma unroll
                    for (int n = 0; n < 2; ++n) *(f32x4*)(C + off + bj * 128 + n * 16) = acc[ai][bj][m][n] * rs[ai][m];
            }
    }
};
struct EpiGU {
    static constexpr bool PERM = true, AFTER_DRAIN = false;
    bf16_t* HID; const float* rss;
    __device__ __forceinline__ void operator()(const f32x4 (&acc)[2][2][4][2], const pg8::Unit& u, int wr, int wc, int fr, int fq) const {
        const int row0 = u.pm * 256 + wr * 64 + fr, col0 = u.pn * 128 + wc * 32 + 8 * fq;
        float rs[2][4]; load_rstd(rss, row0, rs);
#pragma unroll
        for (int ai = 0; ai < 2; ++ai)
#pragma unroll
            for (int m = 0; m < 4; ++m) {
                const float rr = rs[ai][m];
                const f32x4 g0 = acc[ai][0][m][0] * rr, g1 = acc[ai][0][m][1] * rr, u0 = acc[ai][1][m][0] * rr, u1 = acc[ai][1][m][1] * rr;
                u32x4 w;
                w.x = pk_bf16(silu_f(g0[0]) * u0[0], silu_f(g0[1]) * u0[1]); w.y = pk_bf16(silu_f(g0[2]) * u0[2], silu_f(g0[3]) * u0[3]);
                w.z = pk_bf16(silu_f(g1[0]) * u1[0], silu_f(g1[1]) * u1[1]); w.w = pk_bf16(silu_f(g1[2]) * u1[2], silu_f(g1[3]) * u1[3]);
                *(u32x4*)(HID + (size_t)(row0 + ai * 128 + m * 16) * FH + col0) = w;
            }
    }
};
template <int MODE> struct EpiBf16 {
    static constexpr bool PERM = true, AFTER_DRAIN = false;
    bf16_t* O; int ldc; const float* aux; const float* rss;
    __device__ __forceinline__ void operator()(const f32x4 (&acc)[2][2][4][2], const pg8::Unit& u, int wr, int wc, int fr, int fq) const {
        const int row0 = u.pm * 256 + wr * 64 + fr; const int ct = wc * 32 + 8 * fq;
        const int colbase = (MODE == 2) ? 0 : u.pn * 256;
        float rs[2][4]; if (MODE == 0) load_rstd(rss, row0, rs);
        f32x4 av[2][2];
#pragma unroll
        for (int bj = 0; bj < 2; ++bj)
#pragma unroll
            for (int n = 0; n < 2; ++n) av[bj][n] = (MODE == 0) ? (f32x4){0.f, 0.f, 0.f, 0.f} : *(const f32x4*)(aux + u.pn * 256 + ct + bj * 128 + 4 * n);
#pragma unroll
        for (int ai = 0; ai < 2; ++ai)
#pragma unroll
            for (int m = 0; m < 4; ++m) {
                bf16_t* rowp = O + (size_t)(row0 + ai * 128 + m * 16) * ldc + colbase + ct;
#pragma unroll
                for (int bj = 0; bj < 2; ++bj) {
                    f32x4 v0 = acc[ai][bj][m][0], v1 = acc[ai][bj][m][1];
                    if (MODE == 0) { v0 = v0 * rs[ai][m]; v1 = v1 * rs[ai][m]; }
                    if (MODE == 1) { v0 = v0 * av[bj][0]; v1 = v1 * av[bj][1]; }
                    if (MODE == 2) { v0 = v0 + av[bj][0]; v1 = v1 + av[bj][1]; }
                    if (MODE != 1) {
#pragma unroll
                        for (int j = 0; j < 4; ++j) { v0[j] = gelu_tanh(v0[j]); v1[j] = gelu_tanh(v1[j]); }
                    }
                    u32x4 w; w.x = pk_bf16(v0[0], v0[1]); w.y = pk_bf16(v0[2], v0[3]); w.z = pk_bf16(v1[0], v1[1]); w.w = pk_bf16(v1[2], v1[3]);
                    *(u32x4*)(rowp + bj * 128) = w;
                }
            }
    }
};
struct EpiNsaIn {
    static constexpr bool PERM = true, AFTER_DRAIN = false;
    bf16_t* Q; bf16_t* KV; float* gates; const float* cs; const float* rss;
    template <int VAR> __device__ __forceinline__ void variant(const f32x4 (&acc)[2][2][4][2], const pg8::Unit& u, int wr, int wc, int fr, int fq) const {
        const int pn = u.pn; const int jkv = pn - 4;
        const int row0 = u.pm * 256 + wr * 64 + fr;
        const bool rope_w = (VAR <= 1) && ((wc & 1) == 0);
#pragma unroll
        for (int ai = 0; ai < 2; ++ai)
#pragma unroll
            for (int m = 0; m < 4; ++m) {
                const int row = row0 + ai * 128 + m * 16; const int b = row >> 12, s = row & 4095;
                const float rr = rss ? row_rstd(rss, row) : 1.0f;
#pragma unroll
                for (int bj = 0; bj < 2; ++bj) {
                    const int cb = bj * 128 + wc * 32 + fq * 8;
                    f32x4 v0 = acc[ai][bj][m][0] * rr, v1 = acc[ai][bj][m][1] * rr;
                    if (rope_w) {
                        f32x4 p0, p1;
#pragma unroll
                        for (int j = 0; j < 4; ++j) { p0[j] = __shfl_xor(v0[j], 16); p1[j] = __shfl_xor(v1[j], 16); }
                        if (fq < 2) {
                            const f32x4* c4 = (const f32x4*)(cs + (size_t)row * 16);
                            const f32x4 cA = c4[0], cB = c4[1], sA = c4[2], sB = c4[3];
                            if (fq == 0) { v0 = v0 * cA - p0 * sA; v1 = v1 * cB - p1 * sB; }
                            else { v0 = v0 * cA + p0 * sA; v1 = v1 * cB + p1 * sB; }
                        }
                    }
                    const int hh = cb >> 6, d0 = cb & 63;
                    if (VAR == 0) {
                        v0 = v0 * 0.18033688f; v1 = v1 * 0.18033688f;
                        u32x4 w; w.x = pk_bf16(v0[0], v0[1]); w.y = pk_bf16(v0[2], v0[3]); w.z = pk_bf16(v1[0], v1[1]); w.w = pk_bf16(v1[2], v1[3]);
                        *(u32x4*)(Q + ((size_t)(b * 16 + pn * 4 + hh) * 4096 + s) * 64 + d0) = w;
                    } else if (VAR == 1 || VAR == 2) {
                        u32x4 w; w.x = pk_bf16(v0[0], v0[1]); w.y = pk_bf16(v0[2], v0[3]); w.z = pk_bf16(v1[0], v1[1]); w.w = pk_bf16(v1[2], v1[3]);
                        *(u32x4*)(KV + (size_t)jkv * KVSZ + ((size_t)(b * 4 + hh) * 4096 + s) * 64 + d0) = w;
                    } else if (VAR == 3) {
                        bf16_t* tp = KV + (size_t)jkv * KVSZ + ((size_t)(b * 4 + hh) * 64 + d0) * 4096 + s;
#pragma unroll
                        for (int j = 0; j < 4; ++j) { tp[(size_t)j * 4096] = f2bf(v0[j]); tp[(size_t)(j + 4) * 4096] = f2bf(v1[j]); }
                    } else if (cb < 48) {
                        f32x4 g0, g1;
#pragma unroll
                        for (int j = 0; j < 4; ++j) { g0[j] = sigmoid_f(v0[j]); g1[j] = sigmoid_f(v1[j]); }
                        float* gp = gates + (size_t)row * 48 + cb;
                        *(f32x4*)gp = g0; *(f32x4*)(gp + 4) = g1;
                    }
                }
            }
    }
    __device__ __forceinline__ void operator()(const f32x4 (&acc)[2][2][4][2], const pg8::Unit& u, int wr_, int wc_, int fr_, int fq_) const {
        const int pn = u.pn;
        const int t_ = otid(); const int wid_ = __builtin_amdgcn_readfirstlane(t_ >> 6); const int wr = wid_ >> 2, wc = wid_ & 3, fr = t_ & 15, fq = (t_ & 63) >> 4;
        (void)wr_; (void)wc_; (void)fr_; (void)fq_;
        if (pn < 4) variant<0>(acc, u, wr, wc, fr, fq);
        else if (pn == 4 || pn == 6 || pn == 8) variant<1>(acc, u, wr, wc, fr, fq);
        else if (pn == 5) variant<2>(acc, u, wr, wc, fr, fq);
        else if (pn == 7 || pn == 9) variant<3>(acc, u, wr, wc, fr, fq);
        else variant<4>(acc, u, wr, wc, fr, fq);
    }
};
struct EpiGates {
    static constexpr bool PERM = false, AFTER_DRAIN = false;
    float* gates; const float* rss;
    __device__ __forceinline__ void operator()(const f32x4 (&acc)[2][2][4][2], const pg8::Unit& u, int wr, int wc, int fr, int fq) const {
        if (wc > 1) return;
        const int row0 = u.pm * 256 + wr * 64 + fr;
#pragma unroll
        for (int ai = 0; ai < 2; ++ai)
#pragma unroll
            for (int m = 0; m < 4; ++m) {
                const int row = row0 + ai * 128 + m * 16;
                const float rr = rss ? row_rstd(rss, row) : 1.0f;
#pragma unroll
                for (int n = 0; n < 2; ++n) {
                    const int cb = wc * 32 + 16 * n + 4 * fq;
                    if (cb < 48) {
                        const f32x4 v = acc[ai][0][m][n] * rr; f32x4 gsig;
#pragma unroll
                        for (int e = 0; e < 4; ++e) gsig[e] = sigmoid_f(v[e]);
                        *(f32x4*)(gates + (size_t)row * 48 + cb) = gsig;
                    }
                }
            }
    }
};
struct GateOrder {
    int G, c;
    __device__ bool next(int i, pg8::Unit& u) const { const int L = i * G + c; if (L >= 128 || G <= 0) return false; u.pm = L; u.pn = 10; return true; }
    __device__ __forceinline__ void a_ready(const pg8::Unit&) const {}
    __device__ __forceinline__ void done(const pg8::Unit&) const {}
};
struct CmpOrder {
    int G, c;
    __device__ bool next(int i, pg8::Unit& u) const { const int L = i * G + c; if (L >= 64) return false; u.pm = L; u.pn = L >> 5; return true; }
    __device__ __forceinline__ void a_ready(const pg8::Unit&) const {}
    __device__ __forceinline__ void done(const pg8::Unit&) const {}
};

template <class Epi> __device__ __forceinline__ void run_gemm(LAS unsigned char* lds, const bf16_t* A, int lda, const bf16_t* Bt, int M, int N, int K, const Epi& E, int acs = 0) {
    pg8::Gemm g; g.A = A; g.Bt = Bt; g.M = M; g.N = N; g.K = K; g.lda = lda; g.acs = acs;
    pg8::StaticOrder S; S.init(M, N, ogdim(), obid());
    pg8::gemm_phase<Epi, pg8::StaticOrder, false>(lds, g, S, E, nullptr);
}

struct TJob { const float* src; bf16_t* dst; const float* gk; int K, Nsrc, Ndst, mode, tiles; };
__device__ __forceinline__ int job_colmap(int mode, int n) {
    if (mode == 0) return n;
    if (mode == 1) { const int t = n >> 8, r = n & 255; return (r < 128) ? (t * 128 + r) : (FH + t * 128 + (r - 128)); }
    return (n < NSA_IN) ? n : -1;
}
__device__ void transpose_tile(LAS float* tile, const TJob& J, int t) {
    const int tid = otid(), tx = tid & 63, ty = tid >> 6;
    const int nkt = J.K >> 6; const int tn = t / nkt, tk = t - tn * nkt; const int n0 = tn * 64, k0 = tk * 64;
    const int sc = job_colmap(J.mode, n0 + tx);
#pragma unroll
    for (int i = 0; i < 8; ++i) { const int k = k0 + ty + 8 * i; const float gs = J.gk ? J.gk[k] : 1.0f; tile[(ty + 8 * i) * 65 + tx] = (sc >= 0) ? J.src[(size_t)k * J.Nsrc + sc] * gs : 0.f; }
    __syncthreads();
    {
        const int nn = tid >> 3, kg = tid & 7;
        float v[8];
#pragma unroll
        for (int e = 0; e < 8; ++e) v[e] = tile[(kg * 8 + e) * 65 + nn];
        u32x4 w; w.x = pk_bf16(v[0], v[1]); w.y = pk_bf16(v[2], v[3]); w.z = pk_bf16(v[4], v[5]); w.w = pk_bf16(v[6], v[7]);
        *(u32x4*)(J.dst + (size_t)(n0 + nn) * J.K + k0 + kg * 8) = w;
    }
    __syncthreads();
}
__device__ __forceinline__ void get_job(const Params& P, unsigned char* ws, int j, TJob& J) {
        J.gk = nullptr;
        if (j < 4) { J.gk = P.ffn_norm + j * 1024; J.src = P.ffn_w_gate_up + (size_t)j * 1024 * 5632; J.dst = (bf16_t*)(ws + WS_WGU) + (size_t)j * 5632 * 1024; J.K = 1024; J.Nsrc = 5632; J.Ndst = 5632; J.mode = 1; }
        else if (j < 8) { const int l = j - 4; J.src = P.ffn_w_down + (size_t)l * 2816 * 1024; J.dst = (bf16_t*)(ws + WS_WDN) + (size_t)l * 1024 * 2816; J.K = 2816; J.Nsrc = 1024; J.Ndst = 1024; J.mode = 0; }
        else if (j < 10) { const int l = j - 8; J.gk = P.mix_norm + (3 * l) * 1024; J.src = P.nsa_w_in + (size_t)l * 1024 * NSA_IN; J.dst = (bf16_t*)(ws + WS_NWIN) + (size_t)l * NSA_NP * 1024; J.K = 1024; J.Nsrc = NSA_IN; J.Ndst = NSA_NP; J.mode = 2; }
        else if (j < 12) { const int l = j - 10; J.src = P.nsa_w_out + (size_t)l * 1024 * 1024; J.dst = (bf16_t*)(ws + WS_NWOUT) + (size_t)l * 1024 * 1024; J.K = 1024; J.Nsrc = 1024; J.Ndst = 1024; J.mode = 0; }
        else if (j < 14) { const int l = j - 12; J.src = P.nsa_cmp_k_w1 + (size_t)l * 2048 * 256; J.dst = (bf16_t*)(ws + WS_CW1) + (size_t)l * 512 * 2048; J.K = 2048; J.Nsrc = 256; J.Ndst = 256; J.mode = 0; }
        else if (j < 16) { const int l = j - 14; J.src = P.nsa_cmp_v_w1 + (size_t)l * 2048 * 256; J.dst = (bf16_t*)(ws + WS_CW1) + (size_t)l * 512 * 2048 + (size_t)256 * 2048; J.K = 2048; J.Nsrc = 256; J.Ndst = 256; J.mode = 0; }
        else if (j == 16) { J.gk = P.mix_norm + 1024; J.src = P.sgu_w_in; J.dst = (bf16_t*)(ws + WS_SWIN); J.K = 1024; J.Nsrc = 2048; J.Ndst = 2048; J.mode = 0; }
        else if (j == 17) { J.src = P.sgu_w_out; J.dst = (bf16_t*)(ws + WS_SWOUT); J.K = 1024; J.Nsrc = 1024; J.Ndst = 1024; J.mode = 0; }
        else if (j == 18) { J.gk = P.mix_norm + 2048; J.src = P.pool_w_in; J.dst = (bf16_t*)(ws + WS_PWIN); J.K = 1024; J.Nsrc = 1024; J.Ndst = 1024; J.mode = 0; }
        else { J.src = P.pool_w_out; J.dst = (bf16_t*)(ws + WS_PWOUT); J.K = 1024; J.Nsrc = 1024; J.Ndst = 1024; J.mode = 0; }
        J.tiles = (J.Ndst >> 6) * (J.K >> 6);
    }
__device__ void prologue_phase(const Params& P, LAS unsigned char* lds) {
    unsigned char* ws = P.ws;
    const int tid = otid();
    constexpr int NJ = 22;
    int total = 0;
    (void)NJ; (void)total;
    {
        int base = 0;
        for (int j = 0; j < 19; ++j) {
            TJob J; get_job(P, ws, j, J);
            int first = (obid() - base % ogdim() + ogdim()) % ogdim();
            for (int t = first; t < J.tiles; t += ogdim()) transpose_tile((LAS float*)lds, J, t);
            base += J.tiles;
        }
    }
    const size_t gtid = (size_t)obid() * 512 + tid, gsz = (size_t)ogdim() * 512;
    {
        bf16_t* dst = (bf16_t*)(ws + WS_PWOUT);
        for (size_t i = gtid; i < (size_t)256 * 256; i += gsz) {
            const int e0 = (int)(i & 255) * 4, c0 = (int)(i >> 8) * 4; const int g = c0 >> 8;
            const f32x4* wg = (const f32x4*)(P.pool_w_grp + ((size_t)g * 256 + (c0 & 255)) * 256);
            const f32x4* sc = (const f32x4*)(P.pool_scale + g * 256);
            const float* wo = P.pool_w_out + (size_t)g * 256 * 1024 + e0;
            f32x4 acc[4];
#pragma unroll
            for (int j = 0; j < 4; ++j) acc[j] = (f32x4){0.f, 0.f, 0.f, 0.f};
#pragma unroll 2
            for (int m4 = 0; m4 < 64; ++m4) {
                const f32x4 s4 = sc[m4];
                f32x4 wv[4];
#pragma unroll
                for (int j = 0; j < 4; ++j) wv[j] = wg[j * 64 + m4] * s4;
#pragma unroll
                for (int mm = 0; mm < 4; ++mm) {
                    const f32x4 o4 = *(const f32x4*)(wo + (size_t)(m4 * 4 + mm) * 1024);
#pragma unroll
                    for (int j = 0; j < 4; ++j) acc[j] = acc[j] + o4 * wv[j][mm];
                }
            }
#pragma unroll
            for (int ii = 0; ii < 4; ++ii) {
                u32x2 w; w.x = pk_bf16(acc[0][ii], acc[1][ii]); w.y = pk_bf16(acc[2][ii], acc[3][ii]);
                *(u32x2*)(dst + (size_t)(e0 + ii) * 1024 + c0) = w;
            }
        }
    }
    {
        bf16_t* dst = (bf16_t*)(ws + WS_W2T);
        for (size_t i = gtid; i < (size_t)4 * 64 * 256; i += gsz) {
            const int c = (int)(i & 255), d = (int)((i >> 8) & 63), kv = (int)((i >> 14) & 1), l = (int)(i >> 15);
            const float* w2 = (kv ? P.nsa_cmp_v_w2 : P.nsa_cmp_k_w2) + (size_t)l * 256 * 64;
            dst[i] = f2bf(w2[c * 64 + d]);
        }
    }
    {
        bf16_t* dst = (bf16_t*)(ws + WS_SWS);
        for (size_t i = gtid; i < (size_t)8 * 128 * 128; i += gsz) { const int t = (int)((i >> 7) & 127), s = (int)(i & 127); dst[i] = f2bf(s <= t ? P.sgu_w_s[i] : 0.f); }
    }
    {
        float* cs = (float*)(ws + WS_CS);
        for (size_t i = gtid; i < (size_t)MTOK * 8; i += gsz) {
            const int row = (int)(i >> 3), f = (int)(i & 7);
            const float inv = (float)pow(500000.0, -(double)(2 * f) / 16.0);
            const float ang = (float)P.positions[row] * inv;
            float sv, cv; sincosf(ang, &sv, &cv);
            cs[(size_t)row * 16 + f] = cv; cs[(size_t)row * 16 + 8 + f] = sv;
        }
    }
    {
        const int lane = tid & 63; const int gw = obid() * 8 + (tid >> 6), nw = ogdim() * 8;
        bf16_t* XBp = (bf16_t*)(ws + WS_H2); float* rss7 = (float*)(ws + WS_RSS) + (size_t)7 * MTOK * 16;
        for (int row = gw; row < MTOK; row += nw) {
            const f32x4* xr = (const f32x4*)(P.x + (size_t)row * 1024); float ss = 0.f;
#pragma unroll
            for (int i = 0; i < 4; ++i) { const f32x4 v = xr[lane + 64 * i]; ss += v[0] * v[0] + v[1] * v[1] + v[2] * v[2] + v[3] * v[3];
                u32x2 w; w.x = pk_bf16(v[0], v[1]); w.y = pk_bf16(v[2], v[3]); ((u32x2*)(XBp + (size_t)row * 1024))[lane + 64 * i] = w; }
#pragma unroll
            for (int o = 32; o >= 1; o >>= 1) ss += __shfl_xor(ss, o);
            if (lane < 16) rss7[(size_t)row * 16 + lane] = (lane == 0) ? ss : 0.f;
        }
    }
    for (int item = obid(); item < 256; item += ogdim()) {
        const int job = item >> 6, chunk = item & 63; const int l = job >> 1, kv = job & 1;
        const float* pos = (kv ? P.nsa_cmp_pos_v : P.nsa_cmp_pos_k) + (size_t)l * 2048;
        const float* w1 = (kv ? P.nsa_cmp_v_w1 : P.nsa_cmp_k_w1) + (size_t)l * 2048 * 256;
        const int c = tid & 255, hf = tid >> 8;
        float a = 0.f;
        const int r0 = chunk * 32 + hf * 16;
#pragma unroll
        for (int r = 0; r < 16; ++r) a += pos[r0 + r] * w1[(size_t)(r0 + r) * 256 + c];
        LAS float* red = (LAS float*)lds;
        __syncthreads();
        if (hf == 1) red[c] = a;
        __syncthreads();
        if (hf == 0) ((float*)(ws + WS_CBPART))[(size_t)item * 256 + c] = a + red[c];
        __syncthreads();
    }
}
__device__ void cbias_reduce(unsigned char* ws, int l) {
    const int tid = otid(); const int kv = tid >> 8, c = tid & 255;
    const float* part = (const float*)(ws + WS_CBPART) + (size_t)(l * 2 + kv) * 64 * 256 + c;
    float a = 0.f;
#pragma unroll 16
    for (int ch = 0; ch < 64; ++ch) a += part[(size_t)ch * 256];
    ((float*)(ws + WS_CBIAS))[l * 512 + tid] = a;
}

__device__ void rmsnorm_phase(const float* X, const float* g, bf16_t* H, float* outf) {
    const int lane = otid() & 63; const int gw = obid() * 8 + (otid() >> 6), nw = ogdim() * 8;
    f32x4 gv[4];
#pragma unroll
    for (int i = 0; i < 4; ++i) gv[i] = ((const f32x4*)g)[lane + 64 * i];
    for (int row = gw; row < MTOK; row += nw) {
        const f32x4* xr = (const f32x4*)(X + (size_t)row * 1024);
        f32x4 v[4]; float ss = 0.f;
#pragma unroll
        for (int i = 0; i < 4; ++i) { v[i] = xr[lane + 64 * i]; ss += v[i][0] * v[i][0] + v[i][1] * v[i][1] + v[i][2] * v[i][2] + v[i][3] * v[i][3]; }
#pragma unroll
        for (int o = 32; o >= 1; o >>= 1) ss += __shfl_xor(ss, o);
        const float rstd = rsqrtf(ss * (1.0f / 1024.0f) + 1e-6f);
        if (outf) {
#pragma unroll
            for (int i = 0; i < 4; ++i) ((f32x4*)(outf + (size_t)row * 1024))[lane + 64 * i] = v[i] * rstd * gv[i];
        } else {
#pragma unroll
            for (int i = 0; i < 4; ++i) { const f32x4 y = v[i] * rstd * gv[i]; u32x2 w; w.x = pk_bf16(y[0], y[1]); w.y = pk_bf16(y[2], y[3]); ((u32x2*)(H + (size_t)row * 1024))[lane + 64 * i] = w; }
        }
    }
}

__device__ void final_norm_phase(const bf16_t* XB, const float* g, float* out) {
    const int lane = otid() & 63; const int gw = obid() * 8 + (otid() >> 6), nw = ogdim() * 8;
    for (int row = gw; row < MTOK; row += nw) {
        const u32x4* xr = (const u32x4*)(XB + (size_t)row * 1024);
        float v[2][8]; float ss = 0.f;
#pragma unroll
        for (int i = 0; i < 2; ++i) { const u32x4 w = xr[lane + 64 * i];
            v[i][0] = __uint_as_float(w.x << 16); v[i][1] = __uint_as_float(w.x & 0xffff0000u); v[i][2] = __uint_as_float(w.y << 16); v[i][3] = __uint_as_float(w.y & 0xffff0000u);
            v[i][4] = __uint_as_float(w.z << 16); v[i][5] = __uint_as_float(w.z & 0xffff0000u); v[i][6] = __uint_as_float(w.w << 16); v[i][7] = __uint_as_float(w.w & 0xffff0000u);
#pragma unroll
            for (int e = 0; e < 8; ++e) ss += v[i][e] * v[i][e]; }
#pragma unroll
        for (int o = 32; o >= 1; o >>= 1) ss += __shfl_xor(ss, o);
        const float rstd = rsqrtf(ss * (1.0f / 1024.0f) + 1e-6f);
#pragma unroll
        for (int i = 0; i < 2; ++i) { const int c0 = (lane + 64 * i) * 8;
            const f32x4 g0 = *(const f32x4*)(g + c0), g1 = *(const f32x4*)(g + c0 + 4);
            f32x4 o0, o1;
#pragma unroll
            for (int e = 0; e < 4; ++e) { o0[e] = v[i][e] * rstd * g0[e]; o1[e] = v[i][4 + e] * rstd * g1[e]; }
            *(f32x4*)(out + (size_t)row * 1024 + c0) = o0; *(f32x4*)(out + (size_t)row * 1024 + c0 + 4) = o1; }
    }
}

#define MFMA32(a, b, c) __builtin_amdgcn_mfma_f32_32x32x16_bf16((a), (b), (c), 0, 0, 0)
__device__ __forceinline__ int crow16(int i, int h) { return (i & 3) + 8 * (i >> 2) + 4 * h; }
__device__ __forceinline__ f32x16 zero16() { f32x16 z; for (int i = 0; i < 16; ++i) z[i] = 0.f; return z; }
__device__ void cmp2_local(const bf16_t* CH, const bf16_t* w2T, bf16_t* KCMP, bf16_t* VCMPT, int L) {
    const int tid = otid(), w = tid >> 6, lane = tid & 63, r = lane & 31, h = lane >> 5;
    const int type = L >> 5;
    const bf16_t* wp = w2T + (size_t)type * 64 * 256 + 8 * h;
    const bf16_t* chp = CH + ((size_t)L * 256 + w * 32 + r) * 256 + 8 * h;
    f32x16 acc[2]; acc[0] = zero16(); acc[1] = zero16();
#pragma unroll 4
    for (int s = 0; s < 16; ++s) {
        const bf16x8 cf = *(const bf16x8*)(chp + 16 * s);
#pragma unroll
        for (int db = 0; db < 2; ++db) {
            const bf16x8 wf = *(const bf16x8*)(wp + (size_t)(32 * db + r) * 256 + 16 * s);
            acc[db] = (type == 0) ? MFMA32(wf, cf, acc[db]) : MFMA32(cf, wf, acc[db]);
        }
    }
    const int Rl0 = (L & 31) * 256 + w * 32;
#pragma unroll
    for (int db = 0; db < 2; ++db)
#pragma unroll
        for (int q4 = 0; q4 < 4; ++q4) {
            u32x2 o; o.x = pk_bf16(acc[db][4 * q4 + 0], acc[db][4 * q4 + 1]); o.y = pk_bf16(acc[db][4 * q4 + 2], acc[db][4 * q4 + 3]);
            if (type == 0) *(u32x2*)(KCMP + (size_t)(Rl0 + r) * 64 + 32 * db + 8 * q4 + 4 * h) = o;
            else *(u32x2*)(VCMPT + ((size_t)(Rl0 >> 8) * 64 + 32 * db + r) * 256 + (Rl0 & 255) + 8 * q4 + 4 * h) = o;
        }
}


__device__ __forceinline__ void qk_tile(const bf16_t* Kt  , const bf16x8 (&Qf)[4], f32x16 (&ST)[2], int r, int h) {
#pragma unroll
    for (int kb = 0; kb < 2; ++kb) {
        f32x16 a = zero16();
#pragma unroll
        for (int s = 0; s < 4; ++s) { const bf16x8 kf = *(const bf16x8*)(Kt + (size_t)(32 * kb + r) * 64 + 16 * s + 8 * h); a = MFMA32(kf, Qf[s], a); }
        ST[kb] = a;
    }
}
__device__ __forceinline__ bf16x8 pack8(const f32x16& x, int s2) {
    u32x4 p; p.x = pk_bf16(x[8 * s2 + 0], x[8 * s2 + 1]); p.y = pk_bf16(x[8 * s2 + 2], x[8 * s2 + 3]); p.z = pk_bf16(x[8 * s2 + 4], x[8 * s2 + 5]); p.w = pk_bf16(x[8 * s2 + 6], x[8 * s2 + 7]);
    return __builtin_bit_cast(bf16x8, p);
}
__device__ __forceinline__ void pv_tile(const bf16_t* Vt  , int ldv, const f32x16 (&Pm)[2], f32x16 (&O)[2], int r, int h) {
#pragma unroll
    for (int kb = 0; kb < 2; ++kb)
#pragma unroll
        for (int s2 = 0; s2 < 2; ++s2) {
            const bf16x8 pf = pack8(Pm[kb], s2);
#pragma unroll
            for (int db = 0; db < 2; ++db) {
                const bf16_t* vp = Vt + (size_t)(32 * db + r) * ldv + 32 * kb + 16 * s2 + 4 * h;
                const s16x4 lo = *(const s16x4*)vp, hi = *(const s16x4*)(vp + 8);
                const bf16x8 vf = __builtin_shufflevector(lo, hi, 0, 1, 2, 3, 4, 5, 6, 7);
                O[db] = MFMA32(vf, pf, O[db]);
            }
        }
}
constexpr int KB_BYTES = 64 * 144, VB_BYTES = 64 * 136, STG_BYTES = KB_BYTES + VB_BYTES;
constexpr int ATT_STAGE_OFF = 65536 + 512;
__device__ __forceinline__ float ex2(float x) { return __builtin_amdgcn_exp2f(x); }
__device__ __forceinline__ float xor8_add(float x) { const int y = __builtin_amdgcn_update_dpp(0, __float_as_int(x), 0x128, 0xf, 0xf, false); return x + __int_as_float(y); }
__device__ __forceinline__ float xor16_add(float x) { auto rr = __builtin_amdgcn_permlane16_swap(__float_as_uint(x), __float_as_uint(x), false, false); return __uint_as_float(rr[0]) + __uint_as_float(rr[1]); }
__device__ __forceinline__ float max3f(float a, float b, float c) { float r; asm("v_max3_f32 %0, %1, %2, %3" : "=v"(r) : "v"(a), "v"(b), "v"(c)); return r; }

__device__ __forceinline__ void qk_lds(const LAS unsigned char* kb_, unsigned kr_off, const bf16x8 (&Qf)[4], f32x16 (&ST)[2]) {
#pragma unroll
    for (int kb = 0; kb < 2; ++kb) {
        f32x16 a = zero16();
#pragma unroll
        for (int s = 0; s < 4; ++s) { const bf16x8 kf = *(const LAS bf16x8*)(kb_ + kr_off + kb * 32 * 144 + s * 32); a = MFMA32(kf, Qf[s], a); }
        ST[kb] = a;
    }
}
__device__ __forceinline__ void pv_lds(const LAS unsigned char* vb_, unsigned vr_off, const f32x16 (&Pm)[2], f32x16 (&O)[2]) {
#pragma unroll
    for (int kb = 0; kb < 2; ++kb)
#pragma unroll
        for (int s2 = 0; s2 < 2; ++s2) {
            const bf16x8 pf = pack8(Pm[kb], s2);
#pragma unroll
            for (int db = 0; db < 2; ++db) {
                const LAS unsigned char* vp = vb_ + vr_off + db * 32 * 136 + kb * 64 + s2 * 32;
                const s16x4 lo = *(const LAS s16x4*)vp, hi = *(const LAS s16x4*)(vp + 16);
                const bf16x8 vf = __builtin_shufflevector(lo, hi, 0, 1, 2, 3, 4, 5, 6, 7);
                O[db] = MFMA32(vf, pf, O[db]);
            }
        }
}
template <bool MASKED> __device__ __forceinline__ void softmax2(f32x16 (&ST)[2], unsigned vm, bool rowon, float& m_run, float& l_run, f32x16 (&O)[2]) {
    float mx = -1e30f;
    if (MASKED) {
#pragma unroll
        for (int kb = 0; kb < 2; ++kb)
#pragma unroll
            for (int i = 0; i < 16; ++i) { const bool v = (vm >> (16 * kb + i)) & 1u; mx = fmaxf(mx, v ? ST[kb][i] : -1e30f); }
    } else {
#pragma unroll
        for (int kb = 0; kb < 2; ++kb)
#pragma unroll
            for (int i = 0; i < 16; i += 2) mx = max3f(mx, ST[kb][i], ST[kb][i + 1]);
        mx = rowon ? mx : -1e30f;
    }
    if (__any(mx > m_run + 8.0f)) {
        const float mo = fmaxf(mx, __shfl_xor(mx, 32));
        const float m_new = fmaxf(m_run, mo);
        const float alpha = ex2(m_run - m_new);
        l_run *= alpha; m_run = m_new;
#pragma unroll
        for (int db = 0; db < 2; ++db) O[db] = O[db] * alpha;
    }
    float rs0 = 0.f, rs1 = 0.f;
    if (MASKED) {
#pragma unroll
        for (int kb = 0; kb < 2; ++kb)
#pragma unroll
            for (int i = 0; i < 16; ++i) { const bool v = (vm >> (16 * kb + i)) & 1u; const float p = v ? ex2(ST[kb][i] - m_run) : 0.f; ST[kb][i] = p; rs0 += p; }
    } else {
        const float m_use = rowon ? m_run : __builtin_inff();
#pragma unroll
        for (int kb = 0; kb < 2; ++kb)
#pragma unroll
            for (int i = 0; i < 16; i += 2) { const float p0 = ex2(ST[kb][i] - m_use), p1 = ex2(ST[kb][i + 1] - m_use); ST[kb][i] = p0; ST[kb][i + 1] = p1; rs0 += p0; rs1 += p1; }
    }
    l_run += rs0 + rs1;
}

template <int MODE> __device__ __forceinline__ void attn_branch(const bf16_t* Kg, const bf16_t* Vg, int ldv, int kt0, int kt1, const bf16x8 (&Qf)[4], int t, int qb, unsigned long long mysel,
                                                                float& m_run, float& l_run, float inv_l, f32x16 (&O)[2], LAS float* psw, LAS unsigned char* stage, int tid, int r, int h,
                                                                u32x4& kreg, u32x4& vreg, bool pre, const bf16_t* nK, const bf16_t* nV, int nldv) {
    const int srow = tid >> 3, sch = tid & 7;
    const bf16_t* kp = Kg + (size_t)kt0 * 4096 + srow * 64 + sch * 8;
    const bf16_t* vp = Vg + (size_t)srow * ldv + (size_t)kt0 * 64 + sch * 8;
    if (!pre) { kreg = *(const u32x4*)kp; if (MODE != 0) vreg = *(const u32x4*)vp; }
    const unsigned kw_off = srow * 144 + sch * 16, vw_off = srow * 136 + sch * 16;
    const unsigned kr_off = r * 144 + h * 16, vr_off = r * 136 + h * 8;
    const int nmax = (t >= 31) ? ((t - 31) >> 4) : -1;
    __syncthreads();
    *(LAS u32x4*)(stage + kw_off) = kreg;
    if (MODE != 0) { *(LAS u32x2*)(stage + KB_BYTES + vw_off) = (u32x2){vreg.x, vreg.y}; *(LAS u32x2*)(stage + KB_BYTES + vw_off + 8) = (u32x2){vreg.z, vreg.w}; }
    __syncthreads();
    for (int kt = kt0; kt <= kt1; ++kt) {
        const int cur = (kt - kt0) & 1;
        if (kt < kt1) { kp += 4096; kreg = *(const u32x4*)kp; if (MODE != 0) { vp += 64; vreg = *(const u32x4*)vp; } }
        else if (nK) { kreg = *(const u32x4*)(nK + srow * 64 + sch * 8); if (nV) vreg = *(const u32x4*)(nV + (size_t)srow * nldv + sch * 8); }
        const LAS unsigned char* kb_ = stage + cur * STG_BYTES; const LAS unsigned char* vb_ = kb_ + KB_BYTES;
        bool selb = true, active = true;
        if (MODE == 2) { selb = (mysel >> kt) & 1ull; active = (__ballot(selb) != 0ull); }
        if (active) {
            f32x16 ST[2]; qk_lds(kb_, kr_off, Qf, ST);
            if (MODE == 0) {
                unsigned vm = 0u;
#pragma unroll
                for (int kb = 0; kb < 2; ++kb)
#pragma unroll
                    for (int i = 0; i < 16; ++i) { const int n = 64 * kt + 32 * kb + crow16(i, h); if (n <= nmax) vm |= 1u << (16 * kb + i); }
                softmax2<true>(ST, vm, true, m_run, l_run, O);
            } else if (MODE == 1) {
#pragma unroll
                for (int kb = 0; kb < 2; ++kb)
#pragma unroll
                    for (int i = 0; i < 16; ++i) {
                        const int n = 64 * kt + 32 * kb + crow16(i, h);
                        const float p = (n <= nmax) ? ex2(ST[kb][i] - m_run) * inv_l : 0.f; ST[kb][i] = p;
                        if (qb >= 16) {
                            const float ps = xor16_add(xor8_add(p));
                            if (r < 8) psw[r * 256 + n] = ps;
                        }
                    }
                pv_lds(vb_, vr_off, ST, O);
            } else {
                const bool edge = (MODE == 2) ? (kt == qb) : (kt == qb || kt == qb - 8);
                if (edge) {
                    unsigned vm = 0u;
#pragma unroll
                    for (int kb = 0; kb < 2; ++kb)
#pragma unroll
                        for (int i = 0; i < 16; ++i) {
                            const int kp_ = 64 * kt + 32 * kb + crow16(i, h);
                            const bool v = (MODE == 2) ? (selb && kp_ <= t) : (kp_ <= t && kp_ + 512 > t);
                            if (v) vm |= 1u << (16 * kb + i);
                        }
                    softmax2<true>(ST, vm, true, m_run, l_run, O);
                } else {
                    softmax2<false>(ST, 0u, selb, m_run, l_run, O);
                }
                pv_lds(vb_, vr_off, ST, O);
            }
        }
        if (kt < kt1) {
            LAS unsigned char* nb = stage + (cur ^ 1) * STG_BYTES;
            *(LAS u32x4*)(nb + kw_off) = kreg;
            if (MODE != 0) { *(LAS u32x2*)(nb + KB_BYTES + vw_off) = (u32x2){vreg.x, vreg.y}; *(LAS u32x2*)(nb + KB_BYTES + vw_off + 8) = (u32x2){vreg.z, vreg.w}; }
        }
        __syncthreads();
    }
}

__device__ void nsa_attn_phase(const bf16_t* Q, const bf16_t* KV, const bf16_t* KCMP, const bf16_t* VCMPT, const float* gates, bf16_t* AO, LAS unsigned char* lds) {
    const int tid = otid(), wid = tid >> 6, lane = tid & 63, r = lane & 31, h = lane >> 5;
    LAS float* psw = (LAS float*)lds + wid * 2048;
    LAS unsigned long long* selw = (LAS unsigned long long*)(lds + 65536) + wid * 8;
    LAS unsigned char* stage = lds + ATT_STAGE_OFF;
    if (wid < 4) __builtin_amdgcn_s_setprio(2);
    const int G = ogdim();
    for (int idx = obid(); idx < 2048; idx += G) {
        const int vb = idx & 255, jj = idx >> 8;
        const int xcd = vb & 7, slot = vb >> 3;
        const int bg = xcd * 4 + (slot >> 3), kq = slot & 7;
        const int qb = (jj & 1) ? (16 * (jj >> 1) + 15 - kq) : (16 * (jj >> 1) + kq);
        const int b = bg >> 2, g = bg & 3;
        const int head = g * 4 + (r >> 3);
        const int tok = wid * 8 + (r & 7);
        const int t = qb * 64 + tok;
        const size_t rowg = (size_t)b * 4096 + t;
        bf16x8 Qf[4];
        { const bf16_t* qp = Q + ((size_t)(b * 16 + head) * 4096 + t) * 64 + 8 * h;
#pragma unroll
          for (int s = 0; s < 4; ++s) Qf[s] = *(const bf16x8*)(qp + 16 * s); }
        f32x16 OUT[2];
        if (qb >= 16) {
#pragma unroll
            for (int i = 0; i < 32; ++i) psw[lane + 64 * i] = 0.f;
        }
        {
            const bf16_t* Kc = KCMP + (size_t)bg * 256 * 64; const bf16_t* Vc = VCMPT + (size_t)bg * 64 * 256;
            int ntc = ((4 * qb + 2) >> 6) + 1; if (ntc > 4) ntc = 4;
            float m_run = -1e30f, l_run = 0.f;
            f32x16 O[2]; O[0] = zero16(); O[1] = zero16();
            u32x4 kst = {0u, 0u, 0u, 0u}, vst = {0u, 0u, 0u, 0u};
            attn_branch<0>(Kc, Vc, 256, 0, ntc - 1, Qf, t, qb, 0ull, m_run, l_run, 0.f, O, psw, stage, tid, r, h, kst, vst, false, Kc, Vc, 256);
            l_run += __shfl_xor(l_run, 32);
            const float inv_l = l_run > 0.f ? __builtin_amdgcn_rcpf(l_run) : 0.f;
            attn_branch<1>(Kc, Vc, 256, 0, ntc - 1, Qf, t, qb, 0ull, m_run, l_run, inv_l, O, psw, stage, tid, r, h, kst, vst, true, nullptr, nullptr, 0);
            const float g_c = gates[rowg * 48 + head];
#pragma unroll
            for (int db = 0; db < 2; ++db) OUT[db] = O[db] * g_c;
        }
        __syncthreads();
        if (qb < 16) { if (lane < 8) selw[lane] = (2ull << qb) - 1ull; }
        else
        for (int tk = 0; tk < 8; ++tk) {
            const int mblk = lane;
            float imp = 0.f;
#pragma unroll
            for (int j = -1; j <= 3; ++j) { const int n = 4 * mblk + j; if (n >= 0) imp += psw[tk * 256 + n]; }
            if (mblk == 0 || mblk == qb || mblk == qb - 1) imp = 1e9f;
            if (mblk > qb) imp = -1e30f;
            int rank = 0;
#pragma unroll 8
            for (int mp = 0; mp < 64; ++mp) { const float o = __int_as_float(__builtin_amdgcn_readlane(__float_as_int(imp), mp)); rank += (o > imp || (o == imp && mp < mblk)) ? 1 : 0; }
            unsigned long long msk = __ballot(rank < 16);
            msk &= (qb >= 63) ? ~0ull : ((2ull << qb) - 1ull);
            if (lane == 0) selw[tk] = msk;
        }
        __syncthreads();
        const unsigned long long mysel = selw[r & 7];
#pragma unroll
        for (int db = 0; db < 2; ++db)
#pragma unroll
            for (int i = 0; i < 16; ++i) psw[(db * 16 + i) * 64 + lane] = OUT[db][i];
        u32x4 kst2 = {0u, 0u, 0u, 0u}, vst2 = {0u, 0u, 0u, 0u};
        {
            const bf16_t* Ks = KV + 2 * KVSZ + (size_t)bg * 4096 * 64; const bf16_t* Vs = KV + 3 * KVSZ + (size_t)bg * 64 * 4096;
            float m_run = -1e30f, l_run = 0.f; f32x16 O[2]; O[0] = zero16(); O[1] = zero16();
            attn_branch<2>(Ks, Vs, 4096, 0, qb, Qf, t, qb, mysel, m_run, l_run, 0.f, O, psw, stage, tid, r, h, kst2, vst2, false,
                           KV + 4 * KVSZ + (size_t)bg * 4096 * 64 + (size_t)(qb > 8 ? qb - 8 : 0) * 4096, KV + 5 * KVSZ + (size_t)bg * 64 * 4096 + (size_t)(qb > 8 ? qb - 8 : 0) * 64, 4096);
            l_run += __shfl_xor(l_run, 32);
            const float sc = (l_run > 0.f ? __builtin_amdgcn_rcpf(l_run) : 0.f) * gates[rowg * 48 + 16 + head];
#pragma unroll
            for (int db = 0; db < 2; ++db)
#pragma unroll
                for (int i = 0; i < 16; ++i) psw[(db * 16 + i) * 64 + lane] += O[db][i] * sc;
        }
        {
            const bf16_t* Kw = KV + 4 * KVSZ + (size_t)bg * 4096 * 64; const bf16_t* Vw = KV + 5 * KVSZ + (size_t)bg * 64 * 4096;
            float m_run = -1e30f, l_run = 0.f; f32x16 O[2]; O[0] = zero16(); O[1] = zero16();
            attn_branch<3>(Kw, Vw, 4096, (qb > 8 ? qb - 8 : 0), qb, Qf, t, qb, 0ull, m_run, l_run, 0.f, O, psw, stage, tid, r, h, kst2, vst2, true, nullptr, nullptr, 0);
            l_run += __shfl_xor(l_run, 32);
            const float sc = (l_run > 0.f ? __builtin_amdgcn_rcpf(l_run) : 0.f) * gates[rowg * 48 + 32 + head];
#pragma unroll
            for (int db = 0; db < 2; ++db)
#pragma unroll
                for (int i = 0; i < 16; ++i) OUT[db][i] = psw[(db * 16 + i) * 64 + lane] + O[db][i] * sc;
        }
        {
            bf16_t* op = AO + rowg * 1024 + head * 64;
#pragma unroll
            for (int db = 0; db < 2; ++db)
#pragma unroll
                for (int q4 = 0; q4 < 4; ++q4) {
                    u32x2 w; w.x = pk_bf16(OUT[db][4 * q4 + 0], OUT[db][4 * q4 + 1]); w.y = pk_bf16(OUT[db][4 * q4 + 2], OUT[db][4 * q4 + 3]);
                    *(u32x2*)(op + 32 * db + 8 * q4 + 4 * h) = w;
                }
        }
    }
    __builtin_amdgcn_s_setprio(0);
    __syncthreads();
}


__device__ void sgu_spatial_phase(const bf16_t* UV, const float* lng, const float* lnb, const bf16_t* SWS, const float* bs, bf16_t* GATED, LAS unsigned char* lds) {
    constexpr int LDV = 136;
    LAS bf16_t* vnT = (LAS bf16_t*)lds;
    LAS float* mu = (LAS float*)(lds + 128 * LDV * 2); LAS float* rsd = mu + 128;
    const int tid = otid(), wid = tid >> 6, lane = tid & 63, r = lane & 31, h = lane >> 5;
    for (int cn = obid(); cn < 256; cn += ogdim()) {
        const size_t tok0 = (size_t)cn * 128;
        __syncthreads();
#pragma unroll 4
        for (int rr = 0; rr < 16; ++rr) {
            const int sl = wid * 16 + rr;
            const u32x4* vp = (const u32x4*)(UV + (tok0 + sl) * 2048 + 1024);
            float s1 = 0.f, s2 = 0.f;
#pragma unroll
            for (int i = 0; i < 2; ++i) { const u32x4 w = vp[lane + 64 * i];
#pragma unroll
                for (int j = 0; j < 4; ++j) { const float a = __uint_as_float(w[j] << 16), c = __uint_as_float(w[j] & 0xffff0000u); s1 += a + c; s2 += a * a + c * c; } }
#pragma unroll
            for (int o = 32; o >= 1; o >>= 1) { s1 += __shfl_xor(s1, o); s2 += __shfl_xor(s2, o); }
            const float mean = s1 * (1.0f / 1024.0f); const float var = fmaxf(s2 * (1.0f / 1024.0f) - mean * mean, 0.f);
            if (lane == 0) { mu[sl] = mean; rsd[sl] = rsqrtf(var + 1e-5f); }
        }
        __syncthreads();
        for (int g = 0; g < 8; ++g) {
            {
                const int sl = tid >> 2, cq = tid & 3;
                const float mean = mu[sl], rs = rsd[sl];
                const bf16_t* vp = UV + (tok0 + sl) * 2048 + 1024 + g * 128 + cq * 32;
#pragma unroll
                for (int i = 0; i < 4; ++i) {
                    const u32x4 w = *(const u32x4*)(vp + i * 8);
                    const int c0 = cq * 32 + i * 8;
                    const f32x4 ga = *(const f32x4*)(lng + g * 128 + c0), gb = *(const f32x4*)(lng + g * 128 + c0 + 4);
                    const f32x4 ba = *(const f32x4*)(lnb + g * 128 + c0), bb = *(const f32x4*)(lnb + g * 128 + c0 + 4);
#pragma unroll
                    for (int j = 0; j < 4; ++j) {
                        const float a = __uint_as_float(w[j] << 16), c = __uint_as_float(w[j] & 0xffff0000u);
                        const float gA = (2 * j < 4) ? ga[(2 * j) & 3] : gb[(2 * j) & 3], gB = (2 * j + 1 < 4) ? ga[(2 * j + 1) & 3] : gb[(2 * j + 1) & 3];
                        const float bA = (2 * j < 4) ? ba[(2 * j) & 3] : bb[(2 * j) & 3], bB = (2 * j + 1 < 4) ? ba[(2 * j + 1) & 3] : bb[(2 * j + 1) & 3];
                        vnT[(c0 + 2 * j) * LDV + sl] = f2bf((a - mean) * rs * gA + bA);
                        vnT[(c0 + 2 * j + 1) * LDV + sl] = f2bf((c - mean) * rs * gB + bB);
                    }
                }
            }
            __syncthreads();
            const int tb = wid & 3, ch = wid >> 2;
            f32x16 acc[2]; acc[0] = zero16(); acc[1] = zero16();
            const bf16_t* wsp = SWS + ((size_t)g * 128 + tb * 32 + r) * 128 + 8 * h;
            for (int ks = 0; ks <= 2 * tb + 1; ++ks) {
                const bf16x8 bfrag = *(const bf16x8*)(wsp + 16 * ks);
#pragma unroll
                for (int cb = 0; cb < 2; ++cb) {
                    const bf16x8 afrag = *(const LAS bf16x8*)(vnT + (ch * 64 + cb * 32 + r) * LDV + 16 * ks + 8 * h);
                    acc[cb] = MFMA32(afrag, bfrag, acc[cb]);
                }
            }
            const int tl = tb * 32 + r; const size_t token = tok0 + tl;
            const float bias = bs[g * 128 + tl];
#pragma unroll
            for (int cb = 0; cb < 2; ++cb)
#pragma unroll
                for (int q4 = 0; q4 < 4; ++q4) {
                    const int c0 = g * 128 + ch * 64 + cb * 32 + 8 * q4 + 4 * h;
                    const u32x2 uw = *(const u32x2*)(UV + token * 2048 + c0);
                    const float u0 = __uint_as_float(uw.x << 16), u1 = __uint_as_float(uw.x & 0xffff0000u), u2 = __uint_as_float(uw.y << 16), u3 = __uint_as_float(uw.y & 0xffff0000u);
                    u32x2 w; w.x = pk_bf16(u0 * (acc[cb][4 * q4 + 0] + bias), u1 * (acc[cb][4 * q4 + 1] + bias)); w.y = pk_bf16(u2 * (acc[cb][4 * q4 + 2] + bias), u3 * (acc[cb][4 * q4 + 3] + bias));
                    *(u32x2*)(GATED + token * 1024 + c0) = w;
                }
            __syncthreads();
        }
    }
    __syncthreads();
}

__device__ void pool_diff_phase(const float* __restrict__ Z, bf16_t* __restrict__ Dd) {
    const size_t gtid = (size_t)obid() * 512 + otid(), gsz = (size_t)ogdim() * 512;
    for (size_t idx = gtid; idx < (size_t)256 * 1024; idx += gsz) {
        const int c4 = (int)(idx & 255), seg = (int)(idx >> 8);
        const int t0 = seg * 32, s0 = t0 & 4095; const int w = 2 << (c4 >> 6);
        const f32x4* zp = (const f32x4*)Z + c4;
        f32x4 S = {0.f, 0.f, 0.f, 0.f};
        const int jlo = (s0 - w > 0) ? (s0 - w) : 0;
        for (int j = jlo; j < s0; ++j) S = S + zp[(size_t)(t0 - s0 + j) * 256];
#pragma unroll 8
        for (int i = 0; i < 32; ++i) {
            const int s = s0 + i; const f32x4 zt = zp[(size_t)(t0 + i) * 256];
            S = S + zt; if (s - w >= 0) S = S - zp[(size_t)(t0 + i - w) * 256];
            const float inv = 1.0f / (float)((s + 1 < w) ? (s + 1) : w);
            const f32x4 d = S * inv - zt;
            u32x2 o; o.x = pk_bf16(d[0], d[1]); o.y = pk_bf16(d[2], d[3]);
            *(u32x2*)(Dd + (size_t)(t0 + i) * 1024 + c4 * 4) = o;
        }
    }
}

#define XB_TMO      128
#define XB_XCNT(j)  (256  + 64 * (j))
#define XB_XSUB(j)  (1280 + 64 * (j))
#define XB_XGEN(j)  (2304 + 64 * (j))
#define XB_TOP      3328
#define XB_TOPGEN   3392
#define XCD_BAR_WORDS 3456
#define XB_SPIN_CAP (1u << 18)

__device__ __forceinline__ unsigned xb_ld(unsigned* p)              { return __hip_atomic_load(p, __ATOMIC_RELAXED, __HIP_MEMORY_SCOPE_AGENT); }
__device__ __forceinline__ unsigned xb_add(unsigned* p, unsigned v) { return __hip_atomic_fetch_add(p, v, __ATOMIC_RELAXED, __HIP_MEMORY_SCOPE_AGENT); }
__device__ __forceinline__ unsigned xb_xcc_id() { return (unsigned)__builtin_amdgcn_s_getreg((3 << 11) | 20) & 0xFu; }
#define XB_SPIN(cond, bar) do { unsigned _sp = 0; while (cond) { __builtin_amdgcn_s_sleep(1); \
    if ((++_sp & 255u) == 0u) { if (xb_ld(&(bar)[XB_TMO])) break; if (_sp > XB_SPIN_CAP) { atomicAdd(&(bar)[XB_TMO], 1u); break; } } } } while (0)

struct XcdBarrier {
    unsigned* bar; unsigned x;
    volatile LAS unsigned* st;
};

__device__ __forceinline__ XcdBarrier xcd_barrier_post(unsigned* bar, volatile LAS unsigned* st) {
    XcdBarrier b; b.bar = bar; b.x = xb_xcc_id(); b.st = st;
    if (threadIdx.x == 0) (void)xb_add(&bar[XB_XCNT(b.x)], 1u);
    return b;
}
__device__ __forceinline__ void xcd_barrier_complete(unsigned* bar, unsigned x, unsigned& nloc, unsigned& nx) {
    const unsigned G = gridDim.x * gridDim.y * gridDim.z;
    unsigned sum, cnt, mine, sp = 0u;
    for (;;) {
        sum = 0u; cnt = 0u; mine = 0u;
#pragma unroll
        for (unsigned j = 0; j < 16; ++j) { const unsigned c = xb_ld(&bar[XB_XCNT(j)]); sum += c; cnt += (c > 0u) ? 1u : 0u; mine = (j == x) ? c : mine; }
        if (sum == G) break;
        __builtin_amdgcn_s_sleep(1);
        if ((++sp & 255u) == 0u) { if (xb_ld(&bar[XB_TMO])) break; if (sp > XB_SPIN_CAP) { atomicAdd(&bar[XB_TMO], 1u); break; } }
    }
    nloc = mine > 0u ? mine : 1u; nx = cnt > 0u ? cnt : 1u;
}

__device__ __forceinline__ void xcd_barrier(const XcdBarrier& b) {
    asm volatile("s_waitcnt vmcnt(0)" ::: "memory");
    __syncthreads();
    if (threadIdx.x == 0) {
        unsigned* bar = b.bar;
        __builtin_amdgcn_s_waitcnt(0);
        unsigned nloc = b.st[0], nx = b.st[1];
        if (nloc == 0u) { xcd_barrier_complete(bar, b.x, nloc, nx); b.st[0] = nloc; b.st[1] = nx; }
        const unsigned old = xb_add(&bar[XB_XSUB(b.x)], 1u);
        const unsigned gen = old / nloc;
        if (old + 1u == (gen + 1u) * nloc) {
            __builtin_amdgcn_fence(__ATOMIC_RELEASE, "agent");
            asm volatile("s_waitcnt vmcnt(0)" ::: "memory");
            const unsigned og = xb_add(&bar[XB_TOP], 1u);
            const unsigned tg = og / nx;
            if (og + 1u == (tg + 1u) * nx) xb_add(&bar[XB_TOPGEN], 1u);
            else XB_SPIN(xb_ld(&bar[XB_TOPGEN]) == tg, bar);
            __builtin_amdgcn_fence(__ATOMIC_ACQUIRE, "agent");
            xb_add(&bar[XB_XGEN(b.x)], 1u);
            asm volatile("s_waitcnt vmcnt(0)" ::: "memory");
        } else {
            XB_SPIN(xb_ld(&bar[XB_XGEN(b.x)]) == gen, bar);
            __builtin_amdgcn_fence(__ATOMIC_ACQUIRE, "agent");
            asm volatile("s_waitcnt vmcnt(0)" ::: "memory");
        }
    }
    __syncthreads();
}

constexpr int NPH = 25;
__constant__ unsigned char PROG[NPH][2] = {
    {0, 0},
    {3, 0}, {4, 0}, {5, 0}, {6, 0}, {7, 0}, {13, 0}, {14, 0},
    {8, 1}, {9, 1}, {7, 1}, {13, 1}, {14, 1},
    {10, 2}, {11, 2}, {7, 2}, {13, 2}, {14, 2},
    {3, 3}, {4, 3}, {5, 3}, {6, 3}, {7, 3}, {13, 3}, {14, 3},
};
__global__ void __launch_bounds__(512, 2) fwd_megakernel(Params P) {
    extern __shared__ __attribute__((aligned(16))) unsigned char lds_raw[];
    LAS unsigned char* lds = (LAS unsigned char*)lds_raw;
    cg::grid_group grid = cg::this_grid();
    { volatile LAS unsigned* st0 = (volatile LAS unsigned*)(lds + 131072); if (threadIdx.x == 0) { st0[0] = 0u; st0[1] = 0u; } __syncthreads(); }
    (void)xcd_barrier_post((unsigned*)(P.ws + WS_BAR), (volatile LAS unsigned*)(lds + 131072));
    prologue_phase(P, lds);
    if (obid() == 0 && otid() == 0) {
        const float** tb = (const float**)(P.ws + WS_TBL);
        tb[0] = P.x; tb[1] = P.mix_norm; tb[2] = P.ffn_norm; tb[3] = P.final_norm; tb[4] = P.nsa_cmp_k_w2; tb[5] = P.nsa_cmp_v_w2;
        tb[6] = P.sgu_ln_g; tb[7] = P.sgu_ln_b; tb[8] = P.sgu_b_s; tb[9] = P.pool_scale;
    }
    grid.sync();
    unsigned char* const ws_k = P.ws; float* const out_k = P.out;
#pragma unroll 1
    for (int ph = 1; ph <= NPH; ++ph) {
        const int type = (ph < NPH) ? (int)PROG[ph][0] : 15, layer = (ph < NPH) ? (int)PROG[ph][1] : 0;
        unsigned char* ws = ws_k; asm volatile("" : "+s"(ws));
        const float* const* tb = (const float* const*)(ws + WS_TBL);
        bf16_t* H = (bf16_t*)(ws + WS_H);
        bf16_t* BIG = (bf16_t*)(ws + WS_BIG);
        bf16_t* H2 = (bf16_t*)(ws + WS_H2);
        float* RSS = (float*)(ws + WS_RSS);
        const float* rss_in = RSS + (size_t)((layer == 0) ? 7 : (2 * layer - 1)) * MTOK * 16;
        bf16_t* XB = H2;
        float* X = out_k; asm volatile("" : "+s"(X));
        const int kind = layer % 3, j = layer / 3;
        switch (type) {
        case 15: final_norm_phase(XB, tb[3], X); break;
        case 3: { if (obid() == 0) cbias_reduce(ws, j);
                  EpiNsaIn E; E.Q = BIG; E.KV = BIG + (size_t)MTOK * 1024; E.gates = (float*)(ws + WS_GATES); E.cs = (const float*)(ws + WS_CS); E.rss = rss_in;
                  run_gemm(lds, XB, 1024, (const bf16_t*)(ws + WS_NWIN) + (size_t)j * NSA_NP * 1024, MTOK, 2560, 1024, E); } break;
        case 4: if (obid() >= 64) {
                  EpiGates E; E.gates = (float*)(ws + WS_GATES); E.rss = rss_in;
                  pg8::Gemm g; g.A = XB; g.Bt = (const bf16_t*)(ws + WS_NWIN) + (size_t)j * NSA_NP * 1024; g.M = MTOK; g.N = NSA_NP; g.K = 1024; g.lda = 1024; g.acs = 0;
                  GateOrder S; S.G = ogdim() - 64; S.c = obid() - 64;
                  pg8::gemm_phase<EpiGates, GateOrder, false>(lds, g, S, E, nullptr);
                } else { EpiBf16<2> E; E.O = (bf16_t*)(ws + WS_CH); E.ldc = 256; E.aux = (const float*)(ws + WS_CBIAS) + j * 512; E.rss = nullptr;
                  pg8::Gemm g; g.A = BIG + (size_t)MTOK * 1024; g.Bt = (const bf16_t*)(ws + WS_CW1) + (size_t)j * 512 * 2048; g.M = 16384; g.N = 512; g.K = 2048; g.lda = 1024; g.acs = 0;
                  CmpOrder S; S.G = ogdim(); S.c = obid();
                  pg8::gemm_phase<EpiBf16<2>, CmpOrder, false>(lds, g, S, E, nullptr); } break;
        case 5: if (obid() < 64) cmp2_local((const bf16_t*)(ws + WS_CH), (const bf16_t*)(ws + WS_W2T) + (size_t)j * 2 * 64 * 256, (bf16_t*)(ws + WS_KCMP), (bf16_t*)(ws + WS_VCMPT), obid()); break;
        case 6: nsa_attn_phase(BIG, BIG + (size_t)MTOK * 1024, (const bf16_t*)(ws + WS_KCMP), (const bf16_t*)(ws + WS_VCMPT), (const float*)(ws + WS_GATES), H, lds); break;
        case 7: case 14: {
                  EpiResid E; E.XB = XB;
                  if (type == 7) E.rss = RSS + (size_t)(2 * layer) * MTOK * 16; else E.rss = (layer < 3) ? RSS + (size_t)(2 * layer + 1) * MTOK * 16 : nullptr;
                  const bf16_t* A = H; int K = 1024; const bf16_t* Bt;
                  if (type == 14) { A = BIG; K = FH; Bt = (const bf16_t*)(ws + WS_WDN) + (size_t)layer * 1024 * FH; }
                  else if (kind == 0) Bt = (const bf16_t*)(ws + WS_NWOUT) + (size_t)j * 1024 * 1024;
                  else if (kind == 1) Bt = (const bf16_t*)(ws + WS_SWOUT);
                  else Bt = (const bf16_t*)(ws + WS_PWOUT);
                  run_gemm(lds, A, K, Bt, MTOK, 1024, K, E); } break;
        case 8: { EpiBf16<0> E; E.O = BIG; E.ldc = 2048; E.aux = nullptr; E.rss = rss_in;
                  run_gemm(lds, XB, 1024, (const bf16_t*)(ws + WS_SWIN), MTOK, 2048, 1024, E); } break;
        case 9: sgu_spatial_phase(BIG, tb[6], tb[7], (const bf16_t*)(ws + WS_SWS), tb[8], H, lds); break;
        case 10: { EpiF32 E; E.C = (float*)BIG; E.rss = rss_in;
                  run_gemm(lds, XB, 1024, (const bf16_t*)(ws + WS_PWIN), MTOK, 1024, 1024, E); } break;
        case 11: pool_diff_phase((const float*)BIG, H); break;
        case 12: { EpiBf16<1> E; E.O = BIG; E.ldc = 1024; E.aux = tb[9]; E.rss = nullptr;
                  int kk = 256; asm volatile("" : "+s"(kk));
                  run_gemm(lds, H, 1024, (const bf16_t*)(ws + WS_PGRP), MTOK, 1024, kk, E, 512); } break;
        case 13: { EpiGU E; E.HID = BIG; E.rss = RSS + (size_t)(2 * layer) * MTOK * 16;
                  run_gemm(lds, XB, 1024, (const bf16_t*)(ws + WS_WGU) + (size_t)layer * 5632 * 1024, MTOK, 5632, 1024, E); } break;
        default: break;
        }
        if (ph < NPH && type != 4) { XcdBarrier xb; xb.bar = (unsigned*)(ws + WS_BAR); xb.x = xb_xcc_id(); xb.st = (volatile LAS unsigned*)(lds + 131072); xcd_barrier(xb); }
    }
}

extern "C" void kernel_launch(void* const* d_in, const int* in_sizes, int n_in, void* d_out, int out_size, void* d_ws, size_t ws_size, hipStream_t stream) {
    static int grid_blocks = 0;
    if (grid_blocks == 0) {
        if (n_in != 25 || out_size != MTOK * DM || ws_size < WS_END) { fprintf(stderr, "kernel_launch: unexpected shapes (n_in %d, out %d, ws %zu need %zu)\n", n_in, out_size, ws_size, (size_t)WS_END); grid_blocks = -1; return; }
        int dev = 0, cus = 0, per_cu = 0;
        hipGetDevice(&dev);
        hipDeviceGetAttribute(&cus, hipDeviceAttributeMultiprocessorCount, dev);
        if (hipFuncSetAttribute((const void*)fwd_megakernel, hipFuncAttributeMaxDynamicSharedMemorySize, LDS_BYTES) != hipSuccess) { fprintf(stderr, "kernel_launch: hipFuncSetAttribute failed\n"); grid_blocks = -1; return; }
        if (hipOccupancyMaxActiveBlocksPerMultiprocessor(&per_cu, (const void*)fwd_megakernel, 512, LDS_BYTES) != hipSuccess || per_cu < 1) { fprintf(stderr, "kernel_launch: occupancy query gave %d\n", per_cu); per_cu = 1; }
        (void)hipGetLastError();
        grid_blocks = cus * 1;
    }
    if (grid_blocks < 0) return;
    Params p{};
    p.x = (const float*)d_in[0]; p.positions = (const int*)d_in[1]; p.mix_norm = (const float*)d_in[2]; p.ffn_norm = (const float*)d_in[3]; p.final_norm = (const float*)d_in[4];
    p.nsa_w_in = (const float*)d_in[5]; p.nsa_cmp_pos_k = (const float*)d_in[6]; p.nsa_cmp_k_w1 = (const float*)d_in[7]; p.nsa_cmp_k_w2 = (const float*)d_in[8];
    p.nsa_cmp_pos_v = (const float*)d_in[9]; p.nsa_cmp_v_w1 = (const float*)d_in[10]; p.nsa_cmp_v_w2 = (const float*)d_in[11]; p.nsa_w_out = (const float*)d_in[12];
    p.sgu_w_in = (const float*)d_in[13]; p.sgu_ln_g = (const float*)d_in[14]; p.sgu_ln_b = (const float*)d_in[15]; p.sgu_w_s = (const float*)d_in[16]; p.sgu_b_s = (const float*)d_in[17]; p.sgu_w_out = (const float*)d_in[18];
    p.pool_w_in = (const float*)d_in[19]; p.pool_w_grp = (const float*)d_in[20]; p.pool_scale = (const float*)d_in[21]; p.pool_w_out = (const float*)d_in[22];
    p.ffn_w_gate_up = (const float*)d_in[23]; p.ffn_w_down = (const float*)d_in[24];
    p.out = (float*)d_out; p.ws = (unsigned char*)d_ws;
    if (hipMemsetAsync((unsigned char*)d_ws + WS_BAR, 0, 16384, stream) != hipSuccess) { fprintf(stderr, "kernel_launch: memset of barrier words failed\n"); return; }
    void* args[] = {&p};
    hipError_t e = hipLaunchCooperativeKernel((const void*)fwd_megakernel, dim3(grid_blocks), dim3(512), args, LDS_BYTES, stream);
    if (e != hipSuccess) fprintf(stderr, "cooperative launch failed: %s (grid %d)\n", hipGetErrorString(e), grid_blocks);
}
```
